# Optimizing an MI355X kernel written in HIP

```python
import numpy as np
import jax
import jax.numpy as jnp
from jax import lax

D_MODEL = 4096
BATCH = 2
SEQ = 8192
DEPTH = 4

HEAD_DIM = 128
ROPE_THETA = 10000.0
NORM_EPS = 1e-6
Q_BLOCK = 128
N_BRANCH = 4
BRANCH_WIDTH = D_MODEL // 4
DSA_HEADS = BRANCH_WIDTH // HEAD_DIM
IDX_HEADS = 16
IDX_DIM = 64
DSA_TOPK_MAX = 256
CONV_WIDTH = BRANCH_WIDTH
CONV_K = 3
FOX_HEADS = BRANCH_WIDTH // HEAD_DIM
HGRN_HEADS = BRANCH_WIDTH // HEAD_DIM
HGRN_DK = 128
HGRN_DV = 128
HGRN_CHUNK = 64
MERGE_BLOCKS = 16
MERGE_BLOCK_DIM = D_MODEL // MERGE_BLOCKS

IN_LAYOUT = (
    ("a_q", DSA_HEADS * HEAD_DIM), ("a_k", HEAD_DIM), ("a_v", HEAD_DIM),
    ("a_iq", IDX_HEADS * IDX_DIM), ("a_ik", IDX_DIM), ("a_iw", IDX_HEADS), ("a_g", BRANCH_WIDTH),
    ("b_b", CONV_WIDTH), ("b_c", CONV_WIDTH), ("b_x", CONV_WIDTH), ("b_g", BRANCH_WIDTH),
    ("c_q", FOX_HEADS * HEAD_DIM), ("c_k", FOX_HEADS * HEAD_DIM), ("c_v", FOX_HEADS * HEAD_DIM),
    ("c_f", FOX_HEADS), ("c_g", BRANCH_WIDTH),
    ("d_q", HGRN_HEADS * HGRN_DK), ("d_f", HGRN_HEADS * HGRN_DK), ("d_i", HGRN_HEADS * HGRN_DV),
    ("d_g", BRANCH_WIDTH),
)
IN_WIDTH = int(sum(w for _, w in IN_LAYOUT))
IN_OFFSETS = tuple(int(o) for o in np.cumsum([w for _, w in IN_LAYOUT])[:-1])

kernel_name = "hybrid_dsa_conv_fox_hgrn2_gated_merge"


def rms_norm(x, w):
    xf = x.astype(jnp.float32)
    y = xf * lax.rsqrt(jnp.mean(xf * xf, axis=-1, keepdims=True) + NORM_EPS)
    return (y * w.astype(jnp.float32)).astype(x.dtype)


def rotary(x, pos):
    half = x.shape[-1] // 2
    inv = ROPE_THETA ** (-jnp.arange(half, dtype=jnp.float32) / half)
    ang = pos.astype(jnp.float32)[:, None] * inv[None, :]
    cos = jnp.cos(ang)[None, :, None, :]
    sin = jnp.sin(ang)[None, :, None, :]
    xf = x.astype(jnp.float32)
    x1, x2 = xf[..., :half], xf[..., half:]
    return jnp.concatenate([x1 * cos - x2 * sin, x1 * sin + x2 * cos], axis=-1).astype(x.dtype)


def to_blocks(t):
    b, s = t.shape[:2]
    return jnp.moveaxis(t.reshape((b, s // Q_BLOCK, Q_BLOCK) + t.shape[2:]), 1, 0)


def from_blocks(t):
    t = jnp.moveaxis(t, 0, 1)
    return t.reshape((t.shape[0], t.shape[1] * t.shape[2]) + t.shape[3:])


def dsa_sparse_attention(q, k, v, iq, ik, iw):
    b, s = q.shape[:2]
    topk = min(DSA_TOPK_MAX, s // 4)
    pos = jnp.arange(s)
    scale = HEAD_DIM ** -0.5
    iw = iw.astype(jnp.float32) * (IDX_HEADS ** -0.5 * IDX_DIM ** -0.5)
    gather = jax.vmap(lambda t, i: t[i])

    def block(args):
        qb, iqb, iwb, tq = args
        idx_logit = jnp.einsum('bqhd,bkd->bqhk', iqb, ik).astype(jnp.float32)
        score = jnp.einsum('bqh,bqhk->bqk', iwb, jax.nn.relu(idx_logit))
        causal = pos[None, :] <= tq[:, None]
        score = jnp.where(causal[None], score, -jnp.inf)
        _, sel = lax.top_k(score, topk)
        valid = sel <= tq[None, :, None]
        kg = gather(k, sel)
        vg = gather(v, sel)
        logit = jnp.einsum('bqhd,bqnd->bqhn', qb, kg).astype(jnp.float32) * scale
        logit = jnp.where(valid[:, :, None, :], logit, -jnp.inf)
        p = jax.nn.softmax(logit, axis=-1).astype(v.dtype)
        return jnp.einsum('bqhn,bqnd->bqhd', p, vg)

    out = lax.map(block, (to_blocks(q), to_blocks(iq), to_blocks(iw), pos.reshape(-1, Q_BLOCK)))
    return from_blocks(out).reshape(b, s, -1)


def short_gated_conv(b_gate, c_gate, x_in, conv_w):
    u = c_gate * x_in
    y = lax.conv_general_dilated(
        u, conv_w[:, None, :].astype(u.dtype), window_strides=(1,),
        padding=[(CONV_K - 1, 0)], dimension_numbers=('NWC', 'WIO', 'NWC'),
        feature_group_count=u.shape[-1])
    return b_gate * y


def forgetting_attention(q, k, v, log_f):
    s = q.shape[1]
    pos = jnp.arange(s)
    scale = HEAD_DIM ** -0.5
    c = jnp.cumsum(log_f, axis=1)
    c_key = jnp.transpose(c, (0, 2, 1))

    def block(args):
        qb, cb, tq = args
        logit = jnp.einsum('bqhd,bkhd->bhqk', qb, k).astype(jnp.float32) * scale
        logit = logit + jnp.transpose(cb, (0, 2, 1))[..., None] - c_key[:, :, None, :]
        causal = pos[None, :] <= tq[:, None]
        logit = jnp.where(causal[None, None], logit, -jnp.inf)
        p = jax.nn.softmax(logit, axis=-1).astype(v.dtype)
        return jnp.einsum('bhqk,bkhd->bqhd', p, v)

    out = lax.map(block, (to_blocks(q), to_blocks(c), pos.reshape(-1, Q_BLOCK)))
    return from_blocks(out)


def hgrn2_recurrence(q, k, v, log_f):
    b, s, h, dk = q.shape
    dv = v.shape[-1]
    nc = s // HGRN_CHUNK

    def chunks(t):
        return t.reshape(b, nc, HGRN_CHUNK, h, t.shape[-1]).transpose(1, 0, 3, 2, 4)

    tri = jnp.tril(jnp.ones((HGRN_CHUNK, HGRN_CHUNK), dtype=bool))

    def step(state, inp):
        qc, kc, vc, gc = inp
        bcum = jnp.cumsum(gc, axis=2)
        o_inter = jnp.einsum('bhtd,bhde->bhte', qc * jnp.exp(bcum), state)
        diff = bcum[:, :, :, None, :] - bcum[:, :, None, :, :]
        decay = jnp.exp(jnp.where(tri[:, :, None], diff, -jnp.inf))
        att = jnp.einsum('bhtd,bhtsd,bhsd->bhts', qc, decay, kc)
        o_intra = jnp.einsum('bhts,bhse->bhte', att, vc)
        b_last = bcum[:, :, -1:, :]
        new_state = (jnp.exp(b_last[:, :, 0, :])[..., None] * state
                     + jnp.einsum('bhsd,bhse->bhde', kc * jnp.exp(b_last - bcum), vc))
        return new_state, o_inter + o_intra

    state0 = jnp.zeros((b, h, dk, dv), jnp.float32)
    _, o = lax.scan(step, state0, (chunks(q), chunks(k), chunks(v), chunks(log_f)))
    return o.transpose(1, 0, 3, 2, 4).reshape(b, s, h, dv)


def hybrid_layer(x, norm_w, w_in, fox_f_bias, conv_w, hgrn_lb, hgrn_norm_w, w_branch, w_merge, b_merge, w_out):
    b, s, d = x.shape
    pos = jnp.arange(s)
    h = rms_norm(x, norm_w)
    u = h @ w_in
    (a_q, a_k, a_v, a_iq, a_ik, a_iw, a_g,
     b_b, b_c, b_x, b_g,
     c_q, c_k, c_v, c_f, c_g,
     d_q, d_f, d_i, d_g) = jnp.split(u, IN_OFFSETS, axis=-1)

    def heads(t, n):
        return t.reshape(b, s, n, -1)

    qa = rotary(heads(a_q, DSA_HEADS), pos)
    ka = rotary(a_k[:, :, None, :], pos)[:, :, 0]
    iq = rotary(heads(a_iq, IDX_HEADS), pos)
    ik = rotary(a_ik[:, :, None, :], pos)[:, :, 0]
    y_a = dsa_sparse_attention(qa, ka, a_v, iq, ik, a_iw) * jax.nn.silu(a_g)

    y_b = short_gated_conv(b_b, b_c, b_x, conv_w) * jax.nn.silu(b_g)

    log_f_c = jax.nn.log_sigmoid(c_f.astype(jnp.float32) + fox_f_bias.astype(jnp.float32))
    o_c = forgetting_attention(heads(c_q, FOX_HEADS), heads(c_k, FOX_HEADS), heads(c_v, FOX_HEADS), log_f_c)
    y_c = o_c.reshape(b, s, -1) * jax.nn.silu(c_g)

    lb = hgrn_lb.astype(jnp.float32)
    f = lb + (1.0 - lb) * jax.nn.sigmoid(d_f.astype(jnp.float32))
    o_d = hgrn2_recurrence(heads(d_q.astype(jnp.float32), HGRN_HEADS), heads(1.0 - f, HGRN_HEADS),
                           heads(d_i.astype(jnp.float32), HGRN_HEADS), heads(jnp.log(f), HGRN_HEADS))
    o_d = rms_norm(o_d, hgrn_norm_w.reshape(HGRN_HEADS, HGRN_DV)).astype(x.dtype)
    y_d = o_d.reshape(b, s, -1) * jax.nn.silu(d_g)

    h_blk = h.reshape(b, s, MERGE_BLOCKS, MERGE_BLOCK_DIM)

    def gated_branch(i, y):
        g = jnp.einsum('bsnc,ncd->bsnd', h_blk, w_merge[i]).reshape(b, s, d)
        return jax.nn.sigmoid(g + b_merge[i]) * (y @ w_branch[i])

    merged = gated_branch(0, y_a) + gated_branch(1, y_b) + gated_branch(2, y_c) + gated_branch(3, y_d)
    return x + merged @ w_out


def setup_inputs(seed: int = 0) -> dict:
    key = jax.random.key(seed)
    ks = jax.random.split(key, 12)

    def nrm(k, shape, scale):
        return jax.random.normal(k, shape, jnp.float32) * scale

    return {
        "x": nrm(ks[0], (BATCH, SEQ, D_MODEL), 1.0),
        "norm_w": 1.0 + nrm(ks[1], (DEPTH, D_MODEL), 0.02),
        "w_in": nrm(ks[2], (DEPTH, D_MODEL, IN_WIDTH), D_MODEL ** -0.5),
        "fox_f_bias": 1.0 + nrm(ks[3], (DEPTH, FOX_HEADS), 0.1),
        "conv_w": nrm(ks[4], (DEPTH, CONV_K, CONV_WIDTH), CONV_K ** -0.5),
        "hgrn_gamma": nrm(ks[5], (DEPTH, HGRN_HEADS * HGRN_DK), 1.0),
        "hgrn_norm_w": 1.0 + nrm(ks[6], (DEPTH, HGRN_HEADS * HGRN_DV), 0.02),
        "w_branch": nrm(ks[7], (DEPTH, N_BRANCH, BRANCH_WIDTH, D_MODEL), BRANCH_WIDTH ** -0.5),
        "w_merge": nrm(ks[8], (DEPTH, N_BRANCH, MERGE_BLOCKS, MERGE_BLOCK_DIM, MERGE_BLOCK_DIM), MERGE_BLOCK_DIM ** -0.5),
        "b_merge": nrm(ks[9], (DEPTH, N_BRANCH, D_MODEL), 0.01),
        "w_out": nrm(ks[10], (DEPTH, D_MODEL, D_MODEL), D_MODEL ** -0.5),
        "final_norm_w": 1.0 + nrm(ks[11], (D_MODEL,), 0.02),
    }


def reference(x, norm_w, w_in, fox_f_bias, conv_w, hgrn_gamma, hgrn_norm_w, w_branch, w_merge, b_merge, w_out, final_norm_w):
    gam = jax.nn.softmax(hgrn_gamma.astype(jnp.float32), axis=0)
    lower_bounds = jnp.cumsum(gam, axis=0) - gam[0]
    for layer in range(DEPTH):
        x = hybrid_layer(x, norm_w[layer], w_in[layer], fox_f_bias[layer], conv_w[layer],
                         lower_bounds[layer], hgrn_norm_w[layer], w_branch[layer],
                         w_merge[layer], b_merge[layer], w_out[layer])
    return rms_norm(x, final_norm_w)
```

```cpp
#include <hip/hip_runtime.h>
#include <stdint.h>
#include <stdio.h>

typedef unsigned short bf16_t;
#define LAS __attribute__((address_space(3)))

constexpr int D_MODEL = 4096, BATCH = 2, SEQ = 8192, DEPTH = 4, MTOK = BATCH * SEQ;
constexpr int IN_WIDTH = 15704;
constexpr int NU = 15872;
constexpr int LDU = 15616;
constexpr int LDM = 256;
constexpr int C_AQ = 0, C_AIQ = 1024, C_AG = 2048, C_BB = 3072, C_BC = 4096, C_BX = 5120, C_BG = 6144, C_CQ = 7168, C_CK = 8192, C_CV = 9216, C_CG = 10240,
              C_DQ = 11264, C_DF = 12288, C_DI = 13312, C_DG = 14336, C_AK = 15360, C_AV = 15488;
constexpr int MC_IK = 0, MC_IW = 64, MC_CF = 80;

__host__ __device__ __forceinline__ int inproj_src_col(int n) {
    if (n < 1024) { const int c = n & 127; return (n & ~127) + (c >> 1) + 64 * (c & 1); }
    if (n < 2048) { const int m = n - 1024, c = m & 63; return 1280 + (m & ~63) + (c >> 1) + 32 * (c & 1); }
    if (n < 3072) return 2384 + (n - 2048);
    if (n < 4096) return 3408 + (n - 3072);
    if (n < 5120) return 4432 + (n - 4096);
    if (n < 6144) return 5456 + (n - 5120);
    if (n < 7168) return 6480 + (n - 6144);
    if (n < 8192) return 7504 + (n - 7168);
    if (n < 9216) return 8528 + (n - 8192);
    if (n < 10240) return 9552 + (n - 9216);
    if (n < 11264) return 10584 + (n - 10240);
    if (n < 12288) return 11608 + (n - 11264);
    if (n < 13312) return 12632 + (n - 12288);
    if (n < 14336) return 13656 + (n - 13312);
    if (n < 15360) return 14680 + (n - 14336);
    if (n < 15488) { const int c = n - 15360; return 1024 + (c >> 1) + 64 * (c & 1); }
    if (n < 15616) return 1152 + (n - 15488);
    if (n < 15680) { const int c = n - 15616; return 2304 + (c >> 1) + 32 * (c & 1); }
    if (n < 15696) return 2368 + (n - 15680);
    if (n < 15704) return 10576 + (n - 15696);
    return -1;
}

constexpr size_t al256(size_t x) { return (x + 255) & ~(size_t)255; }
constexpr size_t WS_CTL = 0;
constexpr int CW_FOXN = 1024;
constexpr size_t WS_WIN = 1u << 20;
constexpr size_t WS_WB = WS_WIN + al256((size_t)DEPTH * NU * D_MODEL * 2);
constexpr size_t WS_WM = WS_WB + al256((size_t)DEPTH * 4 * D_MODEL * 1024 * 2);
constexpr size_t WS_WO = WS_WM + al256((size_t)DEPTH * 4 * 16 * 256 * 256 * 2);
constexpr size_t WS_H = WS_WO + al256((size_t)DEPTH * D_MODEL * D_MODEL * 2);
constexpr size_t WS_RS = WS_H;
constexpr size_t WS_U = WS_H + al256((size_t)MTOK * D_MODEL * 2);
constexpr size_t WS_UM = WS_U + al256((size_t)MTOK * LDU * 2);
constexpr size_t WS_GATE = WS_UM + al256((size_t)MTOK * LDM * 4);
constexpr size_t WS_Y = WS_GATE + al256((size_t)4 * MTOK * D_MODEL * 2);
constexpr size_t WS_MACC = WS_Y + al256((size_t)MTOK * D_MODEL * 2);
constexpr size_t WS_XB = WS_MACC;
constexpr size_t WS_MERGED = WS_MACC + al256((size_t)MTOK * D_MODEL * 4);
constexpr size_t WS_SCORE = WS_MERGED + al256((size_t)MTOK * D_MODEL * 2);
constexpr int SCP = SEQ + 832;
constexpr int SCPH = SEQ + 1664;
constexpr int SCP_UNUSED = SEQ + 832;
constexpr size_t WS_IDX = WS_SCORE + al256((size_t)MTOK * SCP * 4);
constexpr size_t WS_CF = WS_IDX + al256((size_t)MTOK * 256 * 4);
constexpr size_t WS_HO = WS_CF + al256((size_t)BATCH * 8 * SEQ * 4 * 2);
constexpr size_t WS_ROPE128 = WS_HO + al256((size_t)MTOK * 1024 * 4);
constexpr size_t WS_ROPE64 = WS_ROPE128 + al256((size_t)SEQ * 64 * 2 * 4);
constexpr size_t WS_LB = WS_ROPE64 + al256((size_t)SEQ * 32 * 2 * 4);
constexpr size_t WS_HUT = WS_LB + al256((size_t)DEPTH * 1024 * 4);
constexpr size_t WS_HD = WS_HUT + al256((size_t)BATCH * 8 * (SEQ / 32) * 16384 * 4);
constexpr size_t WS_HST = WS_HD + al256((size_t)BATCH * 8 * (SEQ / 32) * 128 * 4);
constexpr size_t WS_IKB = WS_HST + al256((size_t)BATCH * 8 * (SEQ / 32) * 16384 * 2);
constexpr size_t WS_END = WS_IKB + al256((size_t)MTOK * 64 * 2);

__device__ __forceinline__ float bf2f(bf16_t b) { return __uint_as_float(((unsigned)b) << 16); }
__device__ __forceinline__ bf16_t f2bf(float f) { unsigned u = __float_as_uint(f); u += 0x7fffu + ((u >> 16) & 1u); return (bf16_t)(u >> 16); }
__device__ __forceinline__ unsigned pk2(float lo, float hi) { return (unsigned)f2bf(lo) | ((unsigned)f2bf(hi) << 16); }
template <int CTRL> __device__ __forceinline__ float dpp_f(float v) { return __int_as_float(__builtin_amdgcn_update_dpp(0, __float_as_int(v), CTRL, 0xf, 0xf, true)); }
template <int CTRL> __device__ __forceinline__ int dpp_i(int v) { return __builtin_amdgcn_update_dpp(0, v, CTRL, 0xf, 0xf, true); }
__device__ __forceinline__ float wave_sum(float v) {
    v += dpp_f<0xB1>(v); v += dpp_f<0x4E>(v); v += dpp_f<0x141>(v); v += dpp_f<0x140>(v);
    const int i = __float_as_int(v);
    return (__int_as_float(__builtin_amdgcn_readlane(i, 0)) + __int_as_float(__builtin_amdgcn_readlane(i, 16))) + (__int_as_float(__builtin_amdgcn_readlane(i, 32)) + __int_as_float(__builtin_amdgcn_readlane(i, 48)));
}
__device__ __forceinline__ float wave_max(float v) {
    v = fmaxf(v, dpp_f<0xB1>(v)); v = fmaxf(v, dpp_f<0x4E>(v)); v = fmaxf(v, dpp_f<0x141>(v)); v = fmaxf(v, dpp_f<0x140>(v));
    const int i = __float_as_int(v);
    return fmaxf(fmaxf(__int_as_float(__builtin_amdgcn_readlane(i, 0)), __int_as_float(__builtin_amdgcn_readlane(i, 16))), fmaxf(__int_as_float(__builtin_amdgcn_readlane(i, 32)), __int_as_float(__builtin_amdgcn_readlane(i, 48))));
}
__device__ __forceinline__ int wave_sum_i(int v) {
    v += dpp_i<0xB1>(v); v += dpp_i<0x4E>(v); v += dpp_i<0x141>(v); v += dpp_i<0x140>(v);
    return (__builtin_amdgcn_readlane(v, 0) + __builtin_amdgcn_readlane(v, 16)) + (__builtin_amdgcn_readlane(v, 32) + __builtin_amdgcn_readlane(v, 48));
}
__device__ __forceinline__ float sigmoidf_(float x) { return __builtin_amdgcn_rcpf(1.0f + __expf(-x)); }
__device__ __forceinline__ float siluf_(float x) { return x * __builtin_amdgcn_rcpf(1.0f + __expf(-x)); }

namespace pg8 {
typedef short bf16x8 __attribute__((ext_vector_type(8)));
typedef float f32x4 __attribute__((ext_vector_type(4)));
typedef unsigned u32x4 __attribute__((ext_vector_type(4)));
constexpr int BM = 256, BK = 64, HALF = 128, HTB = HALF * BK * 2, STAGE_BYTES = 8 * HTB, NXCD = 8, WGM = 8;

__host__ __device__ __forceinline__ int lds_byte(int r, int c) { const int st = (r >> 4) * 2 + (c >> 5), rr = r & 15, cc = c & 31, ob = rr * 64 + cc * 2; return st * 1024 + (ob ^ (((ob >> 9) & 1) << 5)); }
__host__ __device__ __forceinline__ void stage_rc(int b, int& R, int& C) { const int st = b / 1024, sb = b % 1024, swz = sb ^ (((sb >> 9) & 1) << 5); R = (st >> 1) * 16 + swz / 64; C = (st & 1) * 32 + (swz % 64) / 2; }
__host__ __device__ __forceinline__ int perm32(int rho) { const int n = rho >> 4, i = rho & 15; return 8 * (i >> 2) + 4 * n + (i & 3); }

struct Unit { int pm, pn, z, pad; };
struct Gemm { const bf16_t* A; const bf16_t* Bt; int M, N, K, lda, ldb, pad; };

struct TileOrder {
    int nM, nN, nwg, G, c, pad;
    __host__ __device__ void init(int nM_, int nN_, int G_, int c_) { nM = nM_; nN = nN_; nwg = nM * nN; G = G_; c = c_; pad = 0; }
    __host__ __device__ bool tile(int i, int& pm, int& pn) const {
        const long L = (long)i * G + c; if (L >= nwg) return false;
        int wgid = (int)L; { const int q = nwg / NXCD, r = nwg % NXCD, xcd = wgid % NXCD, off = wgid / NXCD; wgid = (xcd < r ? xcd * (q + 1) : r * (q + 1) + (xcd - r) * q) + off; }
        const int nig = WGM * nN, gid = wgid / nig, fm = gid * WGM, gsz = (nM - fm) < WGM ? (nM - fm) : WGM;
        pm = fm + ((wgid % nig) % gsz); pn = (wgid % nig) / gsz; return true;
    }
};
struct SchedPlain : TileOrder {
    __device__ __forceinline__ bool next(int i, Unit& u) const { u.z = 0; u.pad = 0; return tile(i, u.pm, u.pn); }
    __device__ __forceinline__ size_t a_off(const Unit& u, const Gemm& g) const { return (size_t)u.pm * BM * g.lda * 2; }
    __device__ __forceinline__ size_t b_off(const Unit& u, const Gemm& g) const { return (size_t)u.pn * BM * g.ldb * 2; }
};
struct SchedGates : TileOrder {
    __device__ __forceinline__ bool next(int i, Unit& u) const { u.z = 0; u.pad = 0;
        if (G != 256 || nwg != 4096) return tile(i, u.pm, u.pn);
        const int cnt = c < 128 ? 12 : 20; if (i >= cnt) return false;
        const int id = (c < 128 ? c * 12 : 128 * 12 + (c - 128) * 20) + i;
        u.pm = id >> 6; u.pn = id & 63; return true; }
    __device__ __forceinline__ size_t a_off(const Unit& u, const Gemm& g) const { return (size_t)u.pm * BM * g.lda * 2 + (size_t)(u.pn & 15) * 512; }
    __device__ __forceinline__ size_t b_off(const Unit& u, const Gemm& g) const { return (size_t)u.pn * 256 * 256 * 2; }
};
struct SchedBranch : TileOrder {
    __device__ __forceinline__ bool next(int i, Unit& u) const { u.z = i & 3; u.pad = 0; return tile(i >> 2, u.pm, u.pn); }
    __device__ __forceinline__ size_t a_off(const Unit& u, const Gemm& g) const { return (size_t)u.pm * BM * g.lda * 2 + (size_t)u.z * 2048; }
    __device__ __forceinline__ size_t b_off(const Unit& u, const Gemm& g) const { return (size_t)u.z * ((size_t)4096 * 1024 * 2) + (size_t)u.pn * BM * g.ldb * 2; }
};

typedef __bf16 bf16x2_t __attribute__((ext_vector_type(2)));
typedef float f32x2_t __attribute__((ext_vector_type(2)));
__device__ __forceinline__ unsigned cvt_pk_bf16(float lo, float hi) { const f32x2_t v = {lo, hi}; return __builtin_bit_cast(unsigned, __builtin_convertvector(v, bf16x2_t)); }

struct NoPre {};
struct EpiInProj {
    static constexpr bool PERM = true;
    struct Pre { float rs2[2]; };
    __device__ __forceinline__ Pre pre(const Unit& u, int wr, int, int fr, int fq) const { Pre p; const float* rp = RS + u.pm * BM + wr * 64 + fq * 16 + fr;
        p.rs2[0] = rp[0]; p.rs2[1] = rp[HALF]; return p; }
    static __device__ __forceinline__ float rs_of(const Pre& pr, int ai, int m, int fr) { return __int_as_float(__builtin_amdgcn_ds_bpermute((m * 16 + fr) * 4, __float_as_int(pr.rs2[ai]))); }
    __device__ __forceinline__ bool keep(const Unit&) const { return false; }
    bf16_t* U; float* UM; bf16_t* IKB; const float* T128; const float* T64;
    const float* RS;
    static __device__ __forceinline__ void rot8(f32x4& v0, f32x4& v1, const float* tab) {
        const f32x4 c0 = *(const f32x4*)tab, c1 = *(const f32x4*)(tab + 4);
        const float a0 = v0[0] * c0[0] - v0[1] * c0[1], a1 = v0[0] * c0[1] + v0[1] * c0[0], a2 = v0[2] * c0[2] - v0[3] * c0[3], a3 = v0[2] * c0[3] + v0[3] * c0[2];
        const float b0 = v1[0] * c1[0] - v1[1] * c1[1], b1 = v1[0] * c1[1] + v1[1] * c1[0], b2 = v1[2] * c1[2] - v1[3] * c1[3], b3 = v1[2] * c1[3] + v1[3] * c1[2];
        v0 = (f32x4){a0, a1, a2, a3}; v1 = (f32x4){b0, b1, b2, b3};
    }
    template <int RK> __device__ __forceinline__ void tile_bf16(f32x4 (&acc)[2][2][4][2], const Unit& u, int wr, int wc, int fr, int fq, const Pre& pr) const {
        const int row0 = u.pm * BM + wr * 64 + fr, col0 = u.pn * BM + wc * 32 + 8 * fq;
#pragma unroll
        for (int ai = 0; ai < 2; ++ai) {
            f32x4 tb[4][2][2]; float rsv[4];
#pragma unroll
            for (int m = 0; m < 4; ++m) rsv[m] = rs_of(pr, ai, m, fr);
            if (RK != 0) {
#pragma unroll
                for (int m = 0; m < 4; ++m) { const int pos = (row0 + ai * HALF + m * 16) & (SEQ - 1);
#pragma unroll
                    for (int bj = 0; bj < 2; ++bj) { if (RK == 3 && bj == 1) continue; const int ct = bj * HALF + wc * 32 + 8 * fq;
                        const float* tp = (RK == 2) ? T64 + ((size_t)pos * 32 + ((ct & 63) >> 1)) * 2 : T128 + ((size_t)pos * 64 + ((ct & 127) >> 1)) * 2;
                        tb[m][bj][0] = *(const f32x4*)tp; tb[m][bj][1] = *(const f32x4*)(tp + 4); } }
            }
#pragma unroll
            for (int m = 0; m < 4; ++m) { bf16_t* rowp = U + (size_t)(row0 + ai * HALF + m * 16) * LDU + col0;
#pragma unroll
                for (int bj = 0; bj < 2; ++bj) { f32x4 v0 = acc[ai][bj][m][0] * rsv[m], v1 = acc[ai][bj][m][1] * rsv[m];
                    if (RK == 1 || RK == 2 || (RK == 3 && bj == 0)) { const f32x4 c0 = tb[m][bj][0], c1 = tb[m][bj][1];
                        const float a0 = v0[0] * c0[0] - v0[1] * c0[1], a1 = v0[0] * c0[1] + v0[1] * c0[0], a2 = v0[2] * c0[2] - v0[3] * c0[3], a3 = v0[2] * c0[3] + v0[3] * c0[2];
                        const float b0 = v1[0] * c1[0] - v1[1] * c1[1], b1 = v1[0] * c1[1] + v1[1] * c1[0], b2 = v1[2] * c1[2] - v1[3] * c1[3], b3 = v1[2] * c1[3] + v1[3] * c1[2];
                        v0 = (f32x4){a0, a1, a2, a3}; v1 = (f32x4){b0, b1, b2, b3}; }
                    u32x4 w; w.x = cvt_pk_bf16(v0[0], v0[1]); w.y = cvt_pk_bf16(v0[2], v0[3]); w.z = cvt_pk_bf16(v1[0], v1[1]); w.w = cvt_pk_bf16(v1[2], v1[3]);
                    *(u32x4*)(rowp + bj * HALF) = w; } }
        }
    }
    __device__ __forceinline__ void operator()(f32x4 (&acc)[2][2][4][2], const Unit& u, int wr, int wc, int fr, int fq, const Pre& pr) const {
        const int row0 = u.pm * BM + wr * 64 + fr;
        if (u.pn < 61) {
            if (u.pn < 4) tile_bf16<1>(acc, u, wr, wc, fr, fq, pr);
            else if (u.pn < 8) tile_bf16<2>(acc, u, wr, wc, fr, fq, pr);
            else if (u.pn == 60) tile_bf16<3>(acc, u, wr, wc, fr, fq, pr);
            else tile_bf16<0>(acc, u, wr, wc, fr, fq, pr);
        } else {
            const int col0 = wc * 32 + 8 * fq;
#pragma unroll
            for (int ai = 0; ai < 2; ++ai)
#pragma unroll
                for (int m = 0; m < 4; ++m) { const int row = row0 + ai * HALF + m * 16, pos = row & (SEQ - 1);
                    const float rsv = rs_of(pr, ai, m, fr); f32x4 v0 = acc[ai][0][m][0] * rsv, v1 = acc[ai][0][m][1] * rsv;
                    if (col0 < 64) { rot8(v0, v1, T64 + ((size_t)pos * 32 + (col0 >> 1)) * 2);
                        u32x4 w; w.x = cvt_pk_bf16(v0[0], v0[1]); w.y = cvt_pk_bf16(v0[2], v0[3]); w.z = cvt_pk_bf16(v1[0], v1[1]); w.w = cvt_pk_bf16(v1[2], v1[3]);
                        *(u32x4*)(IKB + (((((size_t)(row >> 6) * 2 + (row & 1)) * 4 + (col0 >> 4)) * 64 + ((row & 63) >> 1) + 32 * ((col0 >> 3) & 1)) << 3)) = w; }
                    else { float* rowp = UM + (size_t)row * LDM + col0; *(f32x4*)rowp = v0; *(f32x4*)(rowp + 4) = v1; } }
        }
    }
};
struct EpiGates {
    static constexpr bool PERM = true;
    struct Pre { unsigned bvp[2][2][2]; float rs2[2]; };
    __device__ __forceinline__ Pre pre(const Unit& u, int wr, int wc, int fr, int fq) const { const float* bb = bias + (u.pn >> 4) * D_MODEL + (u.pn & 15) * 256 + wc * 32 + 8 * fq; Pre p; const float* rp = RS + u.pm * BM + wr * 64 + fq * 16 + fr; p.rs2[0] = rp[0]; p.rs2[1] = rp[HALF];
#pragma unroll
        for (int bj = 0; bj < 2; ++bj)
#pragma unroll
            for (int n = 0; n < 2; ++n) { const f32x4 t = *(const f32x4*)(bb + bj * HALF + 4 * n); p.bvp[bj][n][0] = cvt_pk_bf16(t[0], t[1]); p.bvp[bj][n][1] = cvt_pk_bf16(t[2], t[3]); }
        return p; }
    __device__ __forceinline__ bool keep(const Unit&) const { return false; }
    unsigned char* G; const float* bias; const float* RS;
    static __device__ __forceinline__ unsigned q8(float x) { const float g = sigmoidf_(x); return (unsigned)fmaxf(__builtin_rintf(g * 255.0f), 1.0f); }
    __device__ __forceinline__ void operator()(f32x4 (&acc)[2][2][4][2], const Unit& u, int wr, int wc, int fr, int fq, const Pre& pr) const {
        const int row0 = u.pm * BM + wr * 64 + fr; const int br = u.pn >> 4, nb = u.pn & 15;
        const int col0 = nb * 256 + wc * 32 + 8 * fq;
        unsigned char* base = G + ((((size_t)br * (MTOK / BM) + u.pm) * 16 + nb) << 16) + (unsigned)(((wr * 4 + wc) * 64 + fq * 16 + fr) * 16); const float* bb = bias + br * D_MODEL + col0;
        f32x4 bv[2][2];
#pragma unroll
        for (int bj = 0; bj < 2; ++bj)
#pragma unroll
            for (int n = 0; n < 2; ++n) { const unsigned a = pr.bvp[bj][n][0], b = pr.bvp[bj][n][1]; bv[bj][n] = (f32x4){__uint_as_float(a << 16), __uint_as_float(a & 0xffff0000u), __uint_as_float(b << 16), __uint_as_float(b & 0xffff0000u)}; }
#pragma unroll
        for (int ai = 0; ai < 2; ++ai)
#pragma unroll
            for (int m = 0; m < 4; ++m) { u32x4 w;
#pragma unroll
                for (int bj = 0; bj < 2; ++bj) { const float rsv = __int_as_float(__builtin_amdgcn_ds_bpermute((m * 16 + fr) * 4, __float_as_int(pr.rs2[ai]))); const f32x4 v0 = acc[ai][bj][m][0] * rsv + bv[bj][0], v1 = acc[ai][bj][m][1] * rsv + bv[bj][1];
                    const unsigned lo = q8(v0[0]) | (q8(v0[1]) << 8) | (q8(v0[2]) << 16) | (q8(v0[3]) << 24), hi = q8(v1[0]) | (q8(v1[1]) << 8) | (q8(v1[2]) << 16) | (q8(v1[3]) << 24);
                    if (bj == 0) { w.x = lo; w.y = hi; } else { w.z = lo; w.w = hi; } }
                *(u32x4*)(base + (ai * 4 + m) * 8192) = w; }
    }
};
struct EpiBranch {
    static constexpr bool PERM = true;
    typedef NoPre Pre; __device__ __forceinline__ Pre pre(const Unit&, int, int, int, int) const { return Pre{}; }
    const unsigned char* G; bf16_t* merged;
    __device__ __forceinline__ bool keep(const Unit& u) const { return u.z < 3; }
    static __device__ __forceinline__ void gate8(const uint2 gw, float (&g)[8]) {
        g[0] = (float)(gw.x & 0xffu); g[1] = (float)((gw.x >> 8) & 0xffu); g[2] = (float)((gw.x >> 16) & 0xffu); g[3] = (float)(gw.x >> 24);
        g[4] = (float)(gw.y & 0xffu); g[5] = (float)((gw.y >> 8) & 0xffu); g[6] = (float)((gw.y >> 16) & 0xffu); g[7] = (float)(gw.y >> 24);
    }
    __device__ __forceinline__ void operator()(f32x4 (&acc)[2][2][4][2], const Unit& u, int wr, int wc, int fr, int fq, const Pre&) const {
        { unsigned m_ = ~0u; asm volatile("" : "+s"(m_)); const int ln_ = (int)__builtin_amdgcn_mbcnt_hi(m_, __builtin_amdgcn_mbcnt_lo(m_, 0u)); fr = ln_ & 15; fq = ln_ >> 4; }
        const int row0 = u.pm * BM + wr * 64 + fr; const int col0 = u.pn * BM + wc * 32 + 8 * fq; const int z = u.z;
        const unsigned toff = (unsigned)(((wr * 4 + wc) * 64 + fq * 16 + fr) * 16);
        const unsigned char* ga = G + ((((size_t)z * (MTOK / BM) + u.pm) * 16 + u.pn) << 16); const unsigned char* gb = G + ((((size_t)(z < 3 ? z + 1 : z) * (MTOK / BM) + u.pm) * 16 + u.pn) << 16);
        const bool last = z == 3;
        u32x4 ra[2][4], rb[2][4];
#pragma unroll
        for (int ai = 0; ai < 2; ++ai)
#pragma unroll
            for (int m = 0; m < 4; ++m) { const unsigned off = toff + (unsigned)((ai * 4 + m) * 8192);
                ra[ai][m] = *(const u32x4*)(ga + off); rb[ai][m] = *(const u32x4*)(gb + off); }
#pragma unroll
        for (int ai = 0; ai < 2; ++ai)
#pragma unroll
            for (int m = 0; m < 4; ++m)
#pragma unroll
                for (int bj = 0; bj < 2; ++bj) { float r[8], d[8]; gate8(bj ? make_uint2(ra[ai][m].z, ra[ai][m].w) : make_uint2(ra[ai][m].x, ra[ai][m].y), r); gate8(bj ? make_uint2(rb[ai][m].z, rb[ai][m].w) : make_uint2(rb[ai][m].x, rb[ai][m].y), d);
#pragma unroll
                    for (int j = 0; j < 8; ++j) r[j] = last ? r[j] * (1.0f / 255.0f) : r[j] * __builtin_amdgcn_rcpf(d[j]);
                    f32x4 v0 = acc[ai][bj][m][0], v1 = acc[ai][bj][m][1];
                    v0[0] *= r[0]; v0[1] *= r[1]; v0[2] *= r[2]; v0[3] *= r[3]; v1[0] *= r[4]; v1[1] *= r[5]; v1[2] *= r[6]; v1[3] *= r[7];
                    acc[ai][bj][m][0] = v0; acc[ai][bj][m][1] = v1; }
        if (last) {
#pragma unroll
            for (int ai = 0; ai < 2; ++ai)
#pragma unroll
                for (int m = 0; m < 4; ++m)
#pragma unroll
                    for (int bj = 0; bj < 2; ++bj) { const size_t off = (size_t)(row0 + ai * HALF + m * 16) * D_MODEL + col0 + bj * HALF;
                        const f32x4 v0 = acc[ai][bj][m][0], v1 = acc[ai][bj][m][1];
                        u32x4 w; w.x = cvt_pk_bf16(v0[0], v0[1]); w.y = cvt_pk_bf16(v0[2], v0[3]); w.z = cvt_pk_bf16(v1[0], v1[1]); w.w = cvt_pk_bf16(v1[2], v1[3]);
                        *(u32x4*)(merged + off) = w; }
        }
    }
};
struct EpiOut {
    static constexpr bool PERM = true;
    typedef NoPre Pre; __device__ __forceinline__ Pre pre(const Unit&, int, int, int, int) const { return Pre{}; }
    __device__ __forceinline__ bool keep(const Unit&) const { return false; }
    bf16_t* x; float* ps;
    __device__ __forceinline__ void operator()(f32x4 (&acc)[2][2][4][2], const Unit& u, int wr, int wc, int fr, int fq, const Pre&) const {
        const int row0 = u.pm * BM + wr * 64 + fr, col0 = u.pn * BM + wc * 32 + 8 * fq;
        const unsigned o0 = ((unsigned)row0 * (unsigned)D_MODEL + (unsigned)col0) * 2u;
        u32x4 b[2][4][2];
#pragma unroll
        for (int ai = 0; ai < 2; ++ai)
#pragma unroll
            for (int m = 0; m < 4; ++m)
#pragma unroll
                for (int bj = 0; bj < 2; ++bj) b[ai][m][bj] = *(const u32x4*)((const char*)x + (o0 + (unsigned)(((ai * HALF + m * 16) * D_MODEL + bj * HALF) * 2)));
        const int ln = fq * 16 + fr;
#pragma unroll
        for (int ai = 0; ai < 2; ++ai) {
#pragma unroll
            for (int m = 0; m < 4; ++m) { float ss = 0.f;
#pragma unroll
                for (int bj = 0; bj < 2; ++bj) { const u32x4 q = b[ai][m][bj]; const f32x4 v0 = acc[ai][bj][m][0], v1 = acc[ai][bj][m][1];
                    const float e0 = v0[0] + __uint_as_float(q.x << 16), e1 = v0[1] + __uint_as_float(q.x & 0xffff0000u), e2 = v0[2] + __uint_as_float(q.y << 16), e3 = v0[3] + __uint_as_float(q.y & 0xffff0000u);
                    const float e4 = v1[0] + __uint_as_float(q.z << 16), e5 = v1[1] + __uint_as_float(q.z & 0xffff0000u), e6 = v1[2] + __uint_as_float(q.w << 16), e7 = v1[3] + __uint_as_float(q.w & 0xffff0000u);
                    ss += (e0 * e0 + e1 * e1) + (e2 * e2 + e3 * e3) + (e4 * e4 + e5 * e5) + (e6 * e6 + e7 * e7);
                    u32x4 w; w.x = cvt_pk_bf16(e0, e1); w.y = cvt_pk_bf16(e2, e3); w.z = cvt_pk_bf16(e4, e5); w.w = cvt_pk_bf16(e6, e7);
                    *(u32x4*)((char*)x + (o0 + (unsigned)(((ai * HALF + m * 16) * D_MODEL + bj * HALF) * 2))) = w; }
                ss += __int_as_float(__builtin_amdgcn_ds_bpermute((ln ^ 16) * 4, __float_as_int(ss)));
                ss += __int_as_float(__builtin_amdgcn_ds_bpermute((ln ^ 32) * 4, __float_as_int(ss)));
                if (fq == 0) ps[(unsigned)(row0 + ai * HALF + m * 16) * 64u + (unsigned)(u.pn * 4 + wc)] = ss; }
        }
    }
};

template <class Epi, class Sched>
__device__ __forceinline__ void gemm_phase(LAS unsigned char* lds, const Gemm g, const Sched& S, const Epi& E, const int tid) {
    const int wid = __builtin_amdgcn_readfirstlane(tid >> 6), lane = tid & 63, wr = wid >> 2, wc = wid & 3, fr = lane & 15, fq = lane >> 4;
    int K = g.K; asm volatile("" : "+s"(K));
    const int nt = K / BK;
    unsigned voffA[2], voffB[2];
#pragma unroll
    for (int i = 0; i < 2; ++i) { int R, C; stage_rc(tid * 16 + i * 8192, R, C); const int Rb = Epi::PERM ? ((R & ~31) + perm32(R & 31)) : R;
        voffA[i] = (unsigned)(R * g.lda + C) * 2u; voffB[i] = (unsigned)(Rb * g.ldb + C) * 2u; }
    const size_t kstep = (size_t)(BK * 2);
    const size_t hstepA = (size_t)HALF * g.lda * 2, hstepB = (size_t)HALF * g.ldb * 2;
    const unsigned ldsw = (unsigned)wid * 1024u;
    const int aoff = lds_byte(wr * 64 + fr, fq * 8), boff = lds_byte(wc * 32 + fr, fq * 8);
#define PG8_SA(b, h) (((b) * 2 + (h)) * HTB)
#define PG8_SB(b, h) ((4 + (b) * 2 + (h)) * HTB)
#define PG8_STAGE(bufoff, gbase, voff) do { _Pragma("unroll") for (int _i = 0; _i < 2; ++_i) \
        __builtin_amdgcn_global_load_lds((const unsigned*)((const char*)(gbase) + (voff)[_i]), (LAS unsigned*)(lds + (bufoff) + ldsw + _i * 8192), 16, 0, 0); } while (0)
#define PG8_LDA(dst, b, h) do { _Pragma("unroll") for (int m = 0; m < 4; ++m) _Pragma("unroll") for (int k = 0; k < 2; ++k) dst[m][k] = *(const LAS bf16x8*)(lds + PG8_SA(b, h) + aoff + m * 2048 + k * 1024); } while (0)
#define PG8_LDB(dst, b, h) do { _Pragma("unroll") for (int n = 0; n < 2; ++n) _Pragma("unroll") for (int k = 0; k < 2; ++k) dst[n][k] = *(const LAS bf16x8*)(lds + PG8_SB(b, h) + boff + n * 2048 + k * 1024); } while (0)
#define PG8_MMA(ai, bj, At, Bt) do { __builtin_amdgcn_s_setprio(1); _Pragma("unroll") for (int m = 0; m < 4; ++m) _Pragma("unroll") for (int n = 0; n < 2; ++n) _Pragma("unroll") for (int k = 0; k < 2; ++k) \
        acc[ai][bj][m][n] = __builtin_amdgcn_mfma_f32_16x16x32_bf16(Bt[n][k], At[m][k], acc[ai][bj][m][n], 0, 0, 0); __builtin_amdgcn_s_setprio(0); } while (0)
#define PG8_WAIT_V(n) asm volatile("s_waitcnt vmcnt(" #n ")" ::: "memory")
#define PG8_WAIT_L(n) asm volatile("s_waitcnt lgkmcnt(" #n ")" ::: "memory")
#define PG8_BAR __builtin_amdgcn_s_barrier()
#define PG8_SCHED __builtin_amdgcn_sched_barrier(0)
    Unit cur, nxt; int ui = 0;
    if (!S.next(0, cur)) return;
    f32x4 acc[2][2][4][2];
#pragma unroll
    for (int a = 0; a < 2; ++a)
#pragma unroll
        for (int b = 0; b < 2; ++b)
#pragma unroll
            for (int m = 0; m < 4; ++m)
#pragma unroll
                for (int n = 0; n < 2; ++n) acc[a][b][m][n] = (f32x4){0.f, 0.f, 0.f, 0.f};
    bf16x8 At[4][2], B0[2][2], B1[2][2];
    typename Epi::Pre pre = E.pre(cur, wr, wc, fr, fq);
    const char* cA = (const char*)g.A + S.a_off(cur, g); const char* cB = (const char*)g.Bt + S.b_off(cur, g);
    PG8_STAGE(PG8_SB(0, 0), cB, voffB); PG8_STAGE(PG8_SA(0, 0), cA, voffA); PG8_STAGE(PG8_SB(0, 1), cB + hstepB, voffB); PG8_STAGE(PG8_SA(0, 1), cA + hstepA, voffA);
    if (wr == 1) PG8_BAR;
    PG8_WAIT_V(4); PG8_BAR;
    PG8_STAGE(PG8_SB(1, 0), cB + kstep, voffB); PG8_STAGE(PG8_SA(1, 0), cA + kstep, voffA); PG8_STAGE(PG8_SB(1, 1), cB + hstepB + kstep, voffB);
    PG8_WAIT_V(6); PG8_BAR;
    for (;;) {
        const bool has_next = S.next(ui + 1, nxt);
        const char* nA = has_next ? (const char*)g.A + S.a_off(nxt, g) : cA; const char* nB = has_next ? (const char*)g.Bt + S.b_off(nxt, g) : cB;
        for (int t = 0; t < nt; t += 2) {
            const bool last = (t == nt - 2);
            const char* a1 = cA + (size_t)(t + 1) * kstep;
            const char* a2 = last ? nA : cA + (size_t)(t + 2) * kstep; const char* b2 = last ? nB : cB + (size_t)(t + 2) * kstep;
            const char* a3 = a2 + kstep; const char* b3 = b2 + kstep;
            PG8_LDB(B0, 0, 0); PG8_SCHED; PG8_LDA(At, 0, 0); PG8_STAGE(PG8_SA(1, 1), a1 + hstepA, voffA);
            PG8_WAIT_L(8); PG8_BAR; PG8_WAIT_L(0); PG8_MMA(0, 0, At, B0); PG8_BAR; PG8_SCHED;
            PG8_LDB(B1, 0, 1); PG8_STAGE(PG8_SB(0, 0), b2, voffB);
            PG8_BAR; PG8_WAIT_L(0); PG8_MMA(0, 1, At, B1); PG8_BAR;
            PG8_LDA(At, 0, 1); PG8_STAGE(PG8_SA(0, 0), a2, voffA);
            PG8_BAR; PG8_WAIT_L(0); PG8_MMA(1, 0, At, B0); PG8_BAR; PG8_SCHED;
            PG8_STAGE(PG8_SB(0, 1), b2 + hstepB, voffB);
            PG8_WAIT_V(6); PG8_BAR; PG8_MMA(1, 1, At, B1); PG8_BAR;
            PG8_LDB(B0, 1, 0); PG8_SCHED; PG8_LDA(At, 1, 0); PG8_STAGE(PG8_SA(0, 1), a2 + hstepA, voffA);
            PG8_WAIT_L(8); PG8_BAR; PG8_WAIT_L(0); PG8_MMA(0, 0, At, B0); PG8_BAR; PG8_SCHED;
            PG8_LDB(B1, 1, 1); PG8_STAGE(PG8_SB(1, 0), b3, voffB);
            PG8_BAR; PG8_WAIT_L(0); PG8_MMA(0, 1, At, B1); PG8_BAR;
            PG8_LDA(At, 1, 1); PG8_STAGE(PG8_SA(1, 0), a3, voffA);
            PG8_BAR; PG8_WAIT_L(0); PG8_MMA(1, 0, At, B0); PG8_BAR; PG8_SCHED;
            PG8_STAGE(PG8_SB(1, 1), b3 + hstepB, voffB);
            PG8_WAIT_V(6); PG8_BAR; PG8_MMA(1, 1, At, B1); PG8_BAR;
        }
        E(acc, cur, wr, wc, fr, fq, pre);
        if (!has_next) break;
        if (!E.keep(cur))
#pragma unroll
        for (int a = 0; a < 2; ++a)
#pragma unroll
            for (int b = 0; b < 2; ++b)
#pragma unroll
                for (int m = 0; m < 4; ++m)
#pragma unroll
                    for (int n = 0; n < 2; ++n) acc[a][b][m][n] = (f32x4){0.f, 0.f, 0.f, 0.f};
        cur = nxt; cA = nA; cB = nB; ++ui; pre = E.pre(cur, wr, wc, fr, fq);
    }
    PG8_WAIT_V(0);
    if (wr == 0) PG8_BAR;
    PG8_BAR;
#undef PG8_SA
#undef PG8_SB
#undef PG8_STAGE
#undef PG8_LDA
#undef PG8_LDB
#undef PG8_MMA
#undef PG8_WAIT_V
#undef PG8_WAIT_L
#undef PG8_BAR
#undef PG8_SCHED
}
}

namespace att {
typedef short bf16x8 __attribute__((ext_vector_type(8)));
typedef short s16x4 __attribute__((ext_vector_type(4)));
typedef float f32x16 __attribute__((ext_vector_type(16)));
typedef float f32x4 __attribute__((ext_vector_type(4)));
typedef unsigned u32x4 __attribute__((ext_vector_type(4)));
constexpr int D = 128, KVBLK = 64, QBLK = 32, SHM_V = KVBLK * D * 2, SHM_K = KVBLK * D * 2;
constexpr float SCALE = 0.08838834764831845f, THR = 8.f;
#define KSWZ(row, colB) ((row) * 256 + ((colB) ^ (((row) & 7) << 4)))
#define SBAR() __builtin_amdgcn_sched_barrier(0)
__device__ __forceinline__ int v_st(int k, int c) { const int kk = (k & ~0xC) | ((k & 4) << 1) | ((k & 8) >> 1); return ((kk >> 3) * 4 + (c >> 5)) * 512 + ((kk & 7) * 32 + (c & 31)) * 2; }
__device__ __forceinline__ int v_rd_base(int lane) { return ((lane & 3) << 3) | (((lane >> 2) & 3) << 6) | (((lane >> 4) & 1) << 5) | (((lane >> 5) & 1) << 8); }
constexpr int v_rd_off(int d0, int ks, int half) { return d0 * 512 + ks * 4096 + half * 2048; }
__device__ __forceinline__ int crow(int r, int hi) { return (r & 3) + 8 * (r >> 2) + 4 * hi; }
__device__ __forceinline__ unsigned cvtpk(float lo, float hi) { return pg8::cvt_pk_bf16(lo, hi); }
__device__ __forceinline__ void mask_tile(f32x16& p0, f32x16& p1, int dq) {
    const float NEG = -__builtin_inff();
#pragma unroll
    for (int r = 0; r < 16; ++r) {
        const int c = (r & 3) + 8 * (r >> 2);
        if (dq - c < 0) p0[r] = NEG;
        if (dq - c - 32 < 0) p1[r] = NEG;
    }
}
__device__ __forceinline__ void partialSM(f32x16& p0, f32x16& p1, float& m_reg, float& mn, float& alpha) {
    float pmax = p0[0];
#pragma unroll
    for (int r = 1; r < 16; ++r) pmax = fmaxf(pmax, p0[r]);
#pragma unroll
    for (int r = 0; r < 16; ++r) pmax = fmaxf(pmax, p1[r]);
    { auto rr = __builtin_amdgcn_permlane32_swap(__float_as_uint(pmax), __float_as_uint(pmax), false, false);
      pmax = fmaxf(__uint_as_float(rr[0]), __uint_as_float(rr[1])); }
    constexpr float C2 = 1.4426950408889634f * SCALE;
    if (__builtin_expect(__all((pmax - m_reg) * SCALE <= THR), 1)) { mn = m_reg; alpha = 1.f; }
    else { mn = fmaxf(m_reg, pmax); alpha = __builtin_amdgcn_exp2f((m_reg - mn) * C2); m_reg = mn; }
    const float mnL = -mn * C2;
#pragma unroll
    for (int r = 0; r < 16; ++r) p0[r] = fmaf(p0[r], C2, mnL);
#pragma unroll
    for (int r = 0; r < 16; ++r) p1[r] = fmaf(p1[r], C2, mnL);
#pragma unroll
    for (int r = 0; r < 16; ++r) p0[r] = __builtin_amdgcn_exp2f(p0[r]);
}
__device__ __forceinline__ void finishSM(f32x16& p0, f32x16& p1, float alpha, float& l_reg, bf16x8& pa0, bf16x8& pa1, bf16x8& pa2, bf16x8& pa3) {
#pragma unroll
    for (int r = 0; r < 16; ++r) p1[r] = __builtin_amdgcn_exp2f(p1[r]);
    float ps = 0;
#pragma unroll
    for (int r = 0; r < 16; ++r) ps += p0[r];
#pragma unroll
    for (int r = 0; r < 16; ++r) ps += p1[r];
    { auto rr = __builtin_amdgcn_permlane32_swap(__float_as_uint(ps), __float_as_uint(ps), false, false);
      ps = __uint_as_float(rr[0]) + __uint_as_float(rr[1]); }
    l_reg = l_reg * alpha + ps;
#define PK4(P, B_, OUT) do { unsigned a0 = cvtpk(P[B_+0], P[B_+1]), a1 = cvtpk(P[B_+2], P[B_+3]);                          \
        unsigned b0 = cvtpk(P[B_+4], P[B_+5]), b1 = cvtpk(P[B_+6], P[B_+7]);                                             \
        auto r0 = __builtin_amdgcn_permlane32_swap(a0, b0, false, false); auto r1 = __builtin_amdgcn_permlane32_swap(a1, b1, false, false); \
        u32x4 w = {r0[0], r1[0], r0[1], r1[1]}; OUT = *reinterpret_cast<bf16x8*>(&w); } while (0)
    PK4(p0, 0, pa0); PK4(p0, 8, pa1); PK4(p1, 0, pa2); PK4(p1, 8, pa3);
#undef PK4
}
__device__ __forceinline__ void qkt(f32x16& p0, f32x16& p1, const LAS char* Kt, int r32, int hi, const bf16x8* qr) {
    p0 = f32x16{}; p1 = f32x16{};
    const LAS char* kb[4];
#pragma unroll
    for (int dd = 0; dd < 4; ++dd) kb[dd] = Kt + KSWZ(r32, (dd * 16 + hi * 8) * 2);
#pragma unroll
    for (int d0 = 0; d0 < 8; ++d0) { const LAS char* a = kb[d0 & 3] + (d0 >> 2) * 128;
        bf16x8 b0 = *reinterpret_cast<const LAS bf16x8*>(a);
        bf16x8 b1 = *reinterpret_cast<const LAS bf16x8*>(a + 32 * 256);
        p0 = __builtin_amdgcn_mfma_f32_32x32x16_bf16(b0, qr[d0], p0, 0, 0, 0);
        p1 = __builtin_amdgcn_mfma_f32_32x32x16_bf16(b1, qr[d0], p1, 0, 0, 0); }
}
__device__ __forceinline__ void pv_tile(f32x16* o, int vb0, bf16x8 pa0, bf16x8 pa1, bf16x8 pa2, bf16x8 pa3) {
#define TRRD(dst, off) asm volatile("ds_read_b64_tr_b16 %0, %1 offset:%2" : "=&v"(dst) : "v"(vb0), "i"(off) : "memory")
#define PV_D0(d0) do { s16x4 l0, l1, l2, l3, h0, h1, h2, h3; constexpr int b_ = v_rd_off(d0, 0, 0); \
        TRRD(l0, b_); TRRD(h0, b_ + 2048); TRRD(l1, b_ + 4096); TRRD(h1, b_ + 6144); TRRD(l2, b_ + 8192); TRRD(h2, b_ + 10240); TRRD(l3, b_ + 12288); TRRD(h3, b_ + 14336); \
        asm volatile("s_waitcnt lgkmcnt(0)" ::: "memory"); SBAR();   \
        o[d0] = __builtin_amdgcn_mfma_f32_32x32x16_bf16(pa0, (bf16x8){l0[0], l0[1], l0[2], l0[3], h0[0], h0[1], h0[2], h0[3]}, o[d0], 0, 0, 0);   \
        o[d0] = __builtin_amdgcn_mfma_f32_32x32x16_bf16(pa1, (bf16x8){l1[0], l1[1], l1[2], l1[3], h1[0], h1[1], h1[2], h1[3]}, o[d0], 0, 0, 0);   \
        o[d0] = __builtin_amdgcn_mfma_f32_32x32x16_bf16(pa2, (bf16x8){l2[0], l2[1], l2[2], l2[3], h2[0], h2[1], h2[2], h2[3]}, o[d0], 0, 0, 0);   \
        o[d0] = __builtin_amdgcn_mfma_f32_32x32x16_bf16(pa3, (bf16x8){l3[0], l3[1], l3[2], l3[3], h3[0], h3[1], h3[2], h3[3]}, o[d0], 0, 0, 0); } while (0)
    PV_D0(0); PV_D0(1); PV_D0(2); PV_D0(3);
#undef PV_D0
#undef TRRD
}
}


#define GAS __attribute__((address_space(1)))
typedef GAS unsigned gu32;
#define RLX_AGENT __ATOMIC_RELAXED, __HIP_MEMORY_SCOPE_AGENT
#define LDS_WAIT() asm volatile("s_waitcnt lgkmcnt(0)" ::: "memory")
#define VM_WAIT() asm volatile("s_waitcnt vmcnt(0)" ::: "memory")
typedef unsigned v4u __attribute__((ext_vector_type(4)));

#define XB_TMO      128
#define XB_XCNT(j)  (256  + 64 * (j))
#define XB_XSUB(j)  (1280 + 64 * (j))
#define XB_XGEN(j)  (2304 + 64 * (j))
#define XB_TOP      3328
#define XB_TOPGEN   3392
#define XCD_BAR_WORDS 3456
#define XB_SPIN_CAP (1u << 18)
__device__ __forceinline__ unsigned xb_ld(unsigned* p)              { return __hip_atomic_load(p, __ATOMIC_RELAXED, __HIP_MEMORY_SCOPE_AGENT); }
__device__ __forceinline__ unsigned xb_add(unsigned* p, unsigned v) { return __hip_atomic_fetch_add(p, v, __ATOMIC_RELAXED, __HIP_MEMORY_SCOPE_AGENT); }
__device__ __forceinline__ unsigned xb_xcc_id() { return (unsigned)__builtin_amdgcn_s_getreg((3 << 11) | 20) & 0xFu; }
#define XB_SPIN(cond, bar) do { unsigned _sp = 0; while (cond) { __builtin_amdgcn_s_sleep(1); \
    if ((++_sp & 255u) == 0u) { if (xb_ld(&(bar)[XB_TMO])) break; if (_sp > XB_SPIN_CAP) { atomicAdd(&(bar)[XB_TMO], 1u); break; } } } } while (0)
struct XcdBarrier { unsigned* bar; unsigned x; volatile LAS unsigned* st; };
__device__ __forceinline__ XcdBarrier xcd_barrier_post(unsigned* bar, volatile LAS unsigned* st) {
    XcdBarrier b; b.bar = bar; b.x = xb_xcc_id(); b.st = st;
    if (threadIdx.x == 0) (void)xb_add(&bar[XB_XCNT(b.x)], 1u);
    return b;
}
__device__ __forceinline__ void xcd_barrier_complete(unsigned* bar, unsigned x, unsigned& nloc, unsigned& nx) {
    const unsigned G = gridDim.x * gridDim.y * gridDim.z;
    unsigned sum, cnt, mine, sp = 0u;
    for (;;) {
        sum = 0u; cnt = 0u; mine = 0u;
#pragma unroll
        for (unsigned j = 0; j < 16; ++j) { const unsigned c = xb_ld(&bar[XB_XCNT(j)]); sum += c; cnt += (c > 0u) ? 1u : 0u; mine = (j == x) ? c : mine; }
        if (sum == G) break;
        __builtin_amdgcn_s_sleep(1);
        if ((++sp & 255u) == 0u) { if (xb_ld(&bar[XB_TMO])) break; if (sp > XB_SPIN_CAP) { atomicAdd(&bar[XB_TMO], 1u); break; } }
    }
    nloc = mine > 0u ? mine : 1u; nx = cnt > 0u ? cnt : 1u;
}
__device__ __forceinline__ void xcd_barrier(const XcdBarrier& b) {
    asm volatile("s_waitcnt vmcnt(0)" ::: "memory");
    __syncthreads();
    if (threadIdx.x == 0) {
        unsigned* bar = b.bar;
        __builtin_amdgcn_s_waitcnt(0);
        unsigned nloc = b.st[0], nx = b.st[1];
        if (nloc == 0u) { xcd_barrier_complete(bar, b.x, nloc, nx); b.st[0] = nloc; b.st[1] = nx; }
        const unsigned old = xb_add(&bar[XB_XSUB(b.x)], 1u);
        const unsigned gen = old / nloc;
        if (old + 1u == (gen + 1u) * nloc) {
            __builtin_amdgcn_fence(__ATOMIC_RELEASE, "agent");
            asm volatile("s_waitcnt vmcnt(0)" ::: "memory");
            const unsigned og = xb_add(&bar[XB_TOP], 1u);
            const unsigned tg = og / nx;
            if (og + 1u == (tg + 1u) * nx) xb_add(&bar[XB_TOPGEN], 1u);
            else XB_SPIN(xb_ld(&bar[XB_TOPGEN]) == tg, bar);
            __builtin_amdgcn_fence(__ATOMIC_ACQUIRE, "agent");
            xb_add(&bar[XB_XGEN(b.x)], 1u);
            asm volatile("s_waitcnt vmcnt(0)" ::: "memory");
        } else {
            XB_SPIN(xb_ld(&bar[XB_XGEN(b.x)]) == gen, bar);
            __builtin_amdgcn_fence(__ATOMIC_ACQUIRE, "agent");
            asm volatile("s_waitcnt vmcnt(0)" ::: "memory");
        }
    }
    __syncthreads();
}

constexpr int PH_PRO = 0, PH_PER_LAYER = 8, PH_NORM = 0, PH_INPROJ = 1, PH_M1 = 2, PH_M2 = 3, PH_M3 = 4, PH_M4 = 5, PH_BRANCH = 6, PH_OUT = 7;
constexpr int PH_FINAL = 1 + DEPTH * PH_PER_LAYER, PH_COUNT = PH_FINAL + 1;
constexpr int RING_OFF = 0, RING_BYTES = 131072, LDSCTL_OFF = 147456, MISC_OFF = LDSCTL_OFF + 320, LDS_BYTES = 151552;
constexpr int NWAVES = 8;
constexpr int CW_BAR = 4096;
constexpr int MAX_BAR_REGIONS = 64;
static_assert((CW_BAR + MAX_BAR_REGIONS * XCD_BAR_WORDS) * 4 <= (1 << 20), "CTL region");
static_assert(MISC_OFF + 128 <= LDS_BYTES, "LDS map");

struct Args { const float* in[12]; float* out; unsigned char* ws; int ph_lo, ph_hi, li, pad; };
typedef const __attribute__((address_space(4))) Args* ArgsP;


__device__ __forceinline__ void p0_item_load(const float* W, int ldw, int nblk, int item, int lane, bool mapped, float (&tv)[32]) {
    const int kb = item / nblk, nb = item % nblk, k0 = 64 * kb, n0 = 32 * nb;
    const int nn = n0 + (lane & 31); const int sc = mapped ? inproj_src_col(nn) : nn; const int scc = sc >= 0 ? sc : 0;
#pragma unroll
    for (int i = 0; i < 32; ++i) { const int kk = 2 * i + (lane >> 5); const float v = W[(size_t)(k0 + kk) * ldw + scc]; tv[i] = sc >= 0 ? v : 0.f; }
}
__device__ __forceinline__ void p0_item_store(int K, int nblk, bf16_t* WT, LAS float* scr, int item, int lane, const float (&tv)[32], const float* kscale) {
    const int kb = item / nblk, nb = item % nblk, k0 = 64 * kb, n0 = 32 * nb;
    float4 ks0 = make_float4(1.f, 1.f, 1.f, 1.f), ks1 = ks0;
    if (kscale) { ks0 = *(const float4*)(kscale + k0 + 8 * (lane & 7)); ks1 = *(const float4*)(kscale + k0 + 8 * (lane & 7) + 4); }
#pragma unroll
    for (int i = 0; i < 32; ++i) { const int kk = 2 * i + (lane >> 5); scr[kk * 33 + (lane & 31)] = tv[i]; }
    LDS_WAIT(); asm volatile("" ::: "memory");
    const int c = lane & 7;
#pragma unroll
    for (int j = 0; j < 4; ++j) { const int n = (lane >> 3) + 8 * j; const LAS float* s = scr + (8 * c) * 33 + n;
        v4u o; o.x = pk2(s[0 * 33] * ks0.x, s[1 * 33] * ks0.y); o.y = pk2(s[2 * 33] * ks0.z, s[3 * 33] * ks0.w); o.z = pk2(s[4 * 33] * ks1.x, s[5 * 33] * ks1.y); o.w = pk2(s[6 * 33] * ks1.z, s[7 * 33] * ks1.w);
        *(v4u*)(WT + (size_t)(n0 + n) * K + k0 + 8 * c) = o; }
    LDS_WAIT(); asm volatile("" ::: "memory");
}
template <bool OUT_F32> __device__ __forceinline__ void rms_row(const float* xrow, const float* w, bf16_t* ob, float* of, bf16_t* xcopy, int lane) {
    const float4* xr = (const float4*)xrow;
    float4 v[16]; float s = 0.f;
#pragma unroll
    for (int j = 0; j < 16; ++j) { v[j] = xr[j * 64 + lane]; s += v[j].x * v[j].x + v[j].y * v[j].y + v[j].z * v[j].z + v[j].w * v[j].w; }
    if (xcopy) {
#pragma unroll
        for (int j = 0; j < 16; ++j) ((uint2*)xcopy)[j * 64 + lane] = make_uint2(pk2(v[j].x, v[j].y), pk2(v[j].z, v[j].w)); }
    s = wave_sum(s);
    const float r = rsqrtf(s * (1.0f / D_MODEL) + 1e-6f);
#pragma unroll
    for (int j = 0; j < 16; ++j) { const float4 ww = ((const float4*)w)[j * 64 + lane];
        const float a = v[j].x * r * ww.x, b = v[j].y * r * ww.y, c = v[j].z * r * ww.z, d = v[j].w * r * ww.w;
        if (OUT_F32) ((float4*)of)[j * 64 + lane] = make_float4(a, b, c, d);
        else ((uint2*)ob)[j * 64 + lane] = make_uint2(pk2(a, b), pk2(c, d)); }
}
__device__ __forceinline__ void rstd_row_f(const float* xrow, bf16_t* xcopy, float* rs, int lane) {
    const float4* xr = (const float4*)xrow;
    float4 v[16]; float s = 0.f;
#pragma unroll
    for (int j = 0; j < 16; ++j) { v[j] = xr[j * 64 + lane]; s += v[j].x * v[j].x + v[j].y * v[j].y + v[j].z * v[j].z + v[j].w * v[j].w; }
#pragma unroll
    for (int j = 0; j < 16; ++j) ((uint2*)xcopy)[j * 64 + lane] = make_uint2(pk2(v[j].x, v[j].y), pk2(v[j].z, v[j].w));
    s = wave_sum(s);
    if (lane == 0) *rs = rsqrtf(s * (1.0f / D_MODEL) + 1e-6f);
}
__device__ __forceinline__ void rstd_row_b(const bf16_t* xrow, float* rs, int lane) {
    v4u q[8]; float s = 0.f;
#pragma unroll
    for (int j = 0; j < 8; ++j) q[j] = ((const v4u*)xrow)[j * 64 + lane];
#pragma unroll
    for (int j = 0; j < 8; ++j) { const float a0 = __uint_as_float(q[j].x << 16), a1 = __uint_as_float(q[j].x & 0xffff0000u), a2 = __uint_as_float(q[j].y << 16), a3 = __uint_as_float(q[j].y & 0xffff0000u);
        const float a4 = __uint_as_float(q[j].z << 16), a5 = __uint_as_float(q[j].z & 0xffff0000u), a6 = __uint_as_float(q[j].w << 16), a7 = __uint_as_float(q[j].w & 0xffff0000u);
        s += (a0 * a0 + a1 * a1) + (a2 * a2 + a3 * a3) + (a4 * a4 + a5 * a5) + (a6 * a6 + a7 * a7); }
    s = wave_sum(s);
    if (lane == 0) *rs = rsqrtf(s * (1.0f / D_MODEL) + 1e-6f);
}
__device__ __forceinline__ void rstd_row_b2(const bf16_t* xa, const bf16_t* xb, float* rsa, float* rsb, int lane) {
    v4u qa[8], qb[8]; float sa = 0.f, sb = 0.f;
#pragma unroll
    for (int j = 0; j < 8; ++j) { qa[j] = ((const v4u*)xa)[j * 64 + lane]; qb[j] = ((const v4u*)xb)[j * 64 + lane]; }
#pragma unroll
    for (int j = 0; j < 8; ++j) {
        { const float a0 = __uint_as_float(qa[j].x << 16), a1 = __uint_as_float(qa[j].x & 0xffff0000u), a2 = __uint_as_float(qa[j].y << 16), a3 = __uint_as_float(qa[j].y & 0xffff0000u);
          const float a4 = __uint_as_float(qa[j].z << 16), a5 = __uint_as_float(qa[j].z & 0xffff0000u), a6 = __uint_as_float(qa[j].w << 16), a7 = __uint_as_float(qa[j].w & 0xffff0000u);
          sa += (a0 * a0 + a1 * a1) + (a2 * a2 + a3 * a3) + (a4 * a4 + a5 * a5) + (a6 * a6 + a7 * a7); }
        { const float a0 = __uint_as_float(qb[j].x << 16), a1 = __uint_as_float(qb[j].x & 0xffff0000u), a2 = __uint_as_float(qb[j].y << 16), a3 = __uint_as_float(qb[j].y & 0xffff0000u);
          const float a4 = __uint_as_float(qb[j].z << 16), a5 = __uint_as_float(qb[j].z & 0xffff0000u), a6 = __uint_as_float(qb[j].w << 16), a7 = __uint_as_float(qb[j].w & 0xffff0000u);
          sb += (a0 * a0 + a1 * a1) + (a2 * a2 + a3 * a3) + (a4 * a4 + a5 * a5) + (a6 * a6 + a7 * a7); } }
    sa = wave_sum(sa); sb = wave_sum(sb);
    if (lane == 0) { *rsa = rsqrtf(sa * (1.0f / D_MODEL) + 1e-6f); *rsb = rsqrtf(sb * (1.0f / D_MODEL) + 1e-6f); }
}
template <bool OUT_F32> __device__ __forceinline__ void rms_row_b(const bf16_t* xrow, const float* w, bf16_t* ob, float* of, int lane) {
    v4u q[8]; float s = 0.f;
#pragma unroll
    for (int j = 0; j < 8; ++j) q[j] = ((const v4u*)xrow)[j * 64 + lane];
#pragma unroll
    for (int j = 0; j < 8; ++j) { const float a0 = __uint_as_float(q[j].x << 16), a1 = __uint_as_float(q[j].x & 0xffff0000u), a2 = __uint_as_float(q[j].y << 16), a3 = __uint_as_float(q[j].y & 0xffff0000u);
        const float a4 = __uint_as_float(q[j].z << 16), a5 = __uint_as_float(q[j].z & 0xffff0000u), a6 = __uint_as_float(q[j].w << 16), a7 = __uint_as_float(q[j].w & 0xffff0000u);
        s += (a0 * a0 + a1 * a1) + (a2 * a2 + a3 * a3) + (a4 * a4 + a5 * a5) + (a6 * a6 + a7 * a7); }
    s = wave_sum(s);
    const float r = rsqrtf(s * (1.0f / D_MODEL) + 1e-6f);
#pragma unroll
    for (int j = 0; j < 8; ++j) { const float4 w0 = ((const float4*)w)[(j * 64 + lane) * 2], w1 = ((const float4*)w)[(j * 64 + lane) * 2 + 1];
        const float a0 = __uint_as_float(q[j].x << 16) * r * w0.x, a1 = __uint_as_float(q[j].x & 0xffff0000u) * r * w0.y, a2 = __uint_as_float(q[j].y << 16) * r * w0.z, a3 = __uint_as_float(q[j].y & 0xffff0000u) * r * w0.w;
        const float a4 = __uint_as_float(q[j].z << 16) * r * w1.x, a5 = __uint_as_float(q[j].z & 0xffff0000u) * r * w1.y, a6 = __uint_as_float(q[j].w << 16) * r * w1.z, a7 = __uint_as_float(q[j].w & 0xffff0000u) * r * w1.w;
        if (OUT_F32) { ((float4*)of)[(j * 64 + lane) * 2] = make_float4(a0, a1, a2, a3); ((float4*)of)[(j * 64 + lane) * 2 + 1] = make_float4(a4, a5, a6, a7); }
        else { v4u o; o.x = pk2(a0, a1); o.y = pk2(a2, a3); o.z = pk2(a4, a5); o.w = pk2(a6, a7); ((v4u*)ob)[j * 64 + lane] = o; } }
}


constexpr size_t WS_BSC = WS_CF + (size_t)BATCH * 8 * SEQ * 4;
static __device__ __forceinline__ void fox_prep(ArgsP ap, int l, LAS unsigned char* lds, int tidv, int vcu) {
    if (vcu >= BATCH * 8) return;
    const int bh = vcu, b = bh >> 3, h = bh & 7;
    const float* UM = (const float*)(ap->ws + WS_UM); float* CF = (float*)(ap->ws + WS_CF); float* BSC = (float*)(ap->ws + WS_BSC);
    const float bias = ap->in[3][l * 8 + h];
    LAS double* part = (LAS double*)lds;
    double loc[16]; double s = 0.0;
#pragma unroll
    for (int j = 0; j < 16; ++j) { const int t = tidv * 16 + j; const float x = UM[((size_t)b * SEQ + t) * LDM + MC_CF + h] + bias;
        const float ls = fminf(x, 0.f) - log1pf(expf(-fabsf(x))); s += (double)ls; loc[j] = s; }
    part[tidv] = s; __syncthreads();
    double off = 0.0; for (int i = 0; i < tidv; ++i) off += part[i];
#pragma unroll
    for (int j = 0; j < 16; ++j) { const double c = off + loc[j]; CF[(size_t)bh * SEQ + tidv * 16 + j] = (float)c; BSC[(size_t)bh * SEQ + tidv * 16 + j] = (float)(-c * 11.313708498984761); }
    __syncthreads();
}
static __device__ __forceinline__ void fox_attn_unit(const bf16_t* U, const float* bsc  , const float* cf  , float thr, bf16_t* Y, int b, int h, int qb, LAS unsigned char* ldsb, int tidv) {
    using namespace att;
    const int wid = __builtin_amdgcn_readfirstlane(tidv >> 6), lane = tidv & 63, r32 = lane & 31, hi = lane >> 5;
    const int P0 = qb * 256; const size_t brow = (size_t)b * SEQ;
    int j_lo;
    {   const float cp0 = cf[P0]; const int jd = P0 / KVBLK;
        const bool k0 = (lane <= jd) && (cp0 - cf[lane * KVBLK + KVBLK - 1] > -thr), k1 = (lane + 64 <= jd) && (cp0 - cf[(lane + 64) * KVBLK + KVBLK - 1] > -thr);
        const unsigned long long b0 = __ballot(k0), b1 = __ballot(k1);
        j_lo = b0 ? (int)__builtin_ctzll(b0) : (b1 ? 64 + (int)__builtin_ctzll(b1) : jd);
        j_lo = __builtin_amdgcn_readfirstlane(j_lo < jd ? j_lo : jd); }
    const int j_hi = (P0 + 255) / KVBLK + 1, NT = j_hi - j_lo;
    const int qlo = P0 + wid * QBLK, qm = qlo + r32 - 4 * hi;
    LAS char* V_lds = (LAS char*)ldsb; LAS char* K_lds = (LAS char*)ldsb + 2 * SHM_V;
    LAS float* wsl = (LAS float*)(ldsb + 2 * SHM_V + 2 * SHM_K) + wid * 64; LAS float* li_l = wsl; LAS float* al_l = wsl + 32;
    float m_reg = -1e30f, l_reg = 0; f32x16 o[4] = {};
    const int sr = tidv >> 4, sc = (tidv & 15) * 8, vst0 = v_st(sr, sc), vst1 = v_st(32 + sr, sc), kws = KSWZ(sr, sc * 2);
    const int vbase = (int)(uintptr_t)V_lds + v_rd_base(lane);
    const bf16_t* Kg = U + brow * LDU + C_CK + h * 128 + sc; const bf16_t* Vg = U + brow * LDU + C_CV + h * 128 + sc;
    bf16x8 qr[8];
#pragma unroll
    for (int d0 = 0; d0 < 8; ++d0) qr[d0] = *(const bf16x8*)(U + (brow + qlo + r32) * LDU + C_CQ + h * 128 + d0 * 16 + hi * 8);
    bf16x8 st_k0, st_k1, st_v0, st_v1;
#define FX_SLOAD(kb) do { st_k0 = *(const bf16x8*)(Kg + (size_t)((kb) + sr) * LDU); st_k1 = *(const bf16x8*)(Kg + (size_t)((kb) + 32 + sr) * LDU); \
                          st_v0 = *(const bf16x8*)(Vg + (size_t)((kb) + sr) * LDU); st_v1 = *(const bf16x8*)(Vg + (size_t)((kb) + 32 + sr) * LDU); } while (0)
#define FX_SWRITE(bf) do { *(LAS bf16x8*)(K_lds + (bf) * SHM_K + kws) = st_k0; *(LAS bf16x8*)(K_lds + (bf) * SHM_K + kws + 32 * 256) = st_k1; \
                           *(LAS bf16x8*)(V_lds + (bf) * SHM_V + vst0) = st_v0; *(LAS bf16x8*)(V_lds + (bf) * SHM_V + vst1) = st_v1; } while (0)
    FX_SLOAD(j_lo * KVBLK); VM_WAIT(); FX_SWRITE(0);
    __syncthreads();
    for (int t = 0; t < NT; ++t) {
        const int buf = t & 1, kb = (j_lo + t) * KVBLK;
        if (t + 1 < NT) FX_SLOAD(kb + KVBLK);
        f32x16 p0, p1;
        qkt(p0, p1, K_lds + buf * SHM_K, r32, hi, qr);
        {   const float4* bp = (const float4*)(bsc + kb);
#pragma unroll
            for (int g = 0; g < 4; ++g) { const float4 b0 = bp[2 * g + hi], b1 = bp[8 + 2 * g + hi];
                p0[4 * g + 0] += b0.x; p0[4 * g + 1] += b0.y; p0[4 * g + 2] += b0.z; p0[4 * g + 3] += b0.w;
                p1[4 * g + 0] += b1.x; p1[4 * g + 1] += b1.y; p1[4 * g + 2] += b1.z; p1[4 * g + 3] += b1.w; } }
        if (kb + KVBLK - 1 > qlo) mask_tile(p0, p1, qm - kb);
        float mn, alpha; bf16x8 pa0, pa1, pa2, pa3;
        partialSM(p0, p1, m_reg, mn, alpha);
        if (__any(alpha < 1.f)) { if (hi == 0) al_l[r32] = alpha; asm volatile("s_waitcnt lgkmcnt(0)" ::: "memory");
#pragma unroll
            for (int d_ = 0; d_ < 4; ++d_)
#pragma unroll
                for (int r = 0; r < 16; ++r) o[d_][r] *= al_l[crow(r, hi)]; }
        finishSM(p0, p1, alpha, l_reg, pa0, pa1, pa2, pa3); SBAR();
        pv_tile(o, vbase + buf * SHM_V, pa0, pa1, pa2, pa3);
        if (t + 1 < NT) { VM_WAIT(); FX_SWRITE(buf ^ 1); }
        __syncthreads();
    }
#undef FX_SLOAD
#undef FX_SWRITE
    if (hi == 0) li_l[r32] = l_reg; asm volatile("s_waitcnt lgkmcnt(0)" ::: "memory");
#pragma unroll
    for (int rh = 0; rh < 2; ++rh) {
        unsigned short gv[8][4];
#pragma unroll
        for (int r8 = 0; r8 < 8; ++r8)
#pragma unroll
            for (int d0 = 0; d0 < 4; ++d0) gv[r8][d0] = U[(brow + qlo + crow(rh * 8 + r8, hi)) * LDU + C_CG + h * 128 + d0 * 32 + r32];
#pragma unroll
        for (int r8 = 0; r8 < 8; ++r8) { const int r = rh * 8 + r8, orow = crow(r, hi); const float rl = __builtin_amdgcn_rcpf(li_l[orow]);
            const size_t grow = brow + qlo + orow;
#pragma unroll
            for (int d0 = 0; d0 < 4; ++d0) { const float y = o[d0][r] * rl * siluf_(bf2f(gv[r8][d0])); const float yn = dpp_f<0xB1>(y);
                if ((r32 & 1) == 0) *(unsigned*)(Y + grow * D_MODEL + 2 * 1024 + h * 128 + d0 * 32 + r32) = cvtpk(y, yn); } }
    }
    __syncthreads();
}
static __device__ __forceinline__ void fox_attn_phase(ArgsP ap, int l, LAS unsigned char* lds, int tidv, int vcu) {
    const bf16_t* U = (const bf16_t*)(ap->ws + WS_U); const float* BSC = (const float*)(ap->ws + WS_BSC); bf16_t* Y = (bf16_t*)(ap->ws + WS_Y);
    const float* CF = (const float*)(ap->ws + WS_CF); const float* nslot = (const float*)((const unsigned*)ap->ws + CW_FOXN) + l * 32;
    for (int pi = vcu; pi < BATCH * 8 * 16; pi += (int)gridDim.x) {
        const int bh = pi >> 4, x = pi & 15;
        const float bound = att::SCALE * sqrtf(nslot[bh * 2] * nslot[bh * 2 + 1]) * 1.001f;
        const float thr = 2.f * bound + 105.f;
        fox_attn_unit(U, BSC + (size_t)bh * SEQ, CF + (size_t)bh * SEQ, thr, Y, bh >> 3, bh & 7, 31 - x, lds, tidv);
        fox_attn_unit(U, BSC + (size_t)bh * SEQ, CF + (size_t)bh * SEQ, thr, Y, bh >> 3, bh & 7, x, lds, tidv);
    }
}

constexpr int HG_NCH = SEQ / 32;
namespace hg {
using att::bf16x8; using att::f32x16; using att::s16x4; using att::u32x4;
template <int CTRL, int ROWMASK> __device__ __forceinline__ float dppz(float v) { return __int_as_float(__builtin_amdgcn_update_dpp(0, __float_as_int(v), CTRL, ROWMASK, 0xf, true)); }
__device__ __forceinline__ float scan32(float v) {
    v += dppz<0x111, 0xf>(v); v += dppz<0x112, 0xf>(v); v += dppz<0x114, 0xf>(v); v += dppz<0x118, 0xf>(v);
    v += __int_as_float(__builtin_amdgcn_update_dpp(0, __float_as_int(v), 0x142, 0xA, 0xf, false));
    return v;
}
__device__ __forceinline__ float pick_lane(float v, int lane_lo, int hi) {
    const float a = __int_as_float(__builtin_amdgcn_readlane(__float_as_int(v), lane_lo)), b = __int_as_float(__builtin_amdgcn_readlane(__float_as_int(v), lane_lo + 32));
    return hi ? b : a;
}
__device__ __forceinline__ float cl80(float x) { return fminf(fmaxf(x, -115.4156f), 115.4156f); }
__device__ __forceinline__ bf16x8 pack8f(const float (&v)[8]) { u32x4 w = {att::cvtpk(v[0], v[1]), att::cvtpk(v[2], v[3]), att::cvtpk(v[4], v[5]), att::cvtpk(v[6], v[7])}; return *reinterpret_cast<bf16x8*>(&w); }
__device__ __forceinline__ void unpack8(const bf16x8 x, float (&v)[8]) { const u32x4 w = *reinterpret_cast<const u32x4*>(&x);
    v[0] = __uint_as_float(w.x << 16); v[1] = __uint_as_float(w.x & 0xffff0000u); v[2] = __uint_as_float(w.y << 16); v[3] = __uint_as_float(w.y & 0xffff0000u);
    v[4] = __uint_as_float(w.z << 16); v[5] = __uint_as_float(w.z & 0xffff0000u); v[6] = __uint_as_float(w.w << 16); v[7] = __uint_as_float(w.w & 0xffff0000u); }
__device__ __forceinline__ void stage_vtile(const bf16_t* g, size_t ld, LAS char* tile, int lane) {
    bf16x8 t[8];
#pragma unroll
    for (int i = 0; i < 8; ++i) t[i] = *(const bf16x8*)(g + (size_t)(i * 4 + (lane >> 4)) * ld + (lane & 15) * 8);
#pragma unroll
    for (int i = 0; i < 8; ++i) *(LAS bf16x8*)(tile + att::v_st(i * 4 + (lane >> 4), (lane & 15) * 8)) = t[i];
}
#define HG_TRRD(dst, base, off) asm volatile("ds_read_b64_tr_b16 %0, %1 offset:%2" : "=&v"(dst) : "v"(base), "i"(off) : "memory")
#define HG_FRAG2(f0, f1, base, cb) do { s16x4 l0_, h0_, l1_, h1_; HG_TRRD(l0_, base, (cb) * 512); HG_TRRD(h0_, base, (cb) * 512 + 2048); HG_TRRD(l1_, base, (cb) * 512 + 4096); HG_TRRD(h1_, base, (cb) * 512 + 6144); \
        asm volatile("s_waitcnt lgkmcnt(0)" ::: "memory"); __builtin_amdgcn_sched_barrier(0); \
        f0 = (bf16x8){l0_[0], l0_[1], l0_[2], l0_[3], h0_[0], h0_[1], h0_[2], h0_[3]}; f1 = (bf16x8){l1_[0], l1_[1], l1_[2], l1_[3], h1_[0], h1_[1], h1_[2], h1_[3]}; } while (0)

static __device__ __forceinline__ void h1_chunk(const bf16_t* U, const float* lb, bf16_t* UT, float* Dc, int cu, LAS char* wl, int lane) {
    const int r32 = lane & 31, hi = lane >> 5;
    const int bh = cu / HG_NCH, c = cu % HG_NCH, b = bh >> 3, h = bh & 7;
    const size_t row0 = (size_t)b * SEQ + c * 32;
    LAS char* Vt = wl; LAS char* Kt = wl + 8192;
    stage_vtile(U + row0 * LDU + C_DI + h * 128, LDU, Vt, lane);
    const bf16_t* fr = U + (row0 + r32) * LDU + C_DF + h * 128 + hi * 8;
#pragma unroll
    for (int d0 = 0; d0 < 8; ++d0) {
        float x[8], lbv[8], kk[8], bc[8], kt[8];
        unpack8(*(const bf16x8*)(fr + d0 * 16), x);
        { const float4 a = *(const float4*)(lb + h * 128 + d0 * 16 + hi * 8), bq = *(const float4*)(lb + h * 128 + d0 * 16 + hi * 8 + 4);
          lbv[0] = a.x; lbv[1] = a.y; lbv[2] = a.z; lbv[3] = a.w; lbv[4] = bq.x; lbv[5] = bq.y; lbv[6] = bq.z; lbv[7] = bq.w; }
#pragma unroll
        for (int j = 0; j < 8; ++j) { const float f = lbv[j] + (1.0f - lbv[j]) * sigmoidf_(x[j]); kk[j] = 1.0f - f; bc[j] = scan32(__builtin_amdgcn_logf(f)); }
        float dl[8];
#pragma unroll
        for (int j = 0; j < 8; ++j) { const float last = pick_lane(bc[j], 31, hi); kt[j] = kk[j] * __builtin_amdgcn_exp2f(last - bc[j]); dl[j] = __builtin_amdgcn_exp2f(last); }
        *(LAS bf16x8*)(Kt + att::v_st(r32, d0 * 16 + hi * 8)) = pack8f(kt);
        if (r32 == 0) { float* dp = Dc + (size_t)cu * 128 + d0 * 16 + hi * 8; *(float4*)dp = make_float4(dl[0], dl[1], dl[2], dl[3]); *(float4*)(dp + 4) = make_float4(dl[4], dl[5], dl[6], dl[7]); }
    }
    asm volatile("s_waitcnt lgkmcnt(0)" ::: "memory");
    const int vb = (int)(uintptr_t)Vt + att::v_rd_base(lane), kb = (int)(uintptr_t)Kt + att::v_rd_base(lane);
    bf16x8 kf[4][2];
#pragma unroll
    for (int dblk = 0; dblk < 4; ++dblk) HG_FRAG2(kf[dblk][0], kf[dblk][1], kb, dblk);
    bf16_t* out = UT + (size_t)cu * 16384;
#pragma unroll
    for (int e0 = 0; e0 < 4; ++e0) {
        bf16x8 v0, v1; HG_FRAG2(v0, v1, vb, e0);
#pragma unroll
        for (int dblk = 0; dblk < 4; ++dblk) {
            f32x16 acc = {};
            acc = __builtin_amdgcn_mfma_f32_32x32x16_bf16(v0, kf[dblk][0], acc, 0, 0, 0);
            acc = __builtin_amdgcn_mfma_f32_32x32x16_bf16(v1, kf[dblk][1], acc, 0, 0, 0);
#pragma unroll
            for (int r = 0; r < 16; ++r) { const float v = acc[r], vn = dpp_f<0xB1>(v);
                if ((r32 & 1) == 0) *(unsigned*)(out + (size_t)(e0 * 32 + att::crow(r, hi)) * 128 + dblk * 32 + r32) = att::cvtpk(v, vn); }
        }
    }
}
static __device__ __forceinline__ void h3_chunk(const bf16_t* U, const float* lb, const bf16_t* ST, const float* nw, bf16_t* Y, int cu, LAS char* wl, int lane) {
    const int r32 = lane & 31, hi = lane >> 5;
    const int bh = cu / HG_NCH, c = cu % HG_NCH, b = bh >> 3, h = bh & 7;
    const size_t row0 = (size_t)b * SEQ + c * 32;
    LAS char* Vt = wl;
    stage_vtile(U + row0 * LDU + C_DI + h * 128, LDU, Vt, lane);
    const bf16_t* fr = U + (row0 + r32) * LDU + C_DF + h * 128 + hi * 8; const bf16_t* qrp = U + (row0 + r32) * LDU + C_DQ + h * 128 + hi * 8;
    bf16x8 qi[8], qd[8], kd[8];
#pragma unroll
    for (int d0 = 0; d0 < 8; ++d0) {
        float x[8], q[8], lbv[8], a[8], bq_[8], cc[8];
        unpack8(*(const bf16x8*)(fr + d0 * 16), x); unpack8(*(const bf16x8*)(qrp + d0 * 16), q);
        { const float4 a4 = *(const float4*)(lb + h * 128 + d0 * 16 + hi * 8), b4 = *(const float4*)(lb + h * 128 + d0 * 16 + hi * 8 + 4);
          lbv[0] = a4.x; lbv[1] = a4.y; lbv[2] = a4.z; lbv[3] = a4.w; lbv[4] = b4.x; lbv[5] = b4.y; lbv[6] = b4.z; lbv[7] = b4.w; }
#pragma unroll
        for (int j = 0; j < 8; ++j) { const float f = lbv[j] + (1.0f - lbv[j]) * sigmoidf_(x[j]); const float bc = scan32(__builtin_amdgcn_logf(f)); const float mid = pick_lane(bc, 15, hi);
            a[j] = q[j] * __builtin_amdgcn_exp2f(bc); bq_[j] = q[j] * __builtin_amdgcn_exp2f(cl80(bc - mid)); cc[j] = (1.0f - f) * __builtin_amdgcn_exp2f(cl80(mid - bc)); }
        qi[d0] = pack8f(a); qd[d0] = pack8f(bq_); kd[d0] = pack8f(cc);
    }
    f32x16 p = {};
#pragma unroll
    for (int d0 = 0; d0 < 8; ++d0) p = __builtin_amdgcn_mfma_f32_32x32x16_bf16(kd[d0], qd[d0], p, 0, 0, 0);
#pragma unroll
    for (int r = 0; r < 16; ++r) if (att::crow(r, hi) > r32) p[r] = 0.f;
    bf16x8 pa0, pa1;
#define HG_PK4(P, B_, OUT) do { unsigned a0 = att::cvtpk(P[B_+0], P[B_+1]), a1 = att::cvtpk(P[B_+2], P[B_+3]); unsigned b0 = att::cvtpk(P[B_+4], P[B_+5]), b1 = att::cvtpk(P[B_+6], P[B_+7]); \
        auto r0 = __builtin_amdgcn_permlane32_swap(a0, b0, false, false); auto r1 = __builtin_amdgcn_permlane32_swap(a1, b1, false, false); \
        u32x4 w = {r0[0], r1[0], r0[1], r1[1]}; OUT = *reinterpret_cast<bf16x8*>(&w); } while (0)
    HG_PK4(p, 0, pa0); HG_PK4(p, 8, pa1);
#undef HG_PK4
    asm volatile("s_waitcnt lgkmcnt(0)" ::: "memory");
    const int vb = (int)(uintptr_t)Vt + att::v_rd_base(lane);
    const bf16_t* st = ST + (size_t)cu * 16384;
    f32x16 o[4];
#pragma unroll
    for (int e0 = 0; e0 < 4; ++e0) {
        bf16x8 v0, v1; HG_FRAG2(v0, v1, vb, e0);
        f32x16 acc = {};
        acc = __builtin_amdgcn_mfma_f32_32x32x16_bf16(v0, pa0, acc, 0, 0, 0);
        acc = __builtin_amdgcn_mfma_f32_32x32x16_bf16(v1, pa1, acc, 0, 0, 0);
#pragma unroll
        for (int d0 = 0; d0 < 8; ++d0) { const bf16x8 sf = *(const bf16x8*)(st + (size_t)(e0 * 32 + r32) * 128 + d0 * 16 + hi * 8);
            acc = __builtin_amdgcn_mfma_f32_32x32x16_bf16(sf, qi[d0], acc, 0, 0, 0); }
        o[e0] = acc;
    }
    float ss = 0.f;
#pragma unroll
    for (int e0 = 0; e0 < 4; ++e0)
#pragma unroll
        for (int r = 0; r < 16; ++r) ss += o[e0][r] * o[e0][r];
    { auto rr = __builtin_amdgcn_permlane32_swap(__float_as_uint(ss), __float_as_uint(ss), false, false); ss = __uint_as_float(rr[0]) + __uint_as_float(rr[1]); }
    const float rinv = rsqrtf(ss * (1.0f / 128.0f) + 1e-6f);
    const bf16_t* gp = U + (row0 + r32) * LDU + C_DG + h * 128; bf16_t* yp = Y + (row0 + r32) * D_MODEL + 3 * 1024 + h * 128;
#pragma unroll
    for (int e0 = 0; e0 < 4; ++e0)
#pragma unroll
        for (int g4 = 0; g4 < 4; ++g4) { const int e = e0 * 32 + 8 * g4 + 4 * hi;
            const uint2 gg = *(const uint2*)(gp + e); const float4 ww = *(const float4*)(nw + h * 128 + e);
            const float y0 = o[e0][4 * g4 + 0] * rinv * ww.x * siluf_(__uint_as_float(gg.x << 16)), y1 = o[e0][4 * g4 + 1] * rinv * ww.y * siluf_(__uint_as_float(gg.x & 0xffff0000u));
            const float y2 = o[e0][4 * g4 + 2] * rinv * ww.z * siluf_(__uint_as_float(gg.y << 16)), y3 = o[e0][4 * g4 + 3] * rinv * ww.w * siluf_(__uint_as_float(gg.y & 0xffff0000u));
            *(uint2*)(yp + e) = make_uint2(att::cvtpk(y0, y1), att::cvtpk(y2, y3)); }
}
#undef HG_FRAG2
#undef HG_TRRD
}

static __device__ __forceinline__ void hgrn_h1_phase(ArgsP ap, int l, LAS unsigned char* lds, int tidv, int vcu) {
    const bf16_t* U = (const bf16_t*)(ap->ws + WS_U); const float* lb = (const float*)(ap->ws + WS_LB) + l * 1024; bf16_t* UT = (bf16_t*)(ap->ws + WS_HUT); float* Dc = (float*)(ap->ws + WS_HD);
    const int lane = tidv & 63, wave = __builtin_amdgcn_readfirstlane(tidv >> 6);
    LAS char* wl = (LAS char*)lds + wave * 16384;
    for (int cu = vcu * NWAVES + wave; cu < BATCH * 8 * HG_NCH; cu += (int)gridDim.x * NWAVES) hg::h1_chunk(U, lb, UT, Dc, cu, wl, lane);
}
static __device__ __forceinline__ void hgrn_h2_phase(ArgsP ap, int tidv, int vcu) {
    const bf16_t* UT = (const bf16_t*)(ap->ws + WS_HUT); const float* Dc = (const float*)(ap->ws + WS_HD); bf16_t* ST = (bf16_t*)(ap->ws + WS_HST);
    for (int gt = vcu * (NWAVES * 64) + tidv; gt < BATCH * 8 * 128 * 64; gt += (int)gridDim.x * NWAVES * 64) {
        const int bh = gt >> 13, e = (gt >> 6) & 127, d2 = (gt & 63) * 2;
        const size_t base = (size_t)bh * HG_NCH * 16384 + (size_t)e * 128 + d2; const float* dp = Dc + (size_t)bh * HG_NCH * 128 + d2;
        float s0 = 0.f, s1 = 0.f;
        for (int c0 = 0; c0 < HG_NCH; c0 += 16) {
            unsigned uu[16]; float2 dd[16];
#pragma unroll
            for (int j = 0; j < 16; ++j) { uu[j] = *(const unsigned*)(UT + base + (size_t)(c0 + j) * 16384); dd[j] = *(const float2*)(dp + (size_t)(c0 + j) * 128); }
            unsigned so[16];
#pragma unroll
            for (int j = 0; j < 16; ++j) { so[j] = att::cvtpk(s0, s1); s0 = dd[j].x * s0 + __uint_as_float(uu[j] << 16); s1 = dd[j].y * s1 + __uint_as_float(uu[j] & 0xffff0000u); }
#pragma unroll
            for (int j = 0; j < 16; ++j) *(unsigned*)(ST + base + (size_t)(c0 + j) * 16384) = so[j];
        }
    }
}
static __device__ __forceinline__ void hgrn_h3_phase(ArgsP ap, int l, LAS unsigned char* lds, int tidv, int vcu) {
    const bf16_t* U = (const bf16_t*)(ap->ws + WS_U); const float* lb = (const float*)(ap->ws + WS_LB) + l * 1024; const bf16_t* ST = (const bf16_t*)(ap->ws + WS_HST);
    const float* nw = ap->in[6] + (size_t)l * 1024; bf16_t* Y = (bf16_t*)(ap->ws + WS_Y);
    const int lane = tidv & 63, wave = __builtin_amdgcn_readfirstlane(tidv >> 6);
    LAS char* wl = (LAS char*)lds + wave * 16384;
    for (int cu = vcu * NWAVES + wave; cu < BATCH * 8 * HG_NCH; cu += (int)gridDim.x * NWAVES) hg::h3_chunk(U, lb, ST, nw, Y, cu, wl, lane);
}

__device__ __forceinline__ void unpk8(const v4u w, float (&v)[8]) {
    v[0] = __uint_as_float(w.x << 16); v[1] = __uint_as_float(w.x & 0xffff0000u); v[2] = __uint_as_float(w.y << 16); v[3] = __uint_as_float(w.y & 0xffff0000u);
    v[4] = __uint_as_float(w.z << 16); v[5] = __uint_as_float(w.z & 0xffff0000u); v[6] = __uint_as_float(w.w << 16); v[7] = __uint_as_float(w.w & 0xffff0000u); }
static __device__ __forceinline__ void conv_phase(ArgsP ap, int l, int tidv, int vcu) {
    const bf16_t* U = (const bf16_t*)(ap->ws + WS_U); const float* cw = ap->in[4] + (size_t)l * 3 * 1024; bf16_t* Y = (bf16_t*)(ap->ws + WS_Y);
    const int wv = __builtin_amdgcn_readfirstlane(tidv >> 6), ln = tidv & 63, c0 = ln * 16;
    float mq0 = 0.f, mk0 = 0.f, mq1 = 0.f, mk1 = 0.f;
    for (int row = vcu * NWAVES + wv; row < MTOK; row += (int)gridDim.x * NWAVES) {
        const int t = row % SEQ; const bf16_t* u0 = U + (size_t)row * LDU;
        v4u bc[3][2], bx[3][2];
#pragma unroll
        for (int j = 0; j < 3; ++j) { const int back = (t - 2 + j >= 0) ? 2 - j : 0; const bf16_t* ur = u0 - (size_t)back * LDU;
#pragma unroll
            for (int hh = 0; hh < 2; ++hh) { bc[j][hh] = *(const v4u*)(ur + C_BC + c0 + 8 * hh); bx[j][hh] = *(const v4u*)(ur + C_BX + c0 + 8 * hh); } }
        v4u bb[2], bg[2], qv[2], kv[2];
#pragma unroll
        for (int hh = 0; hh < 2; ++hh) { bb[hh] = *(const v4u*)(u0 + C_BB + c0 + 8 * hh); bg[hh] = *(const v4u*)(u0 + C_BG + c0 + 8 * hh);
            qv[hh] = *(const v4u*)(u0 + C_CQ + c0 + 8 * hh); kv[hh] = *(const v4u*)(u0 + C_CK + c0 + 8 * hh); }
        float q2 = 0.f, k2 = 0.f;
#pragma unroll
        for (int hh = 0; hh < 2; ++hh) {
            float acc[8] = {0.f, 0.f, 0.f, 0.f, 0.f, 0.f, 0.f, 0.f};
#pragma unroll
            for (int j = 0; j < 3; ++j) { float a[8], x[8]; unpk8(bc[j][hh], a); unpk8(bx[j][hh], x);
                const float4 w0 = *(const float4*)(cw + j * 1024 + c0 + 8 * hh), w1 = *(const float4*)(cw + j * 1024 + c0 + 8 * hh + 4);
                const float wz = (t - 2 + j >= 0) ? 1.f : 0.f;
                acc[0] += wz * w0.x * (a[0] * x[0]); acc[1] += wz * w0.y * (a[1] * x[1]); acc[2] += wz * w0.z * (a[2] * x[2]); acc[3] += wz * w0.w * (a[3] * x[3]);
                acc[4] += wz * w1.x * (a[4] * x[4]); acc[5] += wz * w1.y * (a[5] * x[5]); acc[6] += wz * w1.z * (a[6] * x[6]); acc[7] += wz * w1.w * (a[7] * x[7]); }
            float b8[8], g8[8], y[8]; unpk8(bb[hh], b8); unpk8(bg[hh], g8);
#pragma unroll
            for (int i = 0; i < 8; ++i) y[i] = b8[i] * acc[i] * siluf_(g8[i]);
            v4u o; o.x = pg8::cvt_pk_bf16(y[0], y[1]); o.y = pg8::cvt_pk_bf16(y[2], y[3]); o.z = pg8::cvt_pk_bf16(y[4], y[5]); o.w = pg8::cvt_pk_bf16(y[6], y[7]);
            *(v4u*)(Y + (size_t)row * D_MODEL + 1024 + c0 + 8 * hh) = o;
            float qq[8], kk[8]; unpk8(qv[hh], qq); unpk8(kv[hh], kk);
#pragma unroll
            for (int i = 0; i < 8; ++i) { q2 += qq[i] * qq[i]; k2 += kk[i] * kk[i]; }
        }
        q2 += dpp_f<0xB1>(q2); k2 += dpp_f<0xB1>(k2); q2 += dpp_f<0x4E>(q2); k2 += dpp_f<0x4E>(k2); q2 += dpp_f<0x141>(q2); k2 += dpp_f<0x141>(k2);
        if (row < SEQ) { mq0 = fmaxf(mq0, q2); mk0 = fmaxf(mk0, k2); } else { mq1 = fmaxf(mq1, q2); mk1 = fmaxf(mk1, k2); }
    }
    if ((ln & 7) == 0) { unsigned* slot = (unsigned*)ap->ws + CW_FOXN + ((l * 2 + 0) * 8 + (ln >> 3)) * 2;
        atomicMax(slot, __float_as_uint(mq0)); atomicMax(slot + 1, __float_as_uint(mk0)); atomicMax(slot + 16, __float_as_uint(mq1)); atomicMax(slot + 17, __float_as_uint(mk1)); }
}
static __device__ __forceinline__ void dsa_score_unit(const bf16_t* U, const float* UM, const bf16_t* IKB, unsigned short* score, int b, int qblk, int tidv) {
    using att::bf16x8; using att::f32x16;
    const int wave = __builtin_amdgcn_readfirstlane(tidv >> 6), lane = tidv & 63, r = lane & 31, hi = lane >> 5;
    const size_t brow = (size_t)b * SEQ; const int t0 = qblk * 32 + wave * 4;
    const int qq = (r >> 2) & 1, head = (r & 3) + 4 * (r >> 3);
    bf16x8 A[2][4]; float w[2][16];
#pragma unroll
    for (int s = 0; s < 2; ++s) {
        const bf16_t* qp = U + (brow + t0 + 2 * s + qq) * LDU + C_AIQ + head * 64 + 8 * hi;
#pragma unroll
        for (int ks = 0; ks < 4; ++ks) A[s][ks] = *(const bf16x8*)(qp + ks * 16);
        const float* wp = UM + (brow + t0 + 2 * s + hi) * LDM + MC_IW;
#pragma unroll
        for (int g = 0; g < 4; ++g) { const float4 x = *(const float4*)(wp + 4 * g); w[s][4 * g] = x.x * (1.0f / 32.0f); w[s][4 * g + 1] = x.y * (1.0f / 32.0f); w[s][4 * g + 2] = x.z * (1.0f / 32.0f); w[s][4 * g + 3] = x.w * (1.0f / 32.0f); }
    }
    const int nblk = (qblk + 2) >> 1;
    const bf16_t* kp = IKB + (brow >> 5) * 2048 + (size_t)lane * 8;
    unsigned* sp0 = (unsigned*)(score + (brow + t0 + hi) * SCPH) + r; unsigned* sp1 = (unsigned*)(score + (brow + t0 + 2 + hi) * SCPH) + r;
    bf16x8 B[2][4], Bn[2][4];
#pragma unroll
    for (int g = 0; g < 2; ++g)
#pragma unroll
        for (int ks = 0; ks < 4; ++ks) B[g][ks] = *(const bf16x8*)(kp + (size_t)g * 2048 + ks * 512);
    for (int tb = 0; tb < nblk; ++tb) {
        const int tn = tb + 1 < nblk ? tb + 1 : tb;
#pragma unroll
        for (int g = 0; g < 2; ++g)
#pragma unroll
            for (int ks = 0; ks < 4; ++ks) Bn[g][ks] = *(const bf16x8*)(kp + (size_t)(2 * tn + g) * 2048 + ks * 512);
        f32x16 c[2][2] = {};
#pragma unroll
        for (int ks = 0; ks < 4; ++ks)
#pragma unroll
            for (int g = 0; g < 2; ++g) { c[g][0] = __builtin_amdgcn_mfma_f32_32x32x16_bf16(A[0][ks], B[g][ks], c[g][0], 0, 0, 0); c[g][1] = __builtin_amdgcn_mfma_f32_32x32x16_bf16(A[1][ks], B[g][ks], c[g][1], 0, 0, 0); }
        float sc[2][2];
#pragma unroll
        for (int g = 0; g < 2; ++g) {
            float s0a = 0.f, s0b = 0.f, s1a = 0.f, s1b = 0.f;
#pragma unroll
            for (int i = 0; i < 16; i += 2) {
                s0a += w[0][i] * __builtin_amdgcn_fmed3f(c[g][0][i], 0.f, 3.0e38f); s0b += w[0][i + 1] * __builtin_amdgcn_fmed3f(c[g][0][i + 1], 0.f, 3.0e38f);
                s1a += w[1][i] * __builtin_amdgcn_fmed3f(c[g][1][i], 0.f, 3.0e38f); s1b += w[1][i + 1] * __builtin_amdgcn_fmed3f(c[g][1][i + 1], 0.f, 3.0e38f); }
            sc[g][0] = s0a + s0b; sc[g][1] = s1a + s1b;
        }
        sp0[tb * 32] = __builtin_bit_cast(unsigned, __builtin_amdgcn_cvt_pkrtz(sc[0][0], sc[1][0]));
        sp1[tb * 32] = __builtin_bit_cast(unsigned, __builtin_amdgcn_cvt_pkrtz(sc[0][1], sc[1][1]));
#pragma unroll
        for (int g = 0; g < 2; ++g)
#pragma unroll
            for (int ks = 0; ks < 4; ++ks) B[g][ks] = Bn[g][ks];
    }
}
static __device__ __forceinline__ void dsa_score_phase(ArgsP ap, int tidv, int vcu) {
    const bf16_t* U = (const bf16_t*)(ap->ws + WS_U); const float* UM = (const float*)(ap->ws + WS_UM); const bf16_t* IKB = (const bf16_t*)(ap->ws + WS_IKB); unsigned short* score = (unsigned short*)(ap->ws + WS_SCORE);
    for (int pi = vcu; pi < BATCH * 128; pi += (int)gridDim.x) {
        const int b = pi >> 7, x = pi & 127;
        dsa_score_unit(U, UM, IKB, score, b, 255 - x, tidv);
        dsa_score_unit(U, UM, IKB, score, b, x, tidv);
    }
}
template <int NR> static __device__ __forceinline__ void dsa_topk_row_n(const float* sr, int* out, int n, int lane) {
    unsigned key[NR];
#pragma unroll
    for (int i = 0; i < NR; ++i) { const int s = i * 64 + lane;
        const unsigned bts = __float_as_uint(sr[s < n ? s : n - 1]); const unsigned k = bts ^ ((bts >> 31) ? 0xFFFFFFFFu : 0x80000000u);
        key[i] = s < n ? k : 0u; }
    unsigned T = 0u; int cT = n;
    for (int bit = 31; bit >= 0 && cT != 256; --bit) {
        const unsigned cand = T | (1u << bit); int c = 0;
#pragma unroll
        for (int i = 0; i < NR; ++i) c += (key[i] >= cand) ? 1 : 0;
        c = wave_sum_i(c);
        if (c >= 256) { T = cand; cT = c; }
    }
    int need = 0; unsigned Tg = (T ? T : 1u) - 1u;
    if (cT != 256) {
        int cgt = 0;
#pragma unroll
        for (int i = 0; i < NR; ++i) cgt += (key[i] > T) ? 1 : 0;
        cgt = wave_sum_i(cgt); need = 256 - cgt; Tg = T;
    }
    int base = 0;
    const unsigned long long lmask = (lane == 0) ? 0ull : (~0ull >> (64 - lane));
#pragma unroll
    for (int i = 0; i < NR; ++i) {
        const bool gt = key[i] > Tg, eq = (need > 0) && key[i] == T;
        const unsigned long long beq = __ballot(eq);
        const int eqrank = __popcll(beq & lmask);
        const bool sel = gt || (eq && eqrank < need);
        const unsigned long long bsel = __ballot(sel);
        if (sel) out[base + __popcll(bsel & lmask)] = i * 64 + lane;
        base += __popcll(bsel);
        const int neq = __popcll(beq); need -= neq < need ? neq : need;
    }
}
__device__ __forceinline__ unsigned wave_max_u(unsigned v) {
    v = max(v, (unsigned)dpp_i<0xB1>((int)v)); v = max(v, (unsigned)dpp_i<0x4E>((int)v)); v = max(v, (unsigned)dpp_i<0x141>((int)v)); v = max(v, (unsigned)dpp_i<0x140>((int)v));
    return max(max((unsigned)__builtin_amdgcn_readlane((int)v, 0), (unsigned)__builtin_amdgcn_readlane((int)v, 16)), max((unsigned)__builtin_amdgcn_readlane((int)v, 32), (unsigned)__builtin_amdgcn_readlane((int)v, 48)));
}
template <int NC> static __device__ __forceinline__ void topk_final(LAS const unsigned* cand, int c0, unsigned Tlo, int* out, int lane) {
    unsigned ck[NC], ci[NC];
#pragma unroll
    for (int j = 0; j < NC; ++j) { const int p = j * 64 + lane; ck[j] = p < c0 ? cand[p] : 0u; ci[j] = cand[1024 + p]; }
    unsigned mx = 0u;
#pragma unroll
    for (int j = 0; j < NC; ++j) mx = max(mx, ck[j]);
    mx = wave_max_u(mx);
    const unsigned diff = mx ^ Tlo; const int hb = diff ? 31 - __builtin_clz(diff) : -1;
    unsigned T = hb >= 0 ? (Tlo & ~((2u << hb) - 1u)) : Tlo; int cT = c0;
    for (int bit = hb; bit >= 16 && cT != 256; --bit) {
        const unsigned cnd = T | (1u << bit); int c = 0;
#pragma unroll
        for (int j = 0; j < NC; ++j) c += (ck[j] >= cnd) ? 1 : 0;
        c = wave_sum_i(c);
        if (c >= 256) { T = cnd; cT = c; }
    }
    int need = 0; unsigned Tg = (T ? T : 1u) - 1u;
    if (cT != 256) {
        int cgt = 0;
#pragma unroll
        for (int j = 0; j < NC; ++j) cgt += (ck[j] > T) ? 1 : 0;
        cgt = wave_sum_i(cgt); need = 256 - cgt; Tg = T;
    }
    int base = 0;
    const unsigned long long lmask = (lane == 0) ? 0ull : (~0ull >> (64 - lane));
#pragma unroll
    for (int j = 0; j < NC; ++j) {
        const bool gt = ck[j] > Tg, eq = (need > 0) && ck[j] == T;
        const unsigned long long beq = __ballot(eq);
        const int eqrank = __popcll(beq & lmask);
        const bool sel = gt || (eq && eqrank < need);
        const unsigned long long bsel = __ballot(sel);
        if (sel) out[base + __popcll(bsel & lmask)] = (int)ci[j];
        base += __popcll(bsel);
        const int neq = __popcll(beq); need -= neq < need ? neq : need;
    }
}
template <int NR> static __device__ __forceinline__ bool dsa_topk_row_fast(const unsigned short* sr, int* out, int n, int lane, LAS unsigned* cand) {
    constexpr int NG = NR / 8;
    unsigned key[NR];
    int lane8 = 8 * lane; asm volatile("" : "+v"(lane8));
#pragma unroll
    for (int j = 0; j < NG; ++j) { const v4u v = *(const v4u*)((const char*)sr + (size_t)j * 1024 + (unsigned)(lane8 * 2)); const int nj = n - 512 * j;
        const unsigned wv[4] = {v.x, v.y, v.z, v.w};
#pragma unroll
        for (int q = 0; q < 4; ++q) {
            typedef short s16x2_t __attribute__((ext_vector_type(2)));
            const unsigned sg = __builtin_bit_cast(unsigned, __builtin_bit_cast(s16x2_t, wv[q]) >> (s16x2_t){15, 15});
            const unsigned tq = wv[q] ^ (sg | 0x80008000u);
            key[8 * j + 2 * q] = tq << 16; key[8 * j + 2 * q + 1] = tq & 0xffff0000u; }
        if (nj < 512) {
#pragma unroll
            for (int c = 0; c < 8; ++c) key[8 * j + c] = lane8 < nj - c ? key[8 * j + c] : 0u; } }
    constexpr int SG = NG / 4 > 0 ? NG / 4 : 1;
    const unsigned sk[4] = {key[0], key[(8 * SG) % NR], key[(16 * SG) % NR], key[(24 * SG) % NR]};
    int ns = 0;
#pragma unroll
    for (int q = 0; q < 4; ++q) { const int v = (n - 512 * ((q * SG) % NG) + 7) >> 3; ns += v < 0 ? 0 : (v > 64 ? 64 : v); }
    const float ctf = 256.f + 2.f * sqrtf(256.f * (float)n / (float)ns);
    int m = (int)(ctf * (float)ns / (float)n) + 1; m = m > ns ? ns : m;
    unsigned T0 = 1u << 16; int c0 = n;
    for (int tries = 0; tries < 4; ++tries) {
        unsigned Ts = 0u; int cs = 256;
        for (int bit = 31; bit >= 18 && cs != m; --bit) {
            const unsigned cnd = Ts | (1u << bit);
            int c = ((sk[0] >= cnd) ? 1 : 0) + ((sk[1] >= cnd) ? 1 : 0) + ((sk[2] >= cnd) ? 1 : 0) + ((sk[3] >= cnd) ? 1 : 0);
            c = wave_sum_i(c);
            if (c >= m) { Ts = cnd; cs = c; }
        }
        if (Ts == 0u) Ts = 1u << 16;
        int c = 0;
#pragma unroll
        for (int i = 0; i < NR; ++i) c += (key[i] >= Ts) ? 1 : 0;
        c = wave_sum_i(c);
        if (c >= 256) { T0 = Ts; c0 = c; break; }
        if (m >= ns) break;
        m = 2 * m + 8; m = m > ns ? ns : m;
    }
    bool mass_ties = false; unsigned Tt = 0u; int cgt_t = 0;
    if (c0 > 1024) {
        unsigned T = 0u; int cT = n;
        for (int bit = 31; bit >= 16 && cT != 256; --bit) {
            const unsigned cnd = T | (1u << bit); int c = 0;
#pragma unroll
            for (int i = 0; i < NR; ++i) c += (key[i] >= cnd) ? 1 : 0;
            c = wave_sum_i(c);
            if (c >= 256) { T = cnd; cT = c; }
        }
        T0 = T; c0 = cT;
        if (cT > 1024) {
            int c = 0;
#pragma unroll
            for (int i = 0; i < NR; ++i) c += (key[i] > T) ? 1 : 0;
            mass_ties = true; Tt = T; cgt_t = wave_sum_i(c); }
    }
    if (mass_ties) {
        int base = 0, ebase = cgt_t;
#pragma unroll
        for (int j = 0; j < NG; ++j) {
            bool e[8]; unsigned long long qe[8]; int erank = 0;
#pragma unroll
            for (int c = 0; c < 8; ++c) { const unsigned k = key[8 * j + c]; const bool g = k > Tt; e[c] = k == Tt && k != 0u;
                const unsigned long long qg = __ballot(g); qe[c] = __ballot(e[c]);
                if (g) out[base + (int)__builtin_amdgcn_mbcnt_hi((unsigned)(qg >> 32), __builtin_amdgcn_mbcnt_lo((unsigned)qg, 0u))] = lane8 + (512 * j + c);
                base += __popcll(qg);
                erank += (int)__builtin_amdgcn_mbcnt_hi((unsigned)(qe[c] >> 32), __builtin_amdgcn_mbcnt_lo((unsigned)qe[c], 0u)); }
            int pe = ebase + erank;
#pragma unroll
            for (int c = 0; c < 8; ++c) { if (e[c] && pe < 256) out[pe] = lane8 + (512 * j + c); pe += e[c] ? 1 : 0; ebase += __popcll(qe[c]); }
        }
        return true;
    }
    int base = 0;
#pragma unroll
    for (int j = 0; j < NG; ++j) {
        bool p[8]; int cnt = 0;
#pragma unroll
        for (int c = 0; c < 8; ++c) { p[c] = key[8 * j + c] >= T0; cnt += p[c] ? 1 : 0; }
        int inc = cnt;
        inc += __builtin_amdgcn_update_dpp(0, inc, 0x111, 0xf, 0xf, true); inc += __builtin_amdgcn_update_dpp(0, inc, 0x112, 0xf, 0xf, true);
        inc += __builtin_amdgcn_update_dpp(0, inc, 0x114, 0xf, 0xf, true); inc += __builtin_amdgcn_update_dpp(0, inc, 0x118, 0xf, 0xf, true);
        inc += __builtin_amdgcn_update_dpp(0, inc, 0x142, 0xA, 0xf, false);
        inc += __builtin_amdgcn_update_dpp(0, inc, 0x143, 0xC, 0xf, false);
        int pos = base + inc - cnt; base += __builtin_amdgcn_readlane(inc, 63);
#pragma unroll
        for (int c = 0; c < 8; ++c) { if (p[c]) { cand[pos] = key[8 * j + c]; cand[1024 + pos] = (unsigned)(lane8 + (512 * j + c)); } pos += p[c] ? 1 : 0; }
    }
    asm volatile("s_waitcnt lgkmcnt(0)" ::: "memory");
    if (c0 <= 512) topk_final<8>(cand, c0, T0, out, lane); else topk_final<16>(cand, c0, T0, out, lane);
    return true;
}
static __device__ __forceinline__ void dsa_topk_row(const unsigned short* score, int* idx, int row, int lane, LAS unsigned* cand) {
    asm volatile("" : "+v"(lane));
    const int t = row % SEQ, n = t + 1;
    int* out = idx + (size_t)row * 256;
    if (n <= 256) {
#pragma unroll
        for (int j = 0; j < 4; ++j) { const int p = j * 64 + lane; out[p] = p < n ? p : -1; }
        return;
    }
    const unsigned short* sr = score + (size_t)row * SCPH;
    if (n <= 2048) (void)dsa_topk_row_fast<32>(sr, out, n, lane, cand);
    else if (n <= 3072) (void)dsa_topk_row_fast<48>(sr, out, n, lane, cand);
    else if (n <= 4096) (void)dsa_topk_row_fast<64>(sr, out, n, lane, cand);
    else if (n <= 5120) (void)dsa_topk_row_fast<80>(sr, out, n, lane, cand);
    else if (n <= 6144) (void)dsa_topk_row_fast<96>(sr, out, n, lane, cand);
    else if (n <= 7168) (void)dsa_topk_row_fast<112>(sr, out, n, lane, cand);
    else (void)dsa_topk_row_fast<128>(sr, out, n, lane, cand);
}
static __device__ __forceinline__ void dsa_topk_phase(ArgsP ap, LAS unsigned char* lds, int tidv, int vcu) {
    const unsigned short* score = (const unsigned short*)(ap->ws + WS_SCORE); int* idx = (int*)(ap->ws + WS_IDX);
    const int lane = tidv & 63, wave = __builtin_amdgcn_readfirstlane(tidv >> 6);
    LAS unsigned* cand = (LAS unsigned*)(lds + wave * 8192);
    for (int row = vcu * NWAVES + wave; row < MTOK; row += (int)gridDim.x * NWAVES) dsa_topk_row(score, idx, row, lane, cand);
}
static __device__ __forceinline__ void dsa_attn_simple_phase(ArgsP ap, LAS unsigned char* lds, int tidv, int vcu) {
    const bf16_t* U = (const bf16_t*)(ap->ws + WS_U); const int* idx = (const int*)(ap->ws + WS_IDX); bf16_t* Y = (bf16_t*)(ap->ws + WS_Y);
    const int h = __builtin_amdgcn_readfirstlane(tidv >> 6), lane = tidv & 63;
    LAS int* sidx = (LAS int*)lds; LAS float* qs = (LAS float*)(lds + 1024) + h * 128; LAS float* ps = (LAS float*)(lds + 1024 + 4096) + h * 256;
    for (int row = vcu; row < MTOK; row += (int)gridDim.x) {
        const int b = row / SEQ;
        __syncthreads();
        if (tidv < 256) sidx[tidv] = idx[(size_t)row * 256 + tidv];
        const bf16_t* ur = U + (size_t)row * LDU;
        qs[lane] = bf2f(ur[C_AQ + h * 128 + lane]); qs[lane + 64] = bf2f(ur[C_AQ + h * 128 + lane + 64]);
        __syncthreads();
        float lg[4]; float mx = -1e30f;
#pragma unroll
        for (int c = 0; c < 4; ++c) { const int id = sidx[c * 64 + lane]; float d = -INFINITY;
            if (id >= 0) { const uint4* kr = (const uint4*)(U + ((size_t)b * SEQ + id) * LDU + C_AK); d = 0.f;
#pragma unroll
                for (int j = 0; j < 16; ++j) { const uint4 kk = kr[j]; const LAS float* q = qs + j * 8;
                    d += q[0] * __uint_as_float(kk.x << 16) + q[1] * __uint_as_float(kk.x & 0xffff0000u) + q[2] * __uint_as_float(kk.y << 16) + q[3] * __uint_as_float(kk.y & 0xffff0000u)
                       + q[4] * __uint_as_float(kk.z << 16) + q[5] * __uint_as_float(kk.z & 0xffff0000u) + q[6] * __uint_as_float(kk.w << 16) + q[7] * __uint_as_float(kk.w & 0xffff0000u); }
                d *= 0.08838834764831845f; }
            lg[c] = d; mx = fmaxf(mx, d); }
        mx = wave_max(mx);
        float sum = 0.f;
#pragma unroll
        for (int c = 0; c < 4; ++c) { lg[c] = __expf(lg[c] - mx); sum += lg[c]; }
        sum = wave_sum(sum); const float inv = 1.0f / sum;
#pragma unroll
        for (int c = 0; c < 4; ++c) ps[c * 64 + lane] = lg[c] * inv;
        LDS_WAIT();
        float o0 = 0.f, o1 = 0.f;
        for (int j = 0; j < 256; ++j) { const int id = sidx[j]; if (id < 0) continue; const float p = ps[j];
            const unsigned vv = *(const unsigned*)(U + ((size_t)b * SEQ + id) * LDU + C_AV + 2 * lane);
            o0 += p * __uint_as_float(vv << 16); o1 += p * __uint_as_float(vv & 0xffff0000u); }
        const unsigned gg = *(const unsigned*)(ur + C_AG + h * 128 + 2 * lane);
        o0 *= siluf_(__uint_as_float(gg << 16)); o1 *= siluf_(__uint_as_float(gg & 0xffff0000u));
        *(unsigned*)(Y + (size_t)row * D_MODEL + h * 128 + 2 * lane) = pk2(o0, o1);
    }
    __syncthreads();
}

constexpr int DSA_WAVE_LDS = 16384 + 1024 + 256;
static __device__ __forceinline__ void dsa_attn_row(const bf16_t* U, const int* idx, bf16_t* Y, int row, LAS char* wl, int lane) {
    using namespace att;
    const int r32 = lane & 31, hi = lane >> 5;
    const int b = row / SEQ, t = row % SEQ; const size_t brow = (size_t)b * SEQ;
    const int nvalid = (t + 1) < 256 ? (t + 1) : 256;
    LAS char* Kt = wl; LAS char* Vt = wl + 8192; LAS int* sidx = (LAS int*)(wl + 16384); LAS float* li_l = (LAS float*)(wl + 16384 + 1024); LAS float* al_l = li_l + 32;
    { const v4u v = *(const v4u*)(idx + (size_t)row * 256 + lane * 4); *(LAS v4u*)(sidx + lane * 4) = v; }
    bf16x8 qr[8];
    const bf16_t* qp = U + (size_t)row * LDU + C_AQ + (r32 & 7) * 128 + hi * 8;
#pragma unroll
    for (int d0 = 0; d0 < 8; ++d0) { bf16x8 q = *(const bf16x8*)(qp + d0 * 16); if (r32 >= 8) q = (bf16x8){0, 0, 0, 0, 0, 0, 0, 0}; qr[d0] = q; }
    asm volatile("s_waitcnt lgkmcnt(0)" ::: "memory");
    float m_reg = -1e30f, l_reg = 0; f32x16 o[4] = {};
    const int vbase = (int)(uintptr_t)Vt + v_rd_base(lane);
    const int gr = lane >> 4, gc = lane & 15;
    const bf16_t* Kg = U + brow * LDU + C_AK + gc * 8; const bf16_t* Vg = U + brow * LDU + C_AV + gc * 8;
    bf16x8 kv[8], vv[8];
#define DA_GATHER(tt_) do { _Pragma("unroll") for (int i = 0; i < 8; ++i) { int iv = sidx[(tt_) * 32 + i * 4 + gr]; iv = iv < 0 ? 0 : iv; \
            kv[i] = *(const bf16x8*)(Kg + (size_t)iv * LDU); vv[i] = *(const bf16x8*)(Vg + (size_t)iv * LDU); } } while (0)
    DA_GATHER(0);
    for (int tt = 0; tt < 8; ++tt) {
#pragma unroll
        for (int i = 0; i < 8; ++i) { const int kk = i * 4 + gr; *(LAS bf16x8*)(Kt + KSWZ(kk, gc * 16)) = kv[i]; *(LAS bf16x8*)(Vt + v_st(kk, gc * 8)) = vv[i]; }
        if (tt + 1 < 8) DA_GATHER(tt + 1);
        asm volatile("s_waitcnt lgkmcnt(0)" ::: "memory");
        f32x16 p = {};
        {   const LAS char* kb4[4];
#pragma unroll
            for (int dd = 0; dd < 4; ++dd) kb4[dd] = Kt + KSWZ(r32, (dd * 16 + hi * 8) * 2);
#pragma unroll
            for (int d0 = 0; d0 < 8; ++d0) { const bf16x8 kf = *reinterpret_cast<const LAS bf16x8*>(kb4[d0 & 3] + (d0 >> 2) * 128);
                p = __builtin_amdgcn_mfma_f32_32x32x16_bf16(kf, qr[d0], p, 0, 0, 0); } }
        if (tt * 32 + 32 > nvalid) {
            const float NEG = -__builtin_inff();
#pragma unroll
            for (int r = 0; r < 16; ++r) if (tt * 32 + crow(r, hi) >= nvalid) p[r] = NEG; }
        float pmax = p[0];
#pragma unroll
        for (int r = 1; r < 16; ++r) pmax = fmaxf(pmax, p[r]);
        { auto rr = __builtin_amdgcn_permlane32_swap(__float_as_uint(pmax), __float_as_uint(pmax), false, false); pmax = fmaxf(__uint_as_float(rr[0]), __uint_as_float(rr[1])); }
        constexpr float C2 = 1.4426950408889634f * SCALE;
        float mn, alpha;
        if (__builtin_expect(__all((pmax - m_reg) * SCALE <= THR), 1)) { mn = m_reg; alpha = 1.f; }
        else { mn = fmaxf(m_reg, pmax); alpha = __builtin_amdgcn_exp2f((m_reg - mn) * C2); m_reg = mn; }
        const float mnL = -mn * C2; float ps = 0.f;
#pragma unroll
        for (int r = 0; r < 16; ++r) { p[r] = __builtin_amdgcn_exp2f(fmaf(p[r], C2, mnL)); ps += p[r]; }
        { auto rr = __builtin_amdgcn_permlane32_swap(__float_as_uint(ps), __float_as_uint(ps), false, false); ps = __uint_as_float(rr[0]) + __uint_as_float(rr[1]); }
        l_reg = l_reg * alpha + ps;
        if (__any(alpha < 1.f)) { if (hi == 0) al_l[r32] = alpha; asm volatile("s_waitcnt lgkmcnt(0)" ::: "memory");
#pragma unroll
            for (int d_ = 0; d_ < 4; ++d_)
#pragma unroll
                for (int r = 0; r < 4; ++r) o[d_][r] *= al_l[crow(r, hi)]; }
        bf16x8 pa0, pa1;
#define DA_PK4(P, B_, OUT) do { unsigned a0 = cvtpk(P[B_+0], P[B_+1]), a1 = cvtpk(P[B_+2], P[B_+3]); unsigned b0 = cvtpk(P[B_+4], P[B_+5]), b1 = cvtpk(P[B_+6], P[B_+7]); \
        auto r0 = __builtin_amdgcn_permlane32_swap(a0, b0, false, false); auto r1 = __builtin_amdgcn_permlane32_swap(a1, b1, false, false); \
        u32x4 w = {r0[0], r1[0], r0[1], r1[1]}; OUT = *reinterpret_cast<bf16x8*>(&w); } while (0)
        DA_PK4(p, 0, pa0); DA_PK4(p, 8, pa1);
#undef DA_PK4
        SBAR();
#define DA_TRRD(dst, off) asm volatile("ds_read_b64_tr_b16 %0, %1 offset:%2" : "=&v"(dst) : "v"(vbase), "i"(off) : "memory")
#define DA_PV(d0) do { s16x4 l0, h0, l1, h1; DA_TRRD(l0, (d0) * 512); DA_TRRD(h0, (d0) * 512 + 2048); DA_TRRD(l1, (d0) * 512 + 4096); DA_TRRD(h1, (d0) * 512 + 6144); \
        asm volatile("s_waitcnt lgkmcnt(0)" ::: "memory"); SBAR(); \
        o[d0] = __builtin_amdgcn_mfma_f32_32x32x16_bf16(pa0, (bf16x8){l0[0], l0[1], l0[2], l0[3], h0[0], h0[1], h0[2], h0[3]}, o[d0], 0, 0, 0); \
        o[d0] = __builtin_amdgcn_mfma_f32_32x32x16_bf16(pa1, (bf16x8){l1[0], l1[1], l1[2], l1[3], h1[0], h1[1], h1[2], h1[3]}, o[d0], 0, 0, 0); } while (0)
        DA_PV(0); DA_PV(1); DA_PV(2); DA_PV(3);
#undef DA_PV
#undef DA_TRRD
    }
#undef DA_GATHER
    if (hi == 0) li_l[r32] = l_reg; asm volatile("s_waitcnt lgkmcnt(0)" ::: "memory");
    const bf16_t* gp = U + (size_t)row * LDU + C_AG; bf16_t* yp = Y + (size_t)row * D_MODEL;
    unsigned short gv[4][4];
#pragma unroll
    for (int r = 0; r < 4; ++r)
#pragma unroll
        for (int d0 = 0; d0 < 4; ++d0) gv[r][d0] = gp[(r + 4 * hi) * 128 + d0 * 32 + r32];
#pragma unroll
    for (int r = 0; r < 4; ++r) { const int head = r + 4 * hi; const float rl = __builtin_amdgcn_rcpf(li_l[head]);
#pragma unroll
        for (int d0 = 0; d0 < 4; ++d0) { const float y = o[d0][r] * rl * siluf_(bf2f(gv[r][d0])); const float yn = dpp_f<0xB1>(y);
            if ((r32 & 1) == 0) *(unsigned*)(yp + head * 128 + d0 * 32 + r32) = cvtpk(y, yn); } }
}
static __device__ __forceinline__ void dsa_attn_phase(ArgsP ap, LAS unsigned char* lds, int tidv, int vcu) {
    const bf16_t* U = (const bf16_t*)(ap->ws + WS_U); const int* idx = (const int*)(ap->ws + WS_IDX); bf16_t* Y = (bf16_t*)(ap->ws + WS_Y);
    const int lane = tidv & 63, wave = __builtin_amdgcn_readfirstlane(tidv >> 6);
    LAS char* wl = (LAS char*)lds + wave * DSA_WAVE_LDS;
    for (int row = vcu * NWAVES + wave; row < MTOK; row += (int)gridDim.x * NWAVES) dsa_attn_row(U, idx, Y, row, wl, lane);
}

static __device__ __forceinline__ void ph_inproj(ArgsP ap, int l, LAS unsigned char* lds, int tidv) {
    unsigned char* ws = ap->ws;
    pg8::Gemm g{}; g.A = (const bf16_t*)(ws + WS_XB); g.Bt = (const bf16_t*)(ws + WS_WIN) + (size_t)l * NU * D_MODEL; g.M = MTOK; g.N = NU; g.K = D_MODEL; g.lda = D_MODEL; g.ldb = D_MODEL;
    pg8::EpiInProj E{}; E.U = (bf16_t*)(ws + WS_U); E.UM = (float*)(ws + WS_UM); E.IKB = (bf16_t*)(ws + WS_IKB); E.T128 = (const float*)(ws + WS_ROPE128); E.T64 = (const float*)(ws + WS_ROPE64); E.RS = (const float*)(ws + WS_RS);
    pg8::SchedPlain S; S.init(MTOK / 256, NU / 256, (int)gridDim.x, (int)blockIdx.x);
    pg8::gemm_phase<pg8::EpiInProj, pg8::SchedPlain>(lds + RING_OFF, g, S, E, tidv);
}
static __device__ __forceinline__ void ph_gates(ArgsP ap, int l, LAS unsigned char* lds, int tidv) {
    unsigned char* ws = ap->ws;
    pg8::Gemm g{}; g.A = (const bf16_t*)(ws + WS_XB); g.Bt = (const bf16_t*)(ws + WS_WM) + (size_t)l * 4 * 16 * 65536; g.M = MTOK; g.N = 4 * D_MODEL; g.K = 256; g.lda = D_MODEL; g.ldb = 256;
    pg8::EpiGates E{}; E.G = (unsigned char*)(ws + WS_GATE); E.bias = ap->in[9] + (size_t)l * 4 * D_MODEL; E.RS = (const float*)(ws + WS_RS);
    pg8::SchedGates S; S.init(MTOK / 256, 64, (int)gridDim.x, (int)blockIdx.x);
    pg8::gemm_phase<pg8::EpiGates, pg8::SchedGates>(lds + RING_OFF, g, S, E, tidv);
}
static __device__ __forceinline__ void ph_branch(ArgsP ap, int l, LAS unsigned char* lds, int tidv) {
    unsigned char* ws = ap->ws;
    pg8::Gemm g{}; g.A = (const bf16_t*)(ws + WS_Y); g.Bt = (const bf16_t*)(ws + WS_WB) + (size_t)l * 4 * D_MODEL * 1024; g.M = MTOK; g.N = D_MODEL; g.K = 1024; g.lda = D_MODEL; g.ldb = 1024;
    pg8::EpiBranch E{}; E.G = (const unsigned char*)(ws + WS_GATE); E.merged = (bf16_t*)(ws + WS_MERGED);
    pg8::SchedBranch S; S.init(MTOK / 256, D_MODEL / 256, (int)gridDim.x, (int)blockIdx.x);
    pg8::gemm_phase<pg8::EpiBranch, pg8::SchedBranch>(lds + RING_OFF, g, S, E, tidv);
}
static __device__ __forceinline__ void ph_out(ArgsP ap, int l, LAS unsigned char* lds, int tidv) {
    unsigned char* ws = ap->ws;
    pg8::Gemm g{}; g.A = (const bf16_t*)(ws + WS_MERGED); g.Bt = (const bf16_t*)(ws + WS_WO) + (size_t)l * D_MODEL * D_MODEL; g.M = MTOK; g.N = D_MODEL; g.K = D_MODEL; g.lda = D_MODEL; g.ldb = D_MODEL;
    pg8::EpiOut E{}; E.x = (bf16_t*)(ws + WS_XB); E.ps = (float*)(ws + WS_HO);
    pg8::SchedPlain S; S.init(MTOK / 256, D_MODEL / 256, (int)gridDim.x, (int)blockIdx.x);
    pg8::gemm_phase<pg8::EpiOut, pg8::SchedPlain>(lds + RING_OFF, g, S, E, tidv);
}
__device__ __forceinline__ bool in_range(int lo, int hi, int k) { asm volatile("" : "+s"(k)); return lo <= k && k < hi; }
__device__ __forceinline__ float2 rope_cs(int pos, float frac) {
    const float inv = exp2f(-frac * 13.287712379549449f);
    const float ang = (float)pos * inv;
    double r = (double)ang * 0.15915494309189535; r -= floor(r);
    const float f = (float)r;
    return make_float2(__builtin_amdgcn_cosf(f), __builtin_amdgcn_sinf(f));
}
__global__ void __launch_bounds__(NWAVES * 64, 2) k_mega(Args args_unused) {
    extern __shared__ __attribute__((aligned(16))) unsigned char lds_raw[];
    ArgsP ap = (ArgsP)__builtin_amdgcn_kernarg_segment_ptr();
    int wave_s = __builtin_amdgcn_readfirstlane((int)threadIdx.x >> 6);
#define PHASE_BEGIN() do { asm volatile("" : "+s"(ap), "+s"(wave_s)); unsigned m_ = ~0u; asm volatile("" : "+s"(m_)); tidv = (wave_s << 6) | (int)__builtin_amdgcn_mbcnt_hi(m_, __builtin_amdgcn_mbcnt_lo(m_, 0u)); asm volatile("" : "+v"(tidv)); } while (0)
    int tidv;
    LAS unsigned char* const lds = (LAS unsigned char*)lds_raw;
    const int lo = ap->ph_lo, hi = ap->ph_hi;
    for (int u = threadIdx.x; u < (LDS_BYTES - LDSCTL_OFF) / 4; u += NWAVES * 64) ((LAS unsigned*)(lds + LDSCTL_OFF))[u] = 0u;
    __syncthreads();
    XcdBarrier bar; bar.bar = (unsigned*)ap->ws + CW_BAR + ap->li * XCD_BAR_WORDS; bar.x = 0; bar.st = nullptr;
    if (hi - lo > 1) bar = xcd_barrier_post((unsigned*)ap->ws + CW_BAR + ap->li * XCD_BAR_WORDS, (volatile LAS unsigned*)(lds + MISC_OFF) + 8);
#define IN(k) in_range(lo, hi, (k))
#define BOTH(k) in_range(lo, hi - 1, (k))
#define GRID_BAR() do { asm volatile("" : "+s"(bar.x), "+s"(ap)); bar.bar = (unsigned*)ap->ws + CW_BAR + ap->li * XCD_BAR_WORDS; xcd_barrier(bar); } while (0)
#define VCU() ((int)((gridDim.x % 8 == 0) ? (blockIdx.x % 8) * (gridDim.x / 8) + blockIdx.x / 8 : blockIdx.x))

    if (IN(PH_PRO)) {
        PHASE_BEGIN();
        unsigned char* ws = ap->ws;
        const float* norm_w = ap->in[1]; const float* w_in = ap->in[2]; const float* hgrn_gamma = ap->in[5]; const float* w_branch = ap->in[7]; const float* w_merge = ap->in[8]; const float* w_out = ap->in[10];
        bf16_t* WinT = (bf16_t*)(ws + WS_WIN); bf16_t* WbT = (bf16_t*)(ws + WS_WB); bf16_t* WmT = (bf16_t*)(ws + WS_WM); bf16_t* WoT = (bf16_t*)(ws + WS_WO);
        float2* R128 = (float2*)(ws + WS_ROPE128); float2* R64 = (float2*)(ws + WS_ROPE64); float* LB = (float*)(ws + WS_LB);
        const int lane = tidv & 63, wave = __builtin_amdgcn_readfirstlane(tidv >> 6);
        const int gw = VCU() * NWAVES + wave, NGW = gridDim.x * NWAVES, gt = VCU() * (NWAVES * 64) + tidv, NGT = gridDim.x * NWAVES * 64;
        LAS float* scr = (LAS float*)(lds + RING_OFF + wave * 16384);
        constexpr int I_IN = (D_MODEL / 64) * (NU / 32), I_BR = (1024 / 64) * (D_MODEL / 32), I_MG = (256 / 64) * (256 / 32), I_OUT = (D_MODEL / 64) * (D_MODEL / 32);
        constexpr int T_IN = DEPTH * I_IN, T_BR = DEPTH * 4 * I_BR, T_MG = DEPTH * 64 * I_MG, T_OUT = DEPTH * I_OUT;
#define P0_FAMILY(TOT, IPER, WSRC, SSTR, LDW, KK, NBLK, WDST, DSTR, MAPPED, KSC) \
        for (int it = gw; it < (TOT); it += 2 * NGW) { const int i2 = it + NGW < (TOT) ? it + NGW : it; float ta[32], tb[32]; \
            const float* wa = (WSRC) + (size_t)(it / (IPER)) * (SSTR); const float* wb = (WSRC) + (size_t)(i2 / (IPER)) * (SSTR); \
            p0_item_load(wa, (LDW), (NBLK), it % (IPER), lane, (MAPPED), ta); p0_item_load(wb, (LDW), (NBLK), i2 % (IPER), lane, (MAPPED), tb); \
            { const int mi_ = it / (IPER); p0_item_store((KK), (NBLK), (WDST) + (size_t)mi_ * (DSTR), scr, it % (IPER), lane, ta, KSC); } \
            if (i2 != it) { const int mi_ = i2 / (IPER); p0_item_store((KK), (NBLK), (WDST) + (size_t)mi_ * (DSTR), scr, i2 % (IPER), lane, tb, KSC); } }
        P0_FAMILY(T_IN, I_IN, w_in, (size_t)D_MODEL * IN_WIDTH, IN_WIDTH, D_MODEL, NU / 32, WinT, (size_t)NU * D_MODEL, true, norm_w + (size_t)mi_ * D_MODEL)
        P0_FAMILY(T_BR, I_BR, w_branch, (size_t)1024 * D_MODEL, D_MODEL, 1024, D_MODEL / 32, WbT, (size_t)D_MODEL * 1024, false, (const float*)nullptr)
        P0_FAMILY(T_MG, I_MG, w_merge, (size_t)65536, 256, 256, 256 / 32, WmT, (size_t)65536, false, norm_w + (size_t)(mi_ >> 6) * D_MODEL + (mi_ & 15) * 256)
        P0_FAMILY(T_OUT, I_OUT, w_out, (size_t)D_MODEL * D_MODEL, D_MODEL, D_MODEL, D_MODEL / 32, WoT, (size_t)D_MODEL * D_MODEL, false, (const float*)nullptr)
#undef P0_FAMILY
        for (int i = gt; i < SEQ * 64; i += NGT) { const int pos = i >> 6, j = i & 63; R128[i] = rope_cs(pos, (float)j * (1.0f / 64.0f)); }
        for (int i = gt; i < SEQ * 32; i += NGT) { const int pos = i >> 5, j = i & 31; R64[i] = rope_cs(pos, (float)j * (1.0f / 32.0f)); }
        for (int c = gt; c < 1024; c += NGT) {
            const float g0 = hgrn_gamma[c], g1 = hgrn_gamma[1024 + c], g2 = hgrn_gamma[2048 + c], g3 = hgrn_gamma[3072 + c];
            const float mx = fmaxf(fmaxf(g0, g1), fmaxf(g2, g3));
            const float e0 = expf(g0 - mx), e1 = expf(g1 - mx), e2 = expf(g2 - mx), e3 = expf(g3 - mx);
            const float is = 1.0f / (e0 + e1 + e2 + e3);
            LB[c] = 0.f; LB[1024 + c] = e1 * is; LB[2048 + c] = (e1 + e2) * is; LB[3072 + c] = (e1 + e2 + e3) * is;
        }
    }

    for (int l = 0; l < DEPTH; ++l) {
        const int pb = 1 + l * PH_PER_LAYER;
        if (IN(pb + PH_NORM)) {
            PHASE_BEGIN();
            float* RS = (float*)(ap->ws + WS_RS); bf16_t* XB = (bf16_t*)(ap->ws + WS_XB);
            const int lane = tidv & 63, wave = __builtin_amdgcn_readfirstlane(tidv >> 6);
            const int gw = VCU() * NWAVES + wave, NGW = gridDim.x * NWAVES;
            if (l == 0) { const float* x0 = ap->in[0]; for (int m = gw; m < MTOK; m += NGW) rstd_row_f(x0 + (size_t)m * D_MODEL, XB + (size_t)m * D_MODEL, RS + m, lane); }
            else {
                const float* PS = (const float*)(ap->ws + WS_HO);
                for (int m0 = gw; m0 < MTOK; m0 += 8 * NGW) { float v[8];
#pragma unroll
                    for (int k = 0; k < 8; ++k) { const int m = m0 + k * NGW; v[k] = PS[(size_t)(m < MTOK ? m : m0) * 64 + lane]; }
#pragma unroll
                    for (int k = 0; k < 8; ++k) { const int m = m0 + k * NGW; const float sm = wave_sum(v[k]); if (lane == 0 && m < MTOK) RS[m] = rsqrtf(sm * (1.0f / D_MODEL) + 1e-6f); } } }
            if (BOTH(pb + PH_NORM)) GRID_BAR();
        }
        if (IN(pb + PH_INPROJ)) {
            PHASE_BEGIN(); ph_inproj(ap, l, lds, tidv);
            PHASE_BEGIN(); ph_gates(ap, l, lds, tidv);
            if (BOTH(pb + PH_INPROJ)) GRID_BAR();
        }
        if (IN(pb + PH_M1)) {
            PHASE_BEGIN(); hgrn_h1_phase(ap, l, lds, tidv, VCU()); __syncthreads();
            PHASE_BEGIN(); fox_prep(ap, l, lds, tidv, VCU());
            PHASE_BEGIN(); conv_phase(ap, l, tidv, VCU());
            PHASE_BEGIN(); dsa_score_phase(ap, tidv, VCU());
            if (BOTH(pb + PH_M1)) GRID_BAR(); }
        if (IN(pb + PH_M2)) {
            PHASE_BEGIN(); fox_attn_phase(ap, l, lds, tidv, VCU());
            PHASE_BEGIN(); hgrn_h2_phase(ap, tidv, VCU());
            __syncthreads(); PHASE_BEGIN(); dsa_topk_phase(ap, lds, tidv, VCU());
            if (BOTH(pb + PH_M2)) GRID_BAR(); }
        if (IN(pb + PH_M3)) {
            PHASE_BEGIN(); hgrn_h3_phase(ap, l, lds, tidv, VCU());
            __syncthreads(); PHASE_BEGIN(); dsa_attn_phase(ap, lds, tidv, VCU());
            if (BOTH(pb + PH_M3)) GRID_BAR(); }
        if (IN(pb + PH_BRANCH)) { PHASE_BEGIN(); ph_branch(ap, l, lds, tidv); if (BOTH(pb + PH_BRANCH)) GRID_BAR(); }
        if (IN(pb + PH_OUT)) { PHASE_BEGIN(); ph_out(ap, l, lds, tidv); if (BOTH(pb + PH_OUT)) GRID_BAR(); }
    }
    if (IN(PH_FINAL)) {
        PHASE_BEGIN();
        const bf16_t* XB = (const bf16_t*)(ap->ws + WS_XB); float* xout = ap->out; const float* fw = ap->in[11];
        const int lane = tidv & 63, wave = __builtin_amdgcn_readfirstlane(tidv >> 6);
        const int gw = VCU() * NWAVES + wave, NGW = gridDim.x * NWAVES;
        for (int m = gw; m < MTOK; m += NGW) rms_row_b<true>(XB + (size_t)m * D_MODEL, fw, nullptr, xout + (size_t)m * D_MODEL, lane);
    }
#undef IN
#undef BOTH
#undef GRID_BAR
#undef PHASE_BEGIN
#undef VCU
}

extern "C" void kernel_launch(void* const* d_in, const int* in_sizes, int n_in, void* d_out, int out_size, void* d_ws, size_t ws_size, hipStream_t stream) {
    static int grid = 0;
    if (grid == 0) {
        if (ws_size < WS_END || n_in != 12) { fprintf(stderr, "kernel_launch: bad arguments (ws %zu < %zu or n_in %d)\n", ws_size, (size_t)WS_END, n_in); grid = -1; return; }
        int dev = 0, cus = 0, per_cu = 0;
        if (hipGetDevice(&dev) != hipSuccess || hipDeviceGetAttribute(&cus, hipDeviceAttributeMultiprocessorCount, dev) != hipSuccess) { grid = -1; return; }
        if (hipFuncSetAttribute((const void*)k_mega, hipFuncAttributeMaxDynamicSharedMemorySize, LDS_BYTES) != hipSuccess) { fprintf(stderr, "kernel_launch: hipFuncSetAttribute failed\n"); grid = -1; return; }
        if (hipOccupancyMaxActiveBlocksPerMultiprocessor(&per_cu, (const void*)k_mega, NWAVES * 64, LDS_BYTES) != hipSuccess || per_cu < 1) { fprintf(stderr, "kernel_launch: occupancy query says %d\n", per_cu); }
        (void)hipGetLastError();
        grid = cus;
    }
    if (grid < 0) return;
    (void)hipMemsetAsync((char*)d_ws + WS_CTL, 0, (size_t)(CW_BAR + XCD_BAR_WORDS) * 4, stream);
    Args a{};
    for (int i = 0; i < 12; ++i) a.in[i] = (const float*)d_in[i];
    a.out = (float*)d_out; a.ws = (unsigned char*)d_ws;
    const float* fox_f_bias = (const float*)d_in[3]; const float* conv_w = (const float*)d_in[4]; const float* hgrn_norm_w = (const float*)d_in[6];
    unsigned char* ws = (unsigned char*)d_ws;
    bf16_t* U = (bf16_t*)(ws + WS_U); float* UM = (float*)(ws + WS_UM); bf16_t* Y = (bf16_t*)(ws + WS_Y);
    float* SCORE = (float*)(ws + WS_SCORE); int* IDX = (int*)(ws + WS_IDX); float* CF = (float*)(ws + WS_CF); float* HO = (float*)(ws + WS_HO);
    float2* R128 = (float2*)(ws + WS_ROPE128); float2* R64 = (float2*)(ws + WS_ROPE64); float* LB = (float*)(ws + WS_LB);
    a.ph_lo = 0; a.ph_hi = PH_COUNT; a.li = 0;
    hipLaunchKernelGGL(k_mega, dim3(grid), dim3(NWAVES * 64), LDS_BYTES, stream, a);
}
```

```cpp
#include <hip/hip_runtime.h>
#include <stdint.h>
#include <stdio.h>

typedef unsigned short bf16_t;
#define LAS __attribute__((address_space(3)))

constexpr int D_MODEL = 4096, BATCH = 2, SEQ = 8192, DEPTH = 4, MTOK = BATCH * SEQ;
constexpr int IN_WIDTH = 15704;
constexpr int NU = 15872;
constexpr int LDU = 15616;
constexpr int LDM = 256;
constexpr int C_AQ = 0, C_AIQ = 1024, C_AG = 2048, C_BB = 3072, C_BC = 4096, C_BX = 5120, C_BG = 6144, C_CQ = 7168, C_CK = 8192, C_CV = 9216, C_CG = 10240,
              C_DQ = 11264, C_DF = 12288, C_DI = 13312, C_DG = 14336, C_AK = 15360, C_AV = 15488;
constexpr int MC_IK = 0, MC_IW = 64, MC_CF = 80;

__host__ __device__ __forceinline__ int inproj_src_col(int n) {
    if (n < 1024) { const int c = n & 127; return (n & ~127) + (c >> 1) + 64 * (c & 1); }
    if (n < 2048) { const int m = n - 1024, c = m & 63; return 1280 + (m & ~63) + (c >> 1) + 32 * (c & 1); }
    if (n < 3072) return 2384 + (n - 2048);
    if (n < 4096) return 3408 + (n - 3072);
    if (n < 5120) return 4432 + (n - 4096);
    if (n < 6144) return 5456 + (n - 5120);
    if (n < 7168) return 6480 + (n - 6144);
    if (n < 8192) return 7504 + (n - 7168);
    if (n < 9216) return 8528 + (n - 8192);
    if (n < 10240) return 9552 + (n - 9216);
    if (n < 11264) return 10584 + (n - 10240);
    if (n < 12288) return 11608 + (n - 11264);
    if (n < 13312) return 12632 + (n - 12288);
    if (n < 14336) return 13656 + (n - 13312);
    if (n < 15360) return 14680 + (n - 14336);
    if (n < 15488) { const int c = n - 15360; return 1024 + (c >> 1) + 64 * (c & 1); }
    if (n < 15616) return 1152 + (n - 15488);
    if (n < 15680) { const int c = n - 15616; return 2304 + (c >> 1) + 32 * (c & 1); }
    if (n < 15696) return 2368 + (n - 15680);
    if (n < 15704) return 10576 + (n - 15696);
    return -1;
}

constexpr size_t al256(size_t x) { return (x + 255) & ~(size_t)255; }
constexpr size_t WS_CTL = 0;
constexpr int CW_FOXN = 1024;
constexpr size_t WS_WIN = 1u << 20;
constexpr size_t WS_WB = WS_WIN + al256((size_t)DEPTH * NU * D_MODEL * 2);
constexpr size_t WS_WM = WS_WB + al256((size_t)DEPTH * 4 * D_MODEL * 1024 * 2);
constexpr size_t WS_WO = WS_WM + al256((size_t)DEPTH * 4 * 16 * 256 * 256 * 2);
constexpr size_t WS_H = WS_WO + al256((size_t)DEPTH * D_MODEL * D_MODEL * 2);
constexpr size_t WS_RS = WS_H;
constexpr size_t WS_U = WS_H + al256((size_t)MTOK * D_MODEL * 2);
constexpr size_t WS_UM = WS_U + al256((size_t)MTOK * LDU * 2);
constexpr size_t WS_GATE = WS_UM + al256((size_t)MTOK * LDM * 4);
constexpr size_t WS_Y = WS_GATE + al256((size_t)4 * MTOK * D_MODEL * 2);
constexpr size_t WS_MACC = WS_Y + al256((size_t)MTOK * D_MODEL * 2);
constexpr size_t WS_XB = WS_MACC;
constexpr size_t WS_MERGED = WS_MACC + al256((size_t)MTOK * D_MODEL * 4);
constexpr size_t WS_SCORE = WS_MERGED + al256((size_t)MTOK * D_MODEL * 2);
constexpr int SCP = SEQ + 832;
constexpr int SCPH = SEQ + 1664;
constexpr int SCP_UNUSED = SEQ + 832;
constexpr size_t WS_IDX = WS_SCORE + al256((size_t)MTOK * SCP * 4);
constexpr size_t WS_CF = WS_IDX + al256((size_t)MTOK * 256 * 4);
constexpr size_t WS_HO = WS_CF + al256((size_t)BATCH * 8 * SEQ * 4 * 2);
constexpr size_t WS_ROPE128 = WS_HO + al256((size_t)MTOK * 1024 * 4);
constexpr size_t WS_ROPE64 = WS_ROPE128 + al256((size_t)SEQ * 64 * 2 * 4);
constexpr size_t WS_LB = WS_ROPE64 + al256((size_t)SEQ * 32 * 2 * 4);
constexpr size_t WS_HUT = WS_LB + al256((size_t)DEPTH * 1024 * 4);
constexpr size_t WS_HD = WS_HUT + al256((size_t)BATCH * 8 * (SEQ / 32) * 16384 * 4);
constexpr size_t WS_HST = WS_HD + al256((size_t)BATCH * 8 * (SEQ / 32) * 128 * 4);
constexpr size_t WS_IKB = WS_HST + al256((size_t)BATCH * 8 * (SEQ / 32) * 16384 * 2);
constexpr size_t WS_END = WS_IKB + al256((size_t)MTOK * 64 * 2);

__device__ __forceinline__ float bf2f(bf16_t b) { return __uint_as_float(((unsigned)b) << 16); }
__device__ __forceinline__ bf16_t f2bf(float f) { unsigned u = __float_as_uint(f); u += 0x7fffu + ((u >> 16) & 1u); return (bf16_t)(u >> 16); }
__device__ __forceinline__ unsigned pk2(float lo, float hi) { return (unsigned)f2bf(lo) | ((unsigned)f2bf(hi) << 16); }
template <int CTRL> __device__ __forceinline__ float dpp_f(float v) { return __int_as_float(__builtin_amdgcn_update_dpp(0, __float_as_int(v), CTRL, 0xf, 0xf, true)); }
template <int CTRL> __device__ __forceinline__ int dpp_i(int v) { return __builtin_amdgcn_update_dpp(0, v, CTRL, 0xf, 0xf, true); }
__device__ __forceinline__ float wave_sum(float v) {
    v += dpp_f<0xB1>(v); v += dpp_f<0x4E>(v); v += dpp_f<0x141>(v); v += dpp_f<0x140>(v);
    const int i = __float_as_int(v);
    return (__int_as_float(__builtin_amdgcn_readlane(i, 0)) + __int_as_float(__builtin_amdgcn_readlane(i, 16))) + (__int_as_float(__builtin_amdgcn_readlane(i, 32)) + __int_as_float(__builtin_amdgcn_readlane(i, 48)));
}
__device__ __forceinline__ float wave_max(float v) {
    v = fmaxf(v, dpp_f<0xB1>(v)); v = fmaxf(v, dpp_f<0x4E>(v)); v = fmaxf(v, dpp_f<0x141>(v)); v = fmaxf(v, dpp_f<0x140>(v));
    const int i = __float_as_int(v);
    return fmaxf(fmaxf(__int_as_float(__builtin_amdgcn_readlane(i, 0)), __int_as_float(__builtin_amdgcn_readlane(i, 16))), fmaxf(__int_as_float(__builtin_amdgcn_readlane(i, 32)), __int_as_float(__builtin_amdgcn_readlane(i, 48))));
}
__device__ __forceinline__ int wave_sum_i(int v) {
    v += dpp_i<0xB1>(v); v += dpp_i<0x4E>(v); v += dpp_i<0x141>(v); v += dpp_i<0x140>(v);
    return (__builtin_amdgcn_readlane(v, 0) + __builtin_amdgcn_readlane(v, 16)) + (__builtin_amdgcn_readlane(v, 32) + __builtin_amdgcn_readlane(v, 48));
}
__device__ __forceinline__ float sigmoidf_(float x) { return __builtin_amdgcn_rcpf(1.0f + __expf(-x)); }
__device__ __forceinline__ float siluf_(float x) { return x * __builtin_amdgcn_rcpf(1.0f + __expf(-x)); }

namespace pg8 {
typedef short bf16x8 __attribute__((ext_vector_type(8)));
typedef float f32x4 __attribute__((ext_vector_type(4)));
typedef unsigned u32x4 __attribute__((ext_vector_type(4)));
constexpr int BM = 256, BK = 64, HALF = 128, HTB = HALF * BK * 2, STAGE_BYTES = 8 * HTB, NXCD = 8, WGM = 8;

__host__ __device__ __forceinline__ int lds_byte(int r, int c) { const int st = (r >> 4) * 2 + (c >> 5), rr = r & 15, cc = c & 31, ob = rr * 64 + cc * 2; return st * 1024 + (ob ^ (((ob >> 9) & 1) << 5)); }
__host__ __device__ __forceinline__ void stage_rc(int b, int& R, int& C) { const int st = b / 1024, sb = b % 1024, swz = sb ^ (((sb >> 9) & 1) << 5); R = (st >> 1) * 16 + swz / 64; C = (st & 1) * 32 + (swz % 64) / 2; }
__host__ __device__ __forceinline__ int perm32(int rho) { const int n = rho >> 4, i = rho & 15; return 8 * (i >> 2) + 4 * n + (i & 3); }

struct Unit { int pm, pn, z, pad; };
struct Gemm { const bf16_t* A; const bf16_t* Bt; int M, N, K, lda, ldb, pad; };

struct TileOrder {
    int nM, nN, nwg, G, c, pad;
    __host__ __device__ void init(int nM_, int nN_, int G_, int c_) { nM = nM_; nN = nN_; nwg = nM * nN; G = G_; c = c_; pad = 0; }
    __host__ __device__ bool tile(int i, int& pm, int& pn) const {
        const long L = (long)i * G + c; if (L >= nwg) return false;
        int wgid = (int)L; { const int q = nwg / NXCD, r = nwg % NXCD, xcd = wgid % NXCD, off = wgid / NXCD; wgid = (xcd < r ? xcd * (q + 1) : r * (q + 1) + (xcd - r) * q) + off; }
        const int nig = WGM * nN, gid = wgid / nig, fm = gid * WGM, gsz = (nM - fm) < WGM ? (nM - fm) : WGM;
        pm = fm + ((wgid % nig) % gsz); pn = (wgid % nig) / gsz; return true;
    }
};
struct SchedPlain : TileOrder {
    __device__ __forceinline__ bool next(int i, Unit& u) const { u.z = 0; u.pad = 0; return tile(i, u.pm, u.pn); }
    __device__ __forceinline__ size_t a_off(const Unit& u, const Gemm& g) const { return (size_t)u.pm * BM * g.lda * 2; }
    __device__ __forceinline__ size_t b_off(const Unit& u, const Gemm& g) const { return (size_t)u.pn * BM * g.ldb * 2; }
};
struct SchedGates : TileOrder {
    __device__ __forceinline__ bool next(int i, Unit& u) const { u.z = 0; u.pad = 0;
        if (G != 256 || nwg != 4096) return tile(i, u.pm, u.pn);
        const int cnt = c < 128 ? 12 : 20; if (i >= cnt) return false;
        const int id = (c < 128 ? c * 12 : 128 * 12 + (c - 128) * 20) + i;
        u.pm = id >> 6; u.pn = id & 63; return true; }
    __device__ __forceinline__ size_t a_off(const Unit& u, const Gemm& g) const { return (size_t)u.pm * BM * g.lda * 2 + (size_t)(u.pn & 15) * 512; }
    __device__ __forceinline__ size_t b_off(const Unit& u, const Gemm& g) const { return (size_t)u.pn * 256 * 256 * 2; }
};
struct SchedBranch : TileOrder {
    __device__ __forceinline__ bool next(int i, Unit& u) const { u.z = i & 3; u.pad = 0; return tile(i >> 2, u.pm, u.pn); }
    __device__ __forceinline__ size_t a_off(const Unit& u, const Gemm& g) const { return (size_t)u.pm * BM * g.lda * 2 + (size_t)u.z * 2048; }
    __device__ __forceinline__ size_t b_off(const Unit& u, const Gemm& g) const { return (size_t)u.z * ((size_t)4096 * 1024 * 2) + (size_t)u.pn * BM * g.ldb * 2; }
};

typedef __bf16 bf16x2_t __attribute__((ext_vector_type(2)));
typedef float f32x2_t __attribute__((ext_vector_type(2)));
__device__ __forceinline__ unsigned cvt_pk_bf16(float lo, float hi) { const f32x2_t v = {lo, hi}; return __builtin_bit_cast(unsigned, __builtin_convertvector(v, bf16x2_t)); }

struct NoPre {};
struct EpiInProj {
    static constexpr bool PERM = true;
    struct Pre { float rs2[2]; };
    __device__ __forceinline__ Pre pre(const Unit& u, int wr, int, int fr, int fq) const { Pre p; const float* rp = RS + u.pm * BM + wr * 64 + fq * 16 + fr;
        p.rs2[0] = rp[0]; p.rs2[1] = rp[HALF]; return p; }
    static __device__ __forceinline__ float rs_of(const Pre& pr, int ai, int m, int fr) { return __int_as_float(__builtin_amdgcn_ds_bpermute((m * 16 + fr) * 4, __float_as_int(pr.rs2[ai]))); }
    __device__ __forceinline__ bool keep(const Unit&) const { return false; }
    bf16_t* U; float* UM; bf16_t* IKB; const float* T128; const float* T64;
    const float* RS;
    static __device__ __forceinline__ void rot8(f32x4& v0, f32x4& v1, const float* tab) {
        const f32x4 c0 = *(const f32x4*)tab, c1 = *(const f32x4*)(tab + 4);
        const float a0 = v0[0] * c0[0] - v0[1] * c0[1], a1 = v0[0] * c0[1] + v0[1] * c0[0], a2 = v0[2] * c0[2] - v0[3] * c0[3], a3 = v0[2] * c0[3] + v0[3] * c0[2];
        const float b0 = v1[0] * c1[0] - v1[1] * c1[1], b1 = v1[0] * c1[1] + v1[1] * c1[0], b2 = v1[2] * c1[2] - v1[3] * c1[3], b3 = v1[2] * c1[3] + v1[3] * c1[2];
        v0 = (f32x4){a0, a1, a2, a3}; v1 = (f32x4){b0, b1, b2, b3};
    }
    template <int RK> __device__ __forceinline__ void tile_bf16(f32x4 (&acc)[2][2][4][2], const Unit& u, int wr, int wc, int fr, int fq, const Pre& pr) const {
        const int row0 = u.pm * BM + wr * 64 + fr, col0 = u.pn * BM + wc * 32 + 8 * fq;
#pragma unroll
        for (int ai = 0; ai < 2; ++ai) {
            f32x4 tb[4][2][2]; float rsv[4];
#pragma unroll
            for (int m = 0; m < 4; ++m) rsv[m] = rs_of(pr, ai, m, fr);
            if (RK != 0) {
#pragma unroll
                for (int m = 0; m < 4; ++m) { const int pos = (row0 + ai * HALF + m * 16) & (SEQ - 1);
#pragma unroll
                    for (int bj = 0; bj < 2; ++bj) { if (RK == 3 && bj == 1) continue; const int ct = bj * HALF + wc * 32 + 8 * fq;
                        const float* tp = (RK == 2) ? T64 + ((size_t)pos * 32 + ((ct & 63) >> 1)) * 2 : T128 + ((size_t)pos * 64 + ((ct & 127) >> 1)) * 2;
                        tb[m][bj][0] = *(const f32x4*)tp; tb[m][bj][1] = *(const f32x4*)(tp + 4); } }
            }
#pragma unroll
            for (int m = 0; m < 4; ++m) { bf16_t* rowp = U + (size_t)(row0 + ai * HALF + m * 16) * LDU + col0;
#pragma unroll
                for (int bj = 0; bj < 2; ++bj) { f32x4 v0 = acc[ai][bj][m][0] * rsv[m], v1 = acc[ai][bj][m][1] * rsv[m];
                    if (RK == 1 || RK == 2 || (RK == 3 && bj == 0)) { const f32x4 c0 = tb[m][bj][0], c1 = tb[m][bj][1];
                        const float a0 = v0[0] * c0[0] - v0[1] * c0[1], a1 = v0[0] * c0[1] + v0[1] * c0[0], a2 = v0[2] * c0[2] - v0[3] * c0[3], a3 = v0[2] * c0[3] + v0[3] * c0[2];
                        const float b0 = v1[0] * c1[0] - v1[1] * c1[1], b1 = v1[0] * c1[1] + v1[1] * c1[0], b2 = v1[2] * c1[2] - v1[3] * c1[3], b3 = v1[2] * c1[3] + v1[3] * c1[2];
                        v0 = (f32x4){a0, a1, a2, a3}; v1 = (f32x4){b0, b1, b2, b3}; }
                    u32x4 w; w.x = cvt_pk_bf16(v0[0], v0[1]); w.y = cvt_pk_bf16(v0[2], v0[3]); w.z = cvt_pk_bf16(v1[0], v1[1]); w.w = cvt_pk_bf16(v1[2], v1[3]);
                    *(u32x4*)(rowp + bj * HALF) = w; } }
        }
    }
    __device__ __forceinline__ void operator()(f32x4 (&acc)[2][2][4][2], const Unit& u, int wr, int wc, int fr, int fq, const Pre& pr) const {
        const int row0 = u.pm * BM + wr * 64 + fr;
        if (u.pn < 61) {
            if (u.pn < 4) tile_bf16<1>(acc, u, wr, wc, fr, fq, pr);
            else if (u.pn < 8) tile_bf16<2>(acc, u, wr, wc, fr, fq, pr);
            else if (u.pn == 60) tile_bf16<3>(acc, u, wr, wc, fr, fq, pr);
            else tile_bf16<0>(acc, u, wr, wc, fr, fq, pr);
        } else {
            const int col0 = wc * 32 + 8 * fq;
#pragma unroll
            for (int ai = 0; ai < 2; ++ai)
#pragma unroll
                for (int m = 0; m < 4; ++m) { const int row = row0 + ai * HALF + m * 16, pos = row & (SEQ - 1);
                    const float rsv = rs_of(pr, ai, m, fr); f32x4 v0 = acc[ai][0][m][0] * rsv, v1 = acc[ai][0][m][1] * rsv;
                    if (col0 < 64) { rot8(v0, v1, T64 + ((size_t)pos * 32 + (col0 >> 1)) * 2);
                        u32x4 w; w.x = cvt_pk_bf16(v0[0], v0[1]); w.y = cvt_pk_bf16(v0[2], v0[3]); w.z = cvt_pk_bf16(v1[0], v1[1]); w.w = cvt_pk_bf16(v1[2], v1[3]);
                        *(u32x4*)(IKB + (((((size_t)(row >> 6) * 2 + (row & 1)) * 4 + (col0 >> 4)) * 64 + ((row & 63) >> 1) + 32 * ((col0 >> 3) & 1)) << 3)) = w; }
                    else { float* rowp = UM + (size_t)row * LDM + col0; *(f32x4*)rowp = v0; *(f32x4*)(rowp + 4) = v1; } }
        }
    }
};
struct EpiGates {
    static constexpr bool PERM = true;
    struct Pre { unsigned bvp[2][2][2]; float rs2[2]; };
    __device__ __forceinline__ Pre pre(const Unit& u, int wr, int wc, int fr, int fq) const { const float* bb = bias + (u.pn >> 4) * D_MODEL + (u.pn & 15) * 256 + wc * 32 + 8 * fq; Pre p; const float* rp = RS + u.pm * BM + wr * 64 + fq * 16 + fr; p.rs2[0] = rp[0]; p.rs2[1] = rp[HALF];
#pragma unroll
        for (int bj = 0; bj < 2; ++bj)
#pragma unroll
            for (int n = 0; n < 2; ++n) { const f32x4 t = *(const f32x4*)(bb + bj * HALF + 4 * n); p.bvp[bj][n][0] = cvt_pk_bf16(t[0], t[1]); p.bvp[bj][n][1] = cvt_pk_bf16(t[2], t[3]); }
        return p; }
    __device__ __forceinline__ bool keep(const Unit&) const { return false; }
    unsigned char* G; const float* bias; const float* RS;
    static __device__ __forceinline__ unsigned q8(float x) { const float g = sigmoidf_(x); return (unsigned)fmaxf(__builtin_rintf(g * 255.0f), 1.0f); }
    __device__ __forceinline__ void operator()(f32x4 (&acc)[2][2][4][2], const Unit& u, int wr, int wc, int fr, int fq, const Pre& pr) const {
        const int row0 = u.pm * BM + wr * 64 + fr; const int br = u.pn >> 4, nb = u.pn & 15;
        const int col0 = nb * 256 + wc * 32 + 8 * fq;
        unsigned char* base = G + ((((size_t)br * (MTOK / BM) + u.pm) * 16 + nb) << 16) + (unsigned)(((wr * 4 + wc) * 64 + fq * 16 + fr) * 16); const float* bb = bias + br * D_MODEL + col0;
        f32x4 bv[2][2];
#pragma unroll
        for (int bj = 0; bj < 2; ++bj)
#pragma unroll
            for (int n = 0; n < 2; ++n) { const unsigned a = pr.bvp[bj][n][0], b = pr.bvp[bj][n][1]; bv[bj][n] = (f32x4){__uint_as_float(a << 16), __uint_as_float(a & 0xffff0000u), __uint_as_float(b << 16), __uint_as_float(b & 0xffff0000u)}; }
#pragma unroll
        for (int ai = 0; ai < 2; ++ai)
#pragma unroll
            for (int m = 0; m < 4; ++m) { u32x4 w;
#pragma unroll
                for (int bj = 0; bj < 2; ++bj) { const float rsv = __int_as_float(__builtin_amdgcn_ds_bpermute((m * 16 + fr) * 4, __float_as_int(pr.rs2[ai]))); const f32x4 v0 = acc[ai][bj][m][0] * rsv + bv[bj][0], v1 = acc[ai][bj][m][1] * rsv + bv[bj][1];
                    const unsigned lo = q8(v0[0]) | (q8(v0[1]) << 8) | (q8(v0[2]) << 16) | (q8(v0[3]) << 24), hi = q8(v1[0]) | (q8(v1[1]) << 8) | (q8(v1[2]) << 16) | (q8(v1[3]) << 24);
                    if (bj == 0) { w.x = lo; w.y = hi; } else { w.z = lo; w.w = hi; } }
                *(u32x4*)(base + (ai * 4 + m) * 8192) = w; }
    }
};
struct EpiBranch {
    static constexpr bool PERM = true;
    typedef NoPre Pre; __device__ __forceinline__ Pre pre(const Unit&, int, int, int, int) const { return Pre{}; }
    const unsigned char* G; bf16_t* merged;
    __device__ __forceinline__ bool keep(const Unit& u) const { return u.z < 3; }
    static __device__ __forceinline__ void gate8(const uint2 gw, float (&g)[8]) {
        g[0] = (float)(gw.x & 0xffu); g[1] = (float)((gw.x >> 8) & 0xffu); g[2] = (float)((gw.x >> 16) & 0xffu); g[3] = (float)(gw.x >> 24);
        g[4] = (float)(gw.y & 0xffu); g[5] = (float)((gw.y >> 8) & 0xffu); g[6] = (float)((gw.y >> 16) & 0xffu); g[7] = (float)(gw.y >> 24);
    }
    __device__ __forceinline__ void operator()(f32x4 (&acc)[2][2][4][2], const Unit& u, int wr, int wc, int fr, int fq, const Pre&) const {
        { unsigned m_ = ~0u; asm volatile("" : "+s"(m_)); const int ln_ = (int)__builtin_amdgcn_mbcnt_hi(m_, __builtin_amdgcn_mbcnt_lo(m_, 0u)); fr = ln_ & 15; fq = ln_ >> 4; }
        const int row0 = u.pm * BM + wr * 64 + fr; const int col0 = u.pn * BM + wc * 32 + 8 * fq; const int z = u.z;
        const unsigned toff = (unsigned)(((wr * 4 + wc) * 64 + fq * 16 + fr) * 16);
        const unsigned char* ga = G + ((((size_t)z * (MTOK / BM) + u.pm) * 16 + u.pn) << 16); const unsigned char* gb = G + ((((size_t)(z < 3 ? z + 1 : z) * (MTOK / BM) + u.pm) * 16 + u.pn) << 16);
        const bool last = z == 3;
        u32x4 ra[2][4], rb[2][4];
#pragma unroll
        for (int ai = 0; ai < 2; ++ai)
#pragma unroll
            for (int m = 0; m < 4; ++m) { const unsigned off = toff + (unsigned)((ai * 4 + m) * 8192);
                ra[ai][m] = *(const u32x4*)(ga + off); rb[ai][m] = *(const u32x4*)(gb + off); }
#pragma unroll
        for (int ai = 0; ai < 2; ++ai)
#pragma unroll
            for (int m = 0; m < 4; ++m)
#pragma unroll
                for (int bj = 0; bj < 2; ++bj) { float r[8], d[8]; gate8(bj ? make_uint2(ra[ai][m].z, ra[ai][m].w) : make_uint2(ra[ai][m].x, ra[ai][m].y), r); gate8(bj ? make_uint2(rb[ai][m].z, rb[ai][m].w) : make_uint2(rb[ai][m].x, rb[ai][m].y), d);
#pragma unroll
                    for (int j = 0; j < 8; ++j) r[j] = last ? r[j] * (1.0f / 255.0f) : r[j] * __builtin_amdgcn_rcpf(d[j]);
                    f32x4 v0 = acc[ai][bj][m][0], v1 = acc[ai][bj][m][1];
                    v0[0] *= r[0]; v0[1] *= r[1]; v0[2] *= r[2]; v0[3] *= r[3]; v1[0] *= r[4]; v1[1] *= r[5]; v1[2] *= r[6]; v1[3] *= r[7];
                    acc[ai][bj][m][0] = v0; acc[ai][bj][m][1] = v1; }
        if (last) {
#pragma unroll
            for (int ai = 0; ai < 2; ++ai)
#pragma unroll
                for (int m = 0; m < 4; ++m)
#pragma unroll
                    for (int bj = 0; bj < 2; ++bj) { const size_t off = (size_t)(row0 + ai * HALF + m * 16) * D_MODEL + col0 + bj * HALF;
                        const f32x4 v0 = acc[ai][bj][m][0], v1 = acc[ai][bj][m][1];
                        u32x4 w; w.x = cvt_pk_bf16(v0[0], v0[1]); w.y = cvt_pk_bf16(v0[2], v0[3]); w.z = cvt_pk_bf16(v1[0], v1[1]); w.w = cvt_pk_bf16(v1[2], v1[3]);
                        *(u32x4*)(merged + off) = w; }
        }
    }
};
struct EpiOut {
    static constexpr bool PERM = true;
    typedef NoPre Pre; __device__ __forceinline__ Pre pre(const Unit&, int, int, int, int) const { return Pre{}; }
    __device__ __forceinline__ bool keep(const Unit&) const { return false; }
    bf16_t* x; float* ps;
    __device__ __forceinline__ void operator()(f32x4 (&acc)[2][2][4][2], const Unit& u, int wr, int wc, int fr, int fq, const Pre&) const {
        const int row0 = u.pm * BM + wr * 64 + fr, col0 = u.pn * BM + wc * 32 + 8 * fq;
        const unsigned o0 = ((unsigned)row0 * (unsigned)D_MODEL + (unsigned)col0) * 2u;
        u32x4 b[2][4][2];
#pragma unroll
        for (int ai = 0; ai < 2; ++ai)
#pragma unroll
            for (int m = 0; m < 4; ++m)
#pragma unroll
                for (int bj = 0; bj < 2; ++bj) b[ai][m][bj] = *(const u32x4*)((const char*)x + (o0 + (unsigned)(((ai * HALF + m * 16) * D_MODEL + bj * HALF) * 2)));
        const int ln = fq * 16 + fr;
#pragma unroll
        for (int ai = 0; ai < 2; ++ai) {
#pragma unroll
            for (int m = 0; m < 4; ++m) { float ss = 0.f;
#pragma unroll
                for (int bj = 0; bj < 2; ++bj) { const u32x4 q = b[ai][m][bj]; const f32x4 v0 = acc[ai][bj][m][0], v1 = acc[ai][bj][m][1];
                    const float e0 = v0[0] + __uint_as_float(q.x << 16), e1 = v0[1] + __uint_as_float(q.x & 0xffff0000u), e2 = v0[2] + __uint_as_float(q.y << 16), e3 = v0[3] + __uint_as_float(q.y & 0xffff0000u);
                    const float e4 = v1[0] + __uint_as_float(q.z << 16), e5 = v1[1] + __uint_as_float(q.z & 0xffff0000u), e6 = v1[2] + __uint_as_float(q.w << 16), e7 = v1[3] + __uint_as_float(q.w & 0xffff0000u);
                    ss += (e0 * e0 + e1 * e1) + (e2 * e2 + e3 * e3) + (e4 * e4 + e5 * e5) + (e6 * e6 + e7 * e7);
                    u32x4 w; w.x = cvt_pk_bf16(e0, e1); w.y = cvt_pk_bf16(e2, e3); w.z = cvt_pk_bf16(e4, e5); w.w = cvt_pk_bf16(e6, e7);
                    *(u32x4*)((char*)x + (o0 + (unsigned)(((ai * HALF + m * 16) * D_MODEL + bj * HALF) * 2))) = w; }
                ss += __int_as_float(__builtin_amdgcn_ds_bpermute((ln ^ 16) * 4, __float_as_int(ss)));
                ss += __int_as_float(__builtin_amdgcn_ds_bpermute((ln ^ 32) * 4, __float_as_int(ss)));
                if (fq == 0) ps[(unsigned)(row0 + ai * HALF + m * 16) * 64u + (unsigned)(u.pn * 4 + wc)] = ss; }
        }
    }
};

template <class Epi, class Sched>
__device__ __forceinline__ void gemm_phase(LAS unsigned char* lds, const Gemm g, const Sched& S, const Epi& E, const int tid) {
    const int wid = __builtin_amdgcn_readfirstlane(tid >> 6), lane = tid & 63, wr = wid >> 2, wc = wid & 3, fr = lane & 15, fq = lane >> 4;
    int K = g.K; asm volatile("" : "+s"(K));
    const int nt = K / BK;
    unsigned voffA[2], voffB[2];
#pragma unroll
    for (int i = 0; i < 2; ++i) { int R, C; stage_rc(tid * 16 + i * 8192, R, C); const int Rb = Epi::PERM ? ((R & ~31) + perm32(R & 31)) : R;
        voffA[i] = (unsigned)(R * g.lda + C) * 2u; voffB[i] = (unsigned)(Rb * g.ldb + C) * 2u; }
    const size_t kstep = (size_t)(BK * 2);
    const size_t hstepA = (size_t)HALF * g.lda * 2, hstepB = (size_t)HALF * g.ldb * 2;
    const unsigned ldsw = (unsigned)wid * 1024u;
    const int aoff = lds_byte(wr * 64 + fr, fq * 8), boff = lds_byte(wc * 32 + fr, fq * 8);
#define PG8_SA(b, h) (((b) * 2 + (h)) * HTB)
#define PG8_SB(b, h) ((4 + (b) * 2 + (h)) * HTB)
#define PG8_STAGE(bufoff, gbase, voff) do { _Pragma("unroll") for (int _i = 0; _i < 2; ++_i) \
        __builtin_amdgcn_global_load_lds((const unsigned*)((const char*)(gbase) + (voff)[_i]), (LAS unsigned*)(lds + (bufoff) + ldsw + _i * 8192), 16, 0, 0); } while (0)
#define PG8_LDA(dst, b, h) do { _Pragma("unroll") for (int m = 0; m < 4; ++m) _Pragma("unroll") for (int k = 0; k < 2; ++k) dst[m][k] = *(const LAS bf16x8*)(lds + PG8_SA(b, h) + aoff + m * 2048 + k * 1024); } while (0)
#define PG8_LDB(dst, b, h) do { _Pragma("unroll") for (int n = 0; n < 2; ++n) _Pragma("unroll") for (int k = 0; k < 2; ++k) dst[n][k] = *(const LAS bf16x8*)(lds + PG8_SB(b, h) + boff + n * 2048 + k * 1024); } while (0)
#define PG8_MMA(ai, bj, At, Bt) do { __builtin_amdgcn_s_setprio(1); _Pragma("unroll") for (int m = 0; m < 4; ++m) _Pragma("unroll") for (int n = 0; n < 2; ++n) _Pragma("unroll") for (int k = 0; k < 2; ++k) \
        acc[ai][bj][m][n] = __builtin_amdgcn_mfma_f32_16x16x32_bf16(Bt[n][k], At[m][k], acc[ai][bj][m][n], 0, 0, 0); __builtin_amdgcn_s_setprio(0); } while (0)
#define PG8_WAIT_V(n) asm volatile("s_waitcnt vmcnt(" #n ")" ::: "memory")
#define PG8_WAIT_L(n) asm volatile("s_waitcnt lgkmcnt(" #n ")" ::: "memory")
#define PG8_BAR __builtin_amdgcn_s_barrier()
#define PG8_SCHED __builtin_amdgcn_sched_barrier(0)
    Unit cur, nxt; int ui = 0;
    if (!S.next(0, cur)) return;
    f32x4 acc[2][2][4][2];
#pragma unroll
    for (int a = 0; a < 2; ++a)
#pragma unroll
        for (int b = 0; b < 2; ++b)
#pragma unroll
            for (int m = 0; m < 4; ++m)
#pragma unroll
                for (int n = 0; n < 2; ++n) acc[a][b][m][n] = (f32x4){0.f, 0.f, 0.f, 0.f};
    bf16x8 At[4][2], B0[2][2], B1[2][2];
    typename Epi::Pre pre = E.pre(cur, wr, wc, fr, fq);
    const char* cA = (const char*)g.A + S.a_off(cur, g); const char* cB = (const char*)g.Bt + S.b_off(cur, g);
    PG8_STAGE(PG8_SB(0, 0), cB, voffB); PG8_STAGE(PG8_SA(0, 0), cA, voffA); PG8_STAGE(PG8_SB(0, 1), cB + hstepB, voffB); PG8_STAGE(PG8_SA(0, 1), cA + hstepA, voffA);
    if (wr == 1) PG8_BAR;
    PG8_WAIT_V(4); PG8_BAR;
    PG8_STAGE(PG8_SB(1, 0), cB + kstep, voffB); PG8_STAGE(PG8_SA(1, 0), cA + kstep, voffA); PG8_STAGE(PG8_SB(1, 1), cB + hstepB + kstep, voffB);
    PG8_WAIT_V(6); PG8_BAR;
    for (;;) {
        const bool has_next = S.next(ui + 1, nxt);
        const char* nA = has_next ? (const char*)g.A + S.a_off(nxt, g) : cA; const char* nB = has_next ? (const char*)g.Bt + S.b_off(nxt, g) : cB;
        for (int t = 0; t < nt; t += 2) {
            const bool last = (t == nt - 2);
            const char* a1 = cA + (size_t)(t + 1) * kstep;
            const char* a2 = last ? nA : cA + (size_t)(t + 2) * kstep; const char* b2 = last ? nB : cB + (size_t)(t + 2) * kstep;
            const char* a3 = a2 + kstep; const char* b3 = b2 + kstep;
            PG8_LDB(B0, 0, 0); PG8_SCHED; PG8_LDA(At, 0, 0); PG8_STAGE(PG8_SA(1, 1), a1 + hstepA, voffA);
            PG8_WAIT_L(8); PG8_BAR; PG8_WAIT_L(0); PG8_MMA(0, 0, At, B0); PG8_BAR; PG8_SCHED;
            PG8_LDB(B1, 0, 1); PG8_STAGE(PG8_SB(0, 0), b2, voffB);
            PG8_BAR; PG8_WAIT_L(0); PG8_MMA(0, 1, At, B1); PG8_BAR;
            PG8_LDA(At, 0, 1); PG8_STAGE(PG8_SA(0, 0), a2, voffA);
            PG8_BAR; PG8_WAIT_L(0); PG8_MMA(1, 0, At, B0); PG8_BAR; PG8_SCHED;
            PG8_STAGE(PG8_SB(0, 1), b2 + hstepB, voffB);
            PG8_WAIT_V(6); PG8_BAR; PG8_MMA(1, 1, At, B1); PG8_BAR;
            PG8_LDB(B0, 1, 0); PG8_SCHED; PG8_LDA(At, 1, 0); PG8_STAGE(PG8_SA(0, 1), a2 + hstepA, voffA);
            PG8_WAIT_L(8); PG8_BAR; PG8_WAIT_L(0); PG8_MMA(0, 0, At, B0); PG8_BAR; PG8_SCHED;
            PG8_LDB(B1, 1, 1); PG8_STAGE(PG8_SB(1, 0), b3, voffB);
            PG8_BAR; PG8_WAIT_L(0); PG8_MMA(0, 1, At, B1); PG8_BAR;
            PG8_LDA(At, 1, 1); PG8_STAGE(PG8_SA(1, 0), a3, voffA);
            PG8_BAR; PG8_WAIT_L(0); PG8_MMA(1, 0, At, B0); PG8_BAR; PG8_SCHED;
            PG8_STAGE(PG8_SB(1, 1), b3 + hstepB, voffB);
            PG8_WAIT_V(6); PG8_BAR; PG8_MMA(1, 1, At, B1); PG8_BAR;
        }
        E(acc, cur, wr, wc, fr, fq, pre);
        if (!has_next) break;
        if (!E.keep(cur))
#pragma unroll
        for (int a = 0; a < 2; ++a)
#pragma unroll
            for (int b = 0; b < 2; ++b)
#pragma unroll
                for (int m = 0; m < 4; ++m)
#pragma unroll
                    for (int n = 0; n < 2; ++n) acc[a][b][m][n] = (f32x4){0.f, 0.f, 0.f, 0.f};
        cur = nxt; cA = nA; cB = nB; ++ui; pre = E.pre(cur, wr, wc, fr, fq);
    }
    PG8_WAIT_V(0);
    if (wr == 0) PG8_BAR;
    PG8_BAR;
#undef PG8_SA
#undef PG8_SB
#undef PG8_STAGE
#undef PG8_LDA
#undef PG8_LDB
#undef PG8_MMA
#undef PG8_WAIT_V
#undef PG8_WAIT_L
#undef PG8_BAR
#undef PG8_SCHED
}
}

namespace att {
typedef short bf16x8 __attribute__((ext_vector_type(8)));
typedef short s16x4 __attribute__((ext_vector_type(4)));
typedef float f32x16 __attribute__((ext_vector_type(16)));
typedef float f32x4 __attribute__((ext_vector_type(4)));
typedef unsigned u32x4 __attribute__((ext_vector_type(4)));
constexpr int D = 128, KVBLK = 64, QBLK = 32, SHM_V = KVBLK * D * 2, SHM_K = KVBLK * D * 2;
constexpr float SCALE = 0.08838834764831845f, THR = 8.f;
#define KSWZ(row, colB) ((row) * 256 + ((colB) ^ (((row) & 7) << 4)))
#define SBAR() __builtin_amdgcn_sched_barrier(0)
__device__ __forceinline__ int v_st(int k, int c) { const int kk = (k & ~0xC) | ((k & 4) << 1) | ((k & 8) >> 1); return ((kk >> 3) * 4 + (c >> 5)) * 512 + ((kk & 7) * 32 + (c & 31)) * 2; }
__device__ __forceinline__ int v_rd_base(int lane) { return ((lane & 3) << 3) | (((lane >> 2) & 3) << 6) | (((lane >> 4) & 1) << 5) | (((lane >> 5) & 1) << 8); }
constexpr int v_rd_off(int d0, int ks, int half) { return d0 * 512 + ks * 4096 + half * 2048; }
__device__ __forceinline__ int crow(int r, int hi) { return (r & 3) + 8 * (r >> 2) + 4 * hi; }
__device__ __forceinline__ unsigned cvtpk(float lo, float hi) { return pg8::cvt_pk_bf16(lo, hi); }
__device__ __forceinline__ void mask_tile(f32x16& p0, f32x16& p1, int dq) {
    const float NEG = -__builtin_inff();
#pragma unroll
    for (int r = 0; r < 16; ++r) {
        const int c = (r & 3) + 8 * (r >> 2);
        if (dq - c < 0) p0[r] = NEG;
        if (dq - c - 32 < 0) p1[r] = NEG;
    }
}
__device__ __forceinline__ void partialSM(f32x16& p0, f32x16& p1, float& m_reg, float& mn, float& alpha) {
    float pmax = p0[0];
#pragma unroll
    for (int r = 1; r < 16; ++r) pmax = fmaxf(pmax, p0[r]);
#pragma unroll
    for (int r = 0; r < 16; ++r) pmax = fmaxf(pmax, p1[r]);
    { auto rr = __builtin_amdgcn_permlane32_swap(__float_as_uint(pmax), __float_as_uint(pmax), false, false);
      pmax = fmaxf(__uint_as_float(rr[0]), __uint_as_float(rr[1])); }
    constexpr float C2 = 1.4426950408889634f * SCALE;
    if (__builtin_expect(__all((pmax - m_reg) * SCALE <= THR), 1)) { mn = m_reg; alpha = 1.f; }
    else { mn = fmaxf(m_reg, pmax); alpha = __builtin_amdgcn_exp2f((m_reg - mn) * C2); m_reg = mn; }
    const float mnL = -mn * C2;
#pragma unroll
    for (int r = 0; r < 16; ++r) p0[r] = fmaf(p0[r], C2, mnL);
#pragma unroll
    for (int r = 0; r < 16; ++r) p1[r] = fmaf(p1[r], C2, mnL);
#pragma unroll
    for (int r = 0; r < 16; ++r) p0[r] = __builtin_amdgcn_exp2f(p0[r]);
}
__device__ __forceinline__ void finishSM(f32x16& p0, f32x16& p1, float alpha, float& l_reg, bf16x8& pa0, bf16x8& pa1, bf16x8& pa2, bf16x8& pa3) {
#pragma unroll
    for (int r = 0; r < 16; ++r) p1[r] = __builtin_amdgcn_exp2f(p1[r]);
    float ps = 0;
#pragma unroll
    for (int r = 0; r < 16; ++r) ps += p0[r];
#pragma unroll
    for (int r = 0; r < 16; ++r) ps += p1[r];
    { auto rr = __builtin_amdgcn_permlane32_swap(__float_as_uint(ps), __float_as_uint(ps), false, false);
      ps = __uint_as_float(rr[0]) + __uint_as_float(rr[1]); }
    l_reg = l_reg * alpha + ps;
#define PK4(P, B_, OUT) do { unsigned a0 = cvtpk(P[B_+0], P[B_+1]), a1 = cvtpk(P[B_+2], P[B_+3]);                          \
        unsigned b0 = cvtpk(P[B_+4], P[B_+5]), b1 = cvtpk(P[B_+6], P[B_+7]);                                             \
        auto r0 = __builtin_amdgcn_permlane32_swap(a0, b0, false, false); auto r1 = __builtin_amdgcn_permlane32_swap(a1, b1, false, false); \
        u32x4 w = {r0[0], r1[0], r0[1], r1[1]}; OUT = *reinterpret_cast<bf16x8*>(&w); } while (0)
    PK4(p0, 0, pa0); PK4(p0, 8, pa1); PK4(p1, 0, pa2); PK4(p1, 8, pa3);
#undef PK4
}
__device__ __forceinline__ void qkt(f32x16& p0, f32x16& p1, const LAS char* Kt, int r32, int hi, const bf16x8* qr) {
    p0 = f32x16{}; p1 = f32x16{};
    const LAS char* kb[4];
#pragma unroll
    for (int dd = 0; dd < 4; ++dd) kb[dd] = Kt + KSWZ(r32, (dd * 16 + hi * 8) * 2);
#pragma unroll
    for (int d0 = 0; d0 < 8; ++d0) { const LAS char* a = kb[d0 & 3] + (d0 >> 2) * 128;
        bf16x8 b0 = *reinterpret_cast<const LAS bf16x8*>(a);
        bf16x8 b1 = *reinterpret_cast<const LAS bf16x8*>(a + 32 * 256);
        p0 = __builtin_amdgcn_mfma_f32_32x32x16_bf16(b0, qr[d0], p0, 0, 0, 0);
        p1 = __builtin_amdgcn_mfma_f32_32x32x16_bf16(b1, qr[d0], p1, 0, 0, 0); }
}
__device__ __forceinline__ void pv_tile(f32x16* o, int vb0, bf16x8 pa0, bf16x8 pa1, bf16x8 pa2, bf16x8 pa3) {
#define TRRD(dst, off) asm volatile("ds_read_b64_tr_b16 %0, %1 offset:%2" : "=&v"(dst) : "v"(vb0), "i"(off) : "memory")
#define PV_D0(d0) do { s16x4 l0, l1, l2, l3, h0, h1, h2, h3; constexpr int b_ = v_rd_off(d0, 0, 0); \
        TRRD(l0, b_); TRRD(h0, b_ + 2048); TRRD(l1, b_ + 4096); TRRD(h1, b_ + 6144); TRRD(l2, b_ + 8192); TRRD(h2, b_ + 10240); TRRD(l3, b_ + 12288); TRRD(h3, b_ + 14336); \
        asm volatile("s_waitcnt lgkmcnt(0)" ::: "memory"); SBAR();   \
        o[d0] = __builtin_amdgcn_mfma_f32_32x32x16_bf16(pa0, (bf16x8){l0[0], l0[1], l0[2], l0[3], h0[0], h0[1], h0[2], h0[3]}, o[d0], 0, 0, 0);   \
        o[d0] = __builtin_amdgcn_mfma_f32_32x32x16_bf16(pa1, (bf16x8){l1[0], l1[1], l1[2], l1[3], h1[0], h1[1], h1[2], h1[3]}, o[d0], 0, 0, 0);   \
        o[d0] = __builtin_amdgcn_mfma_f32_32x32x16_bf16(pa2, (bf16x8){l2[0], l2[1], l2[2], l2[3], h2[0], h2[1], h2[2], h2[3]}, o[d0], 0, 0, 0);   \
        o[d0] = __builtin_amdgcn_mfma_f32_32x32x16_bf16(pa3, (bf16x8){l3[0], l3[1], l3[2], l3[3], h3[0], h3[1], h3[2], h3[3]}, o[d0], 0, 0, 0); } while (0)
    PV_D0(0); PV_D0(1); PV_D0(2); PV_D0(3);
#undef PV_D0
#undef TRRD
}
}


#define GAS __attribute__((address_space(1)))
typedef GAS unsigned gu32;
#define RLX_AGENT __ATOMIC_RELAXED, __HIP_MEMORY_SCOPE_AGENT
#define LDS_WAIT() asm volatile("s_waitcnt lgkmcnt(0)" ::: "memory")
#define VM_WAIT() asm volatile("s_waitcnt vmcnt(0)" ::: "memory")
typedef unsigned v4u __attribute__((ext_vector_type(4)));

#define XB_TMO      128
#define XB_XCNT(j)  (256  + 64 * (j))
#define XB_XSUB(j)  (1280 + 64 * (j))
#define XB_XGEN(j)  (2304 + 64 * (j))
#define XB_TOP      3328
#define XB_TOPGEN   3392
#define XCD_BAR_WORDS 3456
#define XB_SPIN_CAP (1u << 18)
__device__ __forceinline__ unsigned xb_ld(unsigned* p)              { return __hip_atomic_load(p, __ATOMIC_RELAXED, __HIP_MEMORY_SCOPE_AGENT); }
__device__ __forceinline__ unsigned xb_add(unsigned* p, unsigned v) { return __hip_atomic_fetch_add(p, v, __ATOMIC_RELAXED, __HIP_MEMORY_SCOPE_AGENT); }
__device__ __forceinline__ unsigned xb_xcc_id() { return (unsigned)__builtin_amdgcn_s_getreg((3 << 11) | 20) & 0xFu; }
#define XB_SPIN(cond, bar) do { unsigned _sp = 0; while (cond) { __builtin_amdgcn_s_sleep(1); \
    if ((++_sp & 255u) == 0u) { if (xb_ld(&(bar)[XB_TMO])) break; if (_sp > XB_SPIN_CAP) { atomicAdd(&(bar)[XB_TMO], 1u); break; } } } } while (0)
struct XcdBarrier { unsigned* bar; unsigned x; volatile LAS unsigned* st; };
__device__ __forceinline__ XcdBarrier xcd_barrier_post(unsigned* bar, volatile LAS unsigned* st) {
    XcdBarrier b; b.bar = bar; b.x = xb_xcc_id(); b.st = st;
    if (threadIdx.x == 0) (void)xb_add(&bar[XB_XCNT(b.x)], 1u);
    return b;
}
__device__ __forceinline__ void xcd_barrier_complete(unsigned* bar, unsigned x, unsigned& nloc, unsigned& nx) {
    const unsigned G = gridDim.x * gridDim.y * gridDim.z;
    unsigned sum, cnt, mine, sp = 0u;
    for (;;) {
        sum = 0u; cnt = 0u; mine = 0u;
#pragma unroll
        for (unsigned j = 0; j < 16; ++j) { const unsigned c = xb_ld(&bar[XB_XCNT(j)]); sum += c; cnt += (c > 0u) ? 1u : 0u; mine = (j == x) ? c : mine; }
        if (sum == G) break;
        __builtin_amdgcn_s_sleep(1);
        if ((++sp & 255u) == 0u) { if (xb_ld(&bar[XB_TMO])) break; if (sp > XB_SPIN_CAP) { atomicAdd(&bar[XB_TMO], 1u); break; } }
    }
    nloc = mine > 0u ? mine : 1u; nx = cnt > 0u ? cnt : 1u;
}
__device__ __forceinline__ void xcd_barrier(const XcdBarrier& b) {
    asm volatile("s_waitcnt vmcnt(0)" ::: "memory");
    __syncthreads();
    if (threadIdx.x == 0) {
        unsigned* bar = b.bar;
        __builtin_amdgcn_s_waitcnt(0);
        unsigned nloc = b.st[0], nx = b.st[1];
        if (nloc == 0u) { xcd_barrier_complete(bar, b.x, nloc, nx); b.st[0] = nloc; b.st[1] = nx; }
        const unsigned old = xb_add(&bar[XB_XSUB(b.x)], 1u);
        const unsigned gen = old / nloc;
        if (old + 1u == (gen + 1u) * nloc) {
            __builtin_amdgcn_fence(__ATOMIC_RELEASE, "agent");
            asm volatile("s_waitcnt vmcnt(0)" ::: "memory");
            const unsigned og = xb_add(&bar[XB_TOP], 1u);
            const unsigned tg = og / nx;
            if (og + 1u == (tg + 1u) * nx) xb_add(&bar[XB_TOPGEN], 1u);
            else XB_SPIN(xb_ld(&bar[XB_TOPGEN]) == tg, bar);
            __builtin_amdgcn_fence(__ATOMIC_ACQUIRE, "agent");
            xb_add(&bar[XB_XGEN(b.x)], 1u);
            asm volatile("s_waitcnt vmcnt(0)" ::: "memory");
        } else {
            XB_SPIN(xb_ld(&bar[XB_XGEN(b.x)]) == gen, bar);
            __builtin_amdgcn_fence(__ATOMIC_ACQUIRE, "agent");
            asm volatile("s_waitcnt vmcnt(0)" ::: "memory");
        }
    }
    __syncthreads();
}

constexpr int PH_PRO = 0, PH_PER_LAYER = 8, PH_NORM = 0, PH_INPROJ = 1, PH_M1 = 2, PH_M2 = 3, PH_M3 = 4, PH_M4 = 5, PH_BRANCH = 6, PH_OUT = 7;
constexpr int PH_FINAL = 1 + DEPTH * PH_PER_LAYER, PH_COUNT = PH_FINAL + 1;
constexpr int RING_OFF = 0, RING_BYTES = 131072, LDSCTL_OFF = 147456, MISC_OFF = LDSCTL_OFF + 320, LDS_BYTES = 151552;
constexpr int NWAVES = 8;
constexpr int CW_BAR = 4096;
constexpr int MAX_BAR_REGIONS = 64;
static_assert((CW_BAR + MAX_BAR_REGIONS * XCD_BAR_WORDS) * 4 <= (1 << 20), "CTL region");
static_assert(MISC_OFF + 128 <= LDS_BYTES, "LDS map");

struct Args { const float* in[12]; float* out; unsigned char* ws; int ph_lo, ph_hi, li, pad; };
typedef const __attribute__((address_space(4))) Args* ArgsP;


__device__ __forceinline__ void p0_item_load(const float* W, int ldw, int nblk, int item, int lane, bool mapped, float (&tv)[32]) {
    const int kb = item / nblk, nb = item % nblk, k0 = 64 * kb, n0 = 32 * nb;
    const int nn = n0 + (lane & 31); const int sc = mapped ? inproj_src_col(nn) : nn; const int scc = sc >= 0 ? sc : 0;
#pragma unroll
    for (int i = 0; i < 32; ++i) { const int kk = 2 * i + (lane >> 5); const float v = W[(size_t)(k0 + kk) * ldw + scc]; tv[i] = sc >= 0 ? v : 0.f; }
}
__device__ __forceinline__ void p0_item_store(int K, int nblk, bf16_t* WT, LAS float* scr, int item, int lane, const float (&tv)[32], const float* kscale) {
    const int kb = item / nblk, nb = item % nblk, k0 = 64 * kb, n0 = 32 * nb;
    float4 ks0 = make_float4(1.f, 1.f, 1.f, 1.f), ks1 = ks0;
    if (kscale) { ks0 = *(const float4*)(kscale + k0 + 8 * (lane & 7)); ks1 = *(const float4*)(kscale + k0 + 8 * (lane & 7) + 4); }
#pragma unroll
    for (int i = 0; i < 32; ++i) { const int kk = 2 * i + (lane >> 5); scr[kk * 33 + (lane & 31)] = tv[i]; }
    LDS_WAIT(); asm volatile("" ::: "memory");
    const int c = lane & 7;
#pragma unroll
    for (int j = 0; j < 4; ++j) { const int n = (lane >> 3) + 8 * j; const LAS float* s = scr + (8 * c) * 33 + n;
        v4u o; o.x = pk2(s[0 * 33] * ks0.x, s[1 * 33] * ks0.y); o.y = pk2(s[2 * 33] * ks0.z, s[3 * 33] * ks0.w); o.z = pk2(s[4 * 33] * ks1.x, s[5 * 33] * ks1.y); o.w = pk2(s[6 * 33] * ks1.z, s[7 * 33] * ks1.w);
        *(v4u*)(WT + (size_t)(n0 + n) * K + k0 + 8 * c) = o; }
    LDS_WAIT(); asm volatile("" ::: "memory");
}
template <bool OUT_F32> __device__ __forceinline__ void rms_row(const float* xrow, const float* w, bf16_t* ob, float* of, bf16_t* xcopy, int lane) {
    const float4* xr = (const float4*)xrow;
    float4 v[16]; float s = 0.f;
#pragma unroll
    for (int j = 0; j < 16; ++j) { v[j] = xr[j * 64 + lane]; s += v[j].x * v[j].x + v[j].y * v[j].y + v[j].z * v[j].z + v[j].w * v[j].w; }
    if (xcopy) {
#pragma unroll
        for (int j = 0; j < 16; ++j) ((uint2*)xcopy)[j * 64 + lane] = make_uint2(pk2(v[j].x, v[j].y), pk2(v[j].z, v[j].w)); }
    s = wave_sum(s);
    const float r = rsqrtf(s * (1.0f / D_MODEL) + 1e-6f);
#pragma unroll
    for (int j = 0; j < 16; ++j) { const float4 ww = ((const float4*)w)[j * 64 + lane];
        const float a = v[j].x * r * ww.x, b = v[j].y * r * ww.y, c = v[j].z * r * ww.z, d = v[j].w * r * ww.w;
        if (OUT_F32) ((float4*)of)[j * 64 + lane] = make_float4(a, b, c, d);
        else ((uint2*)ob)[j * 64 + lane] = make_uint2(pk2(a, b), pk2(c, d)); }
}
__device__ __forceinline__ void rstd_row_f(const float* xrow, bf16_t* xcopy, float* rs, int lane) {
    const float4* xr = (const float4*)xrow;
    float4 v[16]; float s = 0.f;
#pragma unroll
    for (int j = 0; j < 16; ++j) { v[j] = xr[j * 64 + lane]; s += v[j].x * v[j].x + v[j].y * v[j].y + v[j].z * v[j].z + v[j].w * v[j].w; }
#pragma unroll
    for (int j = 0; j < 16; ++j) ((uint2*)xcopy)[j * 64 + lane] = make_uint2(pk2(v[j].x, v[j].y), pk2(v[j].z, v[j].w));
    s = wave_sum(s);
    if (lane == 0) *rs = rsqrtf(s * (1.0f / D_MODEL) + 1e-6f);
}
__device__ __forceinline__ void rstd_row_b(const bf16_t* xrow, float* rs, int lane) {
    v4u q[8]; float s = 0.f;
#pragma unroll
    for (int j = 0; j < 8; ++j) q[j] = ((const v4u*)xrow)[j * 64 + lane];
#pragma unroll
    for (int j = 0; j < 8; ++j) { const float a0 = __uint_as_float(q[j].x << 16), a1 = __uint_as_float(q[j].x & 0xffff0000u), a2 = __uint_as_float(q[j].y << 16), a3 = __uint_as_float(q[j].y & 0xffff0000u);
        const float a4 = __uint_as_float(q[j].z << 16), a5 = __uint_as_float(q[j].z & 0xffff0000u), a6 = __uint_as_float(q[j].w << 16), a7 = __uint_as_float(q[j].w & 0xffff0000u);
        s += (a0 * a0 + a1 * a1) + (a2 * a2 + a3 * a3) + (a4 * a4 + a5 * a5) + (a6 * a6 + a7 * a7); }
    s = wave_sum(s);
    if (lane == 0) *rs = rsqrtf(s * (1.0f / D_MODEL) + 1e-6f);
}
__device__ __forceinline__ void rstd_row_b2(const bf16_t* xa, const bf16_t* xb, float* rsa, float* rsb, int lane) {
    v4u qa[8], qb[8]; float sa = 0.f, sb = 0.f;
#pragma unroll
    for (int j = 0; j < 8; ++j) { qa[j] = ((const v4u*)xa)[j * 64 + lane]; qb[j] = ((const v4u*)xb)[j * 64 + lane]; }
#pragma unroll
    for (int j = 0; j < 8; ++j) {
        { const float a0 = __uint_as_float(qa[j].x << 16), a1 = __uint_as_float(qa[j].x & 0xffff0000u), a2 = __uint_as_float(qa[j].y << 16), a3 = __uint_as_float(qa[j].y & 0xffff0000u);
          const float a4 = __uint_as_float(qa[j].z << 16), a5 = __uint_as_float(qa[j].z & 0xffff0000u), a6 = __uint_as_float(qa[j].w << 16), a7 = __uint_as_float(qa[j].w & 0xffff0000u);
          sa += (a0 * a0 + a1 * a1) + (a2 * a2 + a3 * a3) + (a4 * a4 + a5 * a5) + (a6 * a6 + a7 * a7); }
        { const float a0 = __uint_as_float(qb[j].x << 16), a1 = __uint_as_float(qb[j].x & 0xffff0000u), a2 = __uint_as_float(qb[j].y << 16), a3 = __uint_as_float(qb[j].y & 0xffff0000u);
          const float a4 = __uint_as_float(qb[j].z << 16), a5 = __uint_as_float(qb[j].z & 0xffff0000u), a6 = __uint_as_float(qb[j].w << 16), a7 = __uint_as_float(qb[j].w & 0xffff0000u);
          sb += (a0 * a0 + a1 * a1) + (a2 * a2 + a3 * a3) + (a4 * a4 + a5 * a5) + (a6 * a6 + a7 * a7); } }
    sa = wave_sum(sa); sb = wave_sum(sb);
    if (lane == 0) { *rsa = rsqrtf(sa * (1.0f / D_MODEL) + 1e-6f); *rsb = rsqrtf(sb * (1.0f / D_MODEL) + 1e-6f); }
}
template <bool OUT_F32> __device__ __forceinline__ void rms_row_b(const bf16_t* xrow, const float* w, bf16_t* ob, float* of, int lane) {
    v4u q[8]; float s = 0.f;
#pragma unroll
    for (int j = 0; j < 8; ++j) q[j] = ((const v4u*)xrow)[j * 64 + lane];
#pragma unroll
    for (int j = 0; j < 8; ++j) { const float a0 = __uint_as_float(q[j].x << 16), a1 = __uint_as_float(q[j].x & 0xffff0000u), a2 = __uint_as_float(q[j].y << 16), a3 = __uint_as_float(q[j].y & 0xffff0000u);
        const float a4 = __uint_as_float(q[j].z << 16), a5 = __uint_as_float(q[j].z & 0xffff0000u), a6 = __uint_as_float(q[j].w << 16), a7 = __uint_as_float(q[j].w & 0xffff0000u);
        s += (a0 * a0 + a1 * a1) + (a2 * a2 + a3 * a3) + (a4 * a4 + a5 * a5) + (a6 * a6 + a7 * a7); }
    s = wave_sum(s);
    const float r = rsqrtf(s * (1.0f / D_MODEL) + 1e-6f);
#pragma unroll
    for (int j = 0; j < 8; ++j) { const float4 w0 = ((const float4*)w)[(j * 64 + lane) * 2], w1 = ((const float4*)w)[(j * 64 + lane) * 2 + 1];
        const float a0 = __uint_as_float(q[j].x << 16) * r * w0.x, a1 = __uint_as_float(q[j].x & 0xffff0000u) * r * w0.y, a2 = __uint_as_float(q[j].y << 16) * r * w0.z, a3 = __uint_as_float(q[j].y & 0xffff0000u) * r * w0.w;
        const float a4 = __uint_as_float(q[j].z << 16) * r * w1.x, a5 = __uint_as_float(q[j].z & 0xffff0000u) * r * w1.y, a6 = __uint_as_float(q[j].w << 16) * r * w1.z, a7 = __uint_as_float(q[j].w & 0xffff0000u) * r * w1.w;
        if (OUT_F32) { ((float4*)of)[(j * 64 + lane) * 2] = make_float4(a0, a1, a2, a3); ((float4*)of)[(j * 64 + lane) * 2 + 1] = make_float4(a4, a5, a6, a7); }
        else { v4u o; o.x = pk2(a0, a1); o.y = pk2(a2, a3); o.z = pk2(a4, a5); o.w = pk2(a6, a7); ((v4u*)ob)[j * 64 + lane] = o; } }
}


constexpr size_t WS_BSC = WS_CF + (size_t)BATCH * 8 * SEQ * 4;
static __device__ __forceinline__ void fox_prep(ArgsP ap, int l, LAS unsigned char* lds, int tidv, int vcu) {
    if (vcu >= BATCH * 8) return;
    const int bh = vcu, b = bh >> 3, h = bh & 7;
    const float* UM = (const float*)(ap->ws + WS_UM); float* CF = (float*)(ap->ws + WS_CF); float* BSC = (float*)(ap->ws + WS_BSC);
    const float bias = ap->in[3][l * 8 + h];
    LAS double* part = (LAS double*)lds;
    double loc[16]; double s = 0.0;
#pragma unroll
    for (int j = 0; j < 16; ++j) { const int t = tidv * 16 + j; const float x = UM[((size_t)b * SEQ + t) * LDM + MC_CF + h] + bias;
        const float ls = fminf(x, 0.f) - log1pf(expf(-fabsf(x))); s += (double)ls; loc[j] = s; }
    part[tidv] = s; __syncthreads();
    double off = 0.0; for (int i = 0; i < tidv; ++i) off += part[i];
#pragma unroll
    for (int j = 0; j < 16; ++j) { const double c = off + loc[j]; CF[(size_t)bh * SEQ + tidv * 16 + j] = (float)c; BSC[(size_t)bh * SEQ + tidv * 16 + j] = (float)(-c * 11.313708498984761); }
    __syncthreads();
}
static __device__ __forceinline__ void fox_attn_unit(const bf16_t* U, const float* bsc  , const float* cf  , float thr, bf16_t* Y, int b, int h, int qb, LAS unsigned char* ldsb, int tidv) {
    using namespace att;
    const int wid = __builtin_amdgcn_readfirstlane(tidv >> 6), lane = tidv & 63, r32 = lane & 31, hi = lane >> 5;
    const int P0 = qb * 256; const size_t brow = (size_t)b * SEQ;
    int j_lo;
    {   const float cp0 = cf[P0]; const int jd = P0 / KVBLK;
        const bool k0 = (lane <= jd) && (cp0 - cf[lane * KVBLK + KVBLK - 1] > -thr), k1 = (lane + 64 <= jd) && (cp0 - cf[(lane + 64) * KVBLK + KVBLK - 1] > -thr);
        const unsigned long long b0 = __ballot(k0), b1 = __ballot(k1);
        j_lo = b0 ? (int)__builtin_ctzll(b0) : (b1 ? 64 + (int)__builtin_ctzll(b1) : jd);
        j_lo = __builtin_amdgcn_readfirstlane(j_lo < jd ? j_lo : jd); }
    const int j_hi = (P0 + 255) / KVBLK + 1, NT = j_hi - j_lo;
    const int qlo = P0 + wid * QBLK, qm = qlo + r32 - 4 * hi;
    LAS char* V_lds = (LAS char*)ldsb; LAS char* K_lds = (LAS char*)ldsb + 2 * SHM_V;
    LAS float* wsl = (LAS float*)(ldsb + 2 * SHM_V + 2 * SHM_K) + wid * 64; LAS float* li_l = wsl; LAS float* al_l = wsl + 32;
    float m_reg = -1e30f, l_reg = 0; f32x16 o[4] = {};
    const int sr = tidv >> 4, sc = (tidv & 15) * 8, vst0 = v_st(sr, sc), vst1 = v_st(32 + sr, sc), kws = KSWZ(sr, sc * 2);
    const int vbase = (int)(uintptr_t)V_lds + v_rd_base(lane);
    const bf16_t* Kg = U + brow * LDU + C_CK + h * 128 + sc; const bf16_t* Vg = U + brow * LDU + C_CV + h * 128 + sc;
    bf16x8 qr[8];
#pragma unroll
    for (int d0 = 0; d0 < 8; ++d0) qr[d0] = *(const bf16x8*)(U + (brow + qlo + r32) * LDU + C_CQ + h * 128 + d0 * 16 + hi * 8);
    bf16x8 st_k0, st_k1, st_v0, st_v1;
#define FX_SLOAD(kb) do { st_k0 = *(const bf16x8*)(Kg + (size_t)((kb) + sr) * LDU); st_k1 = *(const bf16x8*)(Kg + (size_t)((kb) + 32 + sr) * LDU); \
                          st_v0 = *(const bf16x8*)(Vg + (size_t)((kb) + sr) * LDU); st_v1 = *(const bf16x8*)(Vg + (size_t)((kb) + 32 + sr) * LDU); } while (0)
#define FX_SWRITE(bf) do { *(LAS bf16x8*)(K_lds + (bf) * SHM_K + kws) = st_k0; *(LAS bf16x8*)(K_lds + (bf) * SHM_K + kws + 32 * 256) = st_k1; \
                           *(LAS bf16x8*)(V_lds + (bf) * SHM_V + vst0) = st_v0; *(LAS bf16x8*)(V_lds + (bf) * SHM_V + vst1) = st_v1; } while (0)
    FX_SLOAD(j_lo * KVBLK); VM_WAIT(); FX_SWRITE(0);
    __syncthreads();
    for (int t = 0; t < NT; ++t) {
        const int buf = t & 1, kb = (j_lo + t) * KVBLK;
        if (t + 1 < NT) FX_SLOAD(kb + KVBLK);
        f32x16 p0, p1;
        qkt(p0, p1, K_lds + buf * SHM_K, r32, hi, qr);
        {   const float4* bp = (const float4*)(bsc + kb);
#pragma unroll
            for (int g = 0; g < 4; ++g) { const float4 b0 = bp[2 * g + hi], b1 = bp[8 + 2 * g + hi];
                p0[4 * g + 0] += b0.x; p0[4 * g + 1] += b0.y; p0[4 * g + 2] += b0.z; p0[4 * g + 3] += b0.w;
                p1[4 * g + 0] += b1.x; p1[4 * g + 1] += b1.y; p1[4 * g + 2] += b1.z; p1[4 * g + 3] += b1.w; } }
        if (kb + KVBLK - 1 > qlo) mask_tile(p0, p1, qm - kb);
        float mn, alpha; bf16x8 pa0, pa1, pa2, pa3;
        partialSM(p0, p1, m_reg, mn, alpha);
        if (__any(alpha < 1.f)) { if (hi == 0) al_l[r32] = alpha; asm volatile("s_waitcnt lgkmcnt(0)" ::: "memory");
#pragma unroll
            for (int d_ = 0; d_ < 4; ++d_)
#pragma unroll
                for (int r = 0; r < 16; ++r) o[d_][r] *= al_l[crow(r, hi)]; }
        finishSM(p0, p1, alpha, l_reg, pa0, pa1, pa2, pa3); SBAR();
        pv_tile(o, vbase + buf * SHM_V, pa0, pa1, pa2, pa3);
        if (t + 1 < NT) { VM_WAIT(); FX_SWRITE(buf ^ 1); }
        __syncthreads();
    }
#undef FX_SLOAD
#undef FX_SWRITE
    if (hi == 0) li_l[r32] = l_reg; asm volatile("s_waitcnt lgkmcnt(0)" ::: "memory");
#pragma unroll
    for (int rh = 0; rh < 2; ++rh) {
        unsigned short gv[8][4];
#pragma unroll
        for (int r8 = 0; r8 < 8; ++r8)
#pragma unroll
            for (int d0 = 0; d0 < 4; ++d0) gv[r8][d0] = U[(brow + qlo + crow(rh * 8 + r8, hi)) * LDU + C_CG + h * 128 + d0 * 32 + r32];
#pragma unroll
        for (int r8 = 0; r8 < 8; ++r8) { const int r = rh * 8 + r8, orow = crow(r, hi); const float rl = __builtin_amdgcn_rcpf(li_l[orow]);
            const size_t grow = brow + qlo + orow;
#pragma unroll
            for (int d0 = 0; d0 < 4; ++d0) { const float y = o[d0][r] * rl * siluf_(bf2f(gv[r8][d0])); const float yn = dpp_f<0xB1>(y);
                if ((r32 & 1) == 0) *(unsigned*)(Y + grow * D_MODEL + 2 * 1024 + h * 128 + d0 * 32 + r32) = cvtpk(y, yn); } }
    }
    __syncthreads();
}
static __device__ __forceinline__ void fox_attn_phase(ArgsP ap, int l, LAS unsigned char* lds, int tidv, int vcu) {
    const bf16_t* U = (const bf16_t*)(ap->ws + WS_U); const float* BSC = (const float*)(ap->ws + WS_BSC); bf16_t* Y = (bf16_t*)(ap->ws + WS_Y);
    const float* CF = (const float*)(ap->ws + WS_CF); const float* nslot = (const float*)((const unsigned*)ap->ws + CW_FOXN) + l * 32;
    for (int pi = vcu; pi < BATCH * 8 * 16; pi += (int)gridDim.x) {
        const int bh = pi >> 4, x = pi & 15;
        const float bound = att::SCALE * sqrtf(nslot[bh * 2] * nslot[bh * 2 + 1]) * 1.001f;
        const float thr = 2.f * bound + 105.f;
        fox_attn_unit(U, BSC + (size_t)bh * SEQ, CF + (size_t)bh * SEQ, thr, Y, bh >> 3, bh & 7, 31 - x, lds, tidv);
        fox_attn_unit(U, BSC + (size_t)bh * SEQ, CF + (size_t)bh * SEQ, thr, Y, bh >> 3, bh & 7, x, lds, tidv);
    }
}

constexpr int HG_NCH = SEQ / 32;
namespace hg {
using att::bf16x8; using att::f32x16; using att::s16x4; using att::u32x4;
template <int CTRL, int ROWMASK> __device__ __forceinline__ float dppz(float v) { return __int_as_float(__builtin_amdgcn_update_dpp(0, __float_as_int(v), CTRL, ROWMASK, 0xf, true)); }
__device__ __forceinline__ float scan32(float v) {
    v += dppz<0x111, 0xf>(v); v += dppz<0x112, 0xf>(v); v += dppz<0x114, 0xf>(v); v += dppz<0x118, 0xf>(v);
    v += __int_as_float(__builtin_amdgcn_update_dpp(0, __float_as_int(v), 0x142, 0xA, 0xf, false));
    return v;
}
__device__ __forceinline__ float pick_lane(float v, int lane_lo, int hi) {
    const float a = __int_as_float(__builtin_amdgcn_readlane(__float_as_int(v), lane_lo)), b = __int_as_float(__builtin_amdgcn_readlane(__float_as_int(v), lane_lo + 32));
    return hi ? b : a;
}
__device__ __forceinline__ float cl80(float x) { return fminf(fmaxf(x, -115.4156f), 115.4156f); }
__device__ __forceinline__ bf16x8 pack8f(const float (&v)[8]) { u32x4 w = {att::cvtpk(v[0], v[1]), att::cvtpk(v[2], v[3]), att::cvtpk(v[4], v[5]), att::cvtpk(v[6], v[7])}; return *reinterpret_cast<bf16x8*>(&w); }
__device__ __forceinline__ void unpack8(const bf16x8 x, float (&v)[8]) { const u32x4 w = *reinterpret_cast<const u32x4*>(&x);
    v[0] = __uint_as_float(w.x << 16); v[1] = __uint_as_float(w.x & 0xffff0000u); v[2] = __uint_as_float(w.y << 16); v[3] = __uint_as_float(w.y & 0xffff0000u);
    v[4] = __uint_as_float(w.z << 16); v[5] = __uint_as_float(w.z & 0xffff0000u); v[6] = __uint_as_float(w.w << 16); v[7] = __uint_as_float(w.w & 0xffff0000u); }
__device__ __forceinline__ void stage_vtile(const bf16_t* g, size_t ld, LAS char* tile, int lane) {
    bf16x8 t[8];
#pragma unroll
    for (int i = 0; i < 8; ++i) t[i] = *(const bf16x8*)(g + (size_t)(i * 4 + (lane >> 4)) * ld + (lane & 15) * 8);
#pragma unroll
    for (int i = 0; i < 8; ++i) *(LAS bf16x8*)(tile + att::v_st(i * 4 + (lane >> 4), (lane & 15) * 8)) = t[i];
}
#define HG_TRRD(dst, base, off) asm volatile("ds_read_b64_tr_b16 %0, %1 offset:%2" : "=&v"(dst) : "v"(base), "i"(off) : "memory")
#define HG_FRAG2(f0, f1, base, cb) do { s16x4 l0_, h0_, l1_, h1_; HG_TRRD(l0_, base, (cb) * 512); HG_TRRD(h0_, base, (cb) * 512 + 2048); HG_TRRD(l1_, base, (cb) * 512 + 4096); HG_TRRD(h1_, base, (cb) * 512 + 6144); \
        asm volatile("s_waitcnt lgkmcnt(0)" ::: "memory"); __builtin_amdgcn_sched_barrier(0); \
        f0 = (bf16x8){l0_[0], l0_[1], l0_[2], l0_[3], h0_[0], h0_[1], h0_[2], h0_[3]}; f1 = (bf16x8){l1_[0], l1_[1], l1_[2], l1_[3], h1_[0], h1_[1], h1_[2], h1_[3]}; } while (0)

static __device__ __forceinline__ void h1_chunk(const bf16_t* U, const float* lb, bf16_t* UT, float* Dc, int cu, LAS char* wl, int lane) {
    const int r32 = lane & 31, hi = lane >> 5;
    const int bh = cu / HG_NCH, c = cu % HG_NCH, b = bh >> 3, h = bh & 7;
    const size_t row0 = (size_t)b * SEQ + c * 32;
    LAS char* Vt = wl; LAS char* Kt = wl + 8192;
    stage_vtile(U + row0 * LDU + C_DI + h * 128, LDU, Vt, lane);
    const bf16_t* fr = U + (row0 + r32) * LDU + C_DF + h * 128 + hi * 8;
#pragma unroll
    for (int d0 = 0; d0 < 8; ++d0) {
        float x[8], lbv[8], kk[8], bc[8], kt[8];
        unpack8(*(const bf16x8*)(fr + d0 * 16), x);
        { const float4 a = *(const float4*)(lb + h * 128 + d0 * 16 + hi * 8), bq = *(const float4*)(lb + h * 128 + d0 * 16 + hi * 8 + 4);
          lbv[0] = a.x; lbv[1] = a.y; lbv[2] = a.z; lbv[3] = a.w; lbv[4] = bq.x; lbv[5] = bq.y; lbv[6] = bq.z; lbv[7] = bq.w; }
#pragma unroll
        for (int j = 0; j < 8; ++j) { const float f = lbv[j] + (1.0f - lbv[j]) * sigmoidf_(x[j]); kk[j] = 1.0f - f; bc[j] = scan32(__builtin_amdgcn_logf(f)); }
        float dl[8];
#pragma unroll
        for (int j = 0; j < 8; ++j) { const float last = pick_lane(bc[j], 31, hi); kt[j] = kk[j] * __builtin_amdgcn_exp2f(last - bc[j]); dl[j] = __builtin_amdgcn_exp2f(last); }
        *(LAS bf16x8*)(Kt + att::v_st(r32, d0 * 16 + hi * 8)) = pack8f(kt);
        if (r32 == 0) { float* dp = Dc + (size_t)cu * 128 + d0 * 16 + hi * 8; *(float4*)dp = make_float4(dl[0], dl[1], dl[2], dl[3]); *(float4*)(dp + 4) = make_float4(dl[4], dl[5], dl[6], dl[7]); }
    }
    asm volatile("s_waitcnt lgkmcnt(0)" ::: "memory");
    const int vb = (int)(uintptr_t)Vt + att::v_rd_base(lane), kb = (int)(uintptr_t)Kt + att::v_rd_base(lane);
    bf16x8 kf[4][2];
#pragma unroll
    for (int dblk = 0; dblk < 4; ++dblk) HG_FRAG2(kf[dblk][0], kf[dblk][1], kb, dblk);
    bf16_t* out = UT + (size_t)cu * 16384;
#pragma unroll
    for (int e0 = 0; e0 < 4; ++e0) {
        bf16x8 v0, v1; HG_FRAG2(v0, v1, vb, e0);
#pragma unroll
        for (int dblk = 0; dblk < 4; ++dblk) {
            f32x16 acc = {};
            acc = __builtin_amdgcn_mfma_f32_32x32x16_bf16(v0, kf[dblk][0], acc, 0, 0, 0);
            acc = __builtin_amdgcn_mfma_f32_32x32x16_bf16(v1, kf[dblk][1], acc, 0, 0, 0);
#pragma unroll
            for (int r = 0; r < 16; ++r) { const float v = acc[r], vn = dpp_f<0xB1>(v);
                if ((r32 & 1) == 0) *(unsigned*)(out + (size_t)(e0 * 32 + att::crow(r, hi)) * 128 + dblk * 32 + r32) = att::cvtpk(v, vn); }
        }
    }
}
static __device__ __forceinline__ void h3_chunk(const bf16_t* U, const float* lb, const bf16_t* ST, const float* nw, bf16_t* Y, int cu, LAS char* wl, int lane) {
    const int r32 = lane & 31, hi = lane >> 5;
    const int bh = cu / HG_NCH, c = cu % HG_NCH, b = bh >> 3, h = bh & 7;
    const size_t row0 = (size_t)b * SEQ + c * 32;
    LAS char* Vt = wl;
    stage_vtile(U + row0 * LDU + C_DI + h * 128, LDU, Vt, lane);
    const bf16_t* fr = U + (row0 + r32) * LDU + C_DF + h * 128 + hi * 8; const bf16_t* qrp = U + (row0 + r32) * LDU + C_DQ + h * 128 + hi * 8;
    bf16x8 qi[8], qd[8], kd[8];
#pragma unroll
    for (int d0 = 0; d0 < 8; ++d0) {
        float x[8], q[8], lbv[8], a[8], bq_[8], cc[8];
        unpack8(*(const bf16x8*)(fr + d0 * 16), x); unpack8(*(const bf16x8*)(qrp + d0 * 16), q);
        { const float4 a4 = *(const float4*)(lb + h * 128 + d0 * 16 + hi * 8), b4 = *(const float4*)(lb + h * 128 + d0 * 16 + hi * 8 + 4);
          lbv[0] = a4.x; lbv[1] = a4.y; lbv[2] = a4.z; lbv[3] = a4.w; lbv[4] = b4.x; lbv[5] = b4.y; lbv[6] = b4.z; lbv[7] = b4.w; }
#pragma unroll
        for (int j = 0; j < 8; ++j) { const float f = lbv[j] + (1.0f - lbv[j]) * sigmoidf_(x[j]); const float bc = scan32(__builtin_amdgcn_logf(f)); const float mid = pick_lane(bc, 15, hi);
            a[j] = q[j] * __builtin_amdgcn_exp2f(bc); bq_[j] = q[j] * __builtin_amdgcn_exp2f(cl80(bc - mid)); cc[j] = (1.0f - f) * __builtin_amdgcn_exp2f(cl80(mid - bc)); }
        qi[d0] = pack8f(a); qd[d0] = pack8f(bq_); kd[d0] = pack8f(cc);
    }
    f32x16 p = {};
#pragma unroll
    for (int d0 = 0; d0 < 8; ++d0) p = __builtin_amdgcn_mfma_f32_32x32x16_bf16(kd[d0], qd[d0], p, 0, 0, 0);
#pragma unroll
    for (int r = 0; r < 16; ++r) if (att::crow(r, hi) > r32) p[r] = 0.f;
    bf16x8 pa0, pa1;
#define HG_PK4(P, B_, OUT) do { unsigned a0 = att::cvtpk(P[B_+0], P[B_+1]), a1 = att::cvtpk(P[B_+2], P[B_+3]); unsigned b0 = att::cvtpk(P[B_+4], P[B_+5]), b1 = att::cvtpk(P[B_+6], P[B_+7]); \
        auto r0 = __builtin_amdgcn_permlane32_swap(a0, b0, false, false); auto r1 = __builtin_amdgcn_permlane32_swap(a1, b1, false, false); \
        u32x4 w = {r0[0], r1[0], r0[1], r1[1]}; OUT = *reinterpret_cast<bf16x8*>(&w); } while (0)
    HG_PK4(p, 0, pa0); HG_PK4(p, 8, pa1);
#undef HG_PK4
    asm volatile("s_waitcnt lgkmcnt(0)" ::: "memory");
    const int vb = (int)(uintptr_t)Vt + att::v_rd_base(lane);
    const bf16_t* st = ST + (size_t)cu * 16384;
    f32x16 o[4];
#pragma unroll
    for (int e0 = 0; e0 < 4; ++e0) {
        bf16x8 v0, v1; HG_FRAG2(v0, v1, vb, e0);
        f32x16 acc = {};
        acc = __builtin_amdgcn_mfma_f32_32x32x16_bf16(v0, pa0, acc, 0, 0, 0);
        acc = __builtin_amdgcn_mfma_f32_32x32x16_bf16(v1, pa1, acc, 0, 0, 0);
#pragma unroll
        for (int d0 = 0; d0 < 8; ++d0) { const bf16x8 sf = *(const bf16x8*)(st + (size_t)(e0 * 32 + r32) * 128 + d0 * 16 + hi * 8);
            acc = __builtin_amdgcn_mfma_f32_32x32x16_bf16(sf, qi[d0], acc, 0, 0, 0); }
        o[e0] = acc;
    }
    float ss = 0.f;
#pragma unroll
    for (int e0 = 0; e0 < 4; ++e0)
#pragma unroll
        for (int r = 0; r < 16; ++r) ss += o[e0][r] * o[e0][r];
    { auto rr = __builtin_amdgcn_permlane32_swap(__float_as_uint(ss), __float_as_uint(ss), false, false); ss = __uint_as_float(rr[0]) + __uint_as_float(rr[1]); }
    const float rinv = rsqrtf(ss * (1.0f / 128.0f) + 1e-6f);
    const bf16_t* gp = U + (row0 + r32) * LDU + C_DG + h * 128; bf16_t* yp = Y + (row0 + r32) * D_MODEL + 3 * 1024 + h * 128;
#pragma unroll
    for (int e0 = 0; e0 < 4; ++e0)
#pragma unroll
        for (int g4 = 0; g4 < 4; ++g4) { const int e = e0 * 32 + 8 * g4 + 4 * hi;
            const uint2 gg = *(const uint2*)(gp + e); const float4 ww = *(const float4*)(nw + h * 128 + e);
            const float y0 = o[e0][4 * g4 + 0] * rinv * ww.x * siluf_(__uint_as_float(gg.x << 16)), y1 = o[e0][4 * g4 + 1] * rinv * ww.y * siluf_(__uint_as_float(gg.x & 0xffff0000u));
            const float y2 = o[e0][4 * g4 + 2] * rinv * ww.z * siluf_(__uint_as_float(gg.y << 16)), y3 = o[e0][4 * g4 + 3] * rinv * ww.w * siluf_(__uint_as_float(gg.y & 0xffff0000u));
            *(uint2*)(yp + e) = make_uint2(att::cvtpk(y0, y1), att::cvtpk(y2, y3)); }
}
#undef HG_FRAG2
#undef HG_TRRD
}

static __device__ __forceinline__ void hgrn_h1_phase(ArgsP ap, int l, LAS unsigned char* lds, int tidv, int vcu) {
    const bf16_t* U = (const bf16_t*)(ap->ws + WS_U); const float* lb = (const float*)(ap->ws + WS_LB) + l * 1024; bf16_t* UT = (bf16_t*)(ap->ws + WS_HUT); float* Dc = (float*)(ap->ws + WS_HD);
    const int lane = tidv & 63, wave = __builtin_amdgcn_readfirstlane(tidv >> 6);
    LAS char* wl = (LAS char*)lds + wave * 16384;
    for (int cu = vcu * NWAVES + wave; cu < BATCH * 8 * HG_NCH; cu += (int)gridDim.x * NWAVES) hg::h1_chunk(U, lb, UT, Dc, cu, wl, lane);
}
static __device__ __forceinline__ void hgrn_h2_phase(ArgsP ap, int tidv, int vcu) {
    const bf16_t* UT = (const bf16_t*)(ap->ws + WS_HUT); const float* Dc = (const float*)(ap->ws + WS_HD); bf16_t* ST = (bf16_t*)(ap->ws + WS_HST);
    for (int gt = vcu * (NWAVES * 64) + tidv; gt < BATCH * 8 * 128 * 64; gt += (int)gridDim.x * NWAVES * 64) {
        const int bh = gt >> 13, e = (gt >> 6) & 127, d2 = (gt & 63) * 2;
        const size_t base = (size_t)bh * HG_NCH * 16384 + (size_t)e * 128 + d2; const float* dp = Dc + (size_t)bh * HG_NCH * 128 + d2;
        float s0 = 0.f, s1 = 0.f;
        for (int c0 = 0; c0 < HG_NCH; c0 += 16) {
            unsigned uu[16]; float2 dd[16];
#pragma unroll
            for (int j = 0; j < 16; ++j) { uu[j] = *(const unsigned*)(UT + base + (size_t)(c0 + j) * 16384); dd[j] = *(const float2*)(dp + (size_t)(c0 + j) * 128); }
            unsigned so[16];
#pragma unroll
            for (int j = 0; j < 16; ++j) { so[j] = att::cvtpk(s0, s1); s0 = dd[j].x * s0 + __uint_as_float(uu[j] << 16); s1 = dd[j].y * s1 + __uint_as_float(uu[j] & 0xffff0000u); }
#pragma unroll
            for (int j = 0; j < 16; ++j) *(unsigned*)(ST + base + (size_t)(c0 + j) * 16384) = so[j];
        }
    }
}
static __device__ __forceinline__ void hgrn_h3_phase(ArgsP ap, int l, LAS unsigned char* lds, int tidv, int vcu) {
    const bf16_t* U = (const bf16_t*)(ap->ws + WS_U); const float* lb = (const float*)(ap->ws + WS_LB) + l * 1024; const bf16_t* ST = (const bf16_t*)(ap->ws + WS_HST);
    const float* nw = ap->in[6] + (size_t)l * 1024; bf16_t* Y = (bf16_t*)(ap->ws + WS_Y);
    const int lane = tidv & 63, wave = __builtin_amdgcn_readfirstlane(tidv >> 6);
    LAS char* wl = (LAS char*)lds + wave * 16384;
    for (int cu = vcu * NWAVES + wave; cu < BATCH * 8 * HG_NCH; cu += (int)gridDim.x * NWAVES) hg::h3_chunk(U, lb, ST, nw, Y, cu, wl, lane);
}

__device__ __forceinline__ void unpk8(const v4u w, float (&v)[8]) {
    v[0] = __uint_as_float(w.x << 16); v[1] = __uint_as_float(w.x & 0xffff0000u); v[2] = __uint_as_float(w.y << 16); v[3] = __uint_as_float(w.y & 0xffff0000u);
    v[4] = __uint_as_float(w.z << 16); v[5] = __uint_as_float(w.z & 0xffff0000u); v[6] = __uint_as_float(w.w << 16); v[7] = __uint_as_float(w.w & 0xffff0000u); }
static __device__ __forceinline__ void conv_phase(ArgsP ap, int l, int tidv, int vcu) {
    const bf16_t* U = (const bf16_t*)(ap->ws + WS_U); const float* cw = ap->in[4] + (size_t)l * 3 * 1024; bf16_t* Y = (bf16_t*)(ap->ws + WS_Y);
    const int wv = __builtin_amdgcn_readfirstlane(tidv >> 6), ln = tidv & 63, c0 = ln * 16;
    float mq0 = 0.f, mk0 = 0.f, mq1 = 0.f, mk1 = 0.f;
    for (int row = vcu * NWAVES + wv; row < MTOK; row += (int)gridDim.x * NWAVES) {
        const int t = row % SEQ; const bf16_t* u0 = U + (size_t)row * LDU;
        v4u bc[3][2], bx[3][2];
#pragma unroll
        for (int j = 0; j < 3; ++j) { const int back = (t - 2 + j >= 0) ? 2 - j : 0; const bf16_t* ur = u0 - (size_t)back * LDU;
#pragma unroll
            for (int hh = 0; hh < 2; ++hh) { bc[j][hh] = *(const v4u*)(ur + C_BC + c0 + 8 * hh); bx[j][hh] = *(const v4u*)(ur + C_BX + c0 + 8 * hh); } }
        v4u bb[2], bg[2], qv[2], kv[2];
#pragma unroll
        for (int hh = 0; hh < 2; ++hh) { bb[hh] = *(const v4u*)(u0 + C_BB + c0 + 8 * hh); bg[hh] = *(const v4u*)(u0 + C_BG + c0 + 8 * hh);
            qv[hh] = *(const v4u*)(u0 + C_CQ + c0 + 8 * hh); kv[hh] = *(const v4u*)(u0 + C_CK + c0 + 8 * hh); }
        float q2 = 0.f, k2 = 0.f;
#pragma unroll
        for (int hh = 0; hh < 2; ++hh) {
            float acc[8] = {0.f, 0.f, 0.f, 0.f, 0.f, 0.f, 0.f, 0.f};
#pragma unroll
            for (int j = 0; j < 3; ++j) { float a[8], x[8]; unpk8(bc[j][hh], a); unpk8(bx[j][hh], x);
                const float4 w0 = *(const float4*)(cw + j * 1024 + c0 + 8 * hh), w1 = *(const float4*)(cw + j * 1024 + c0 + 8 * hh + 4);
                const float wz = (t - 2 + j >= 0) ? 1.f : 0.f;
                acc[0] += wz * w0.x * (a[0] * x[0]); acc[1] += wz * w0.y * (a[1] * x[1]); acc[2] += wz * w0.z * (a[2] * x[2]); acc[3] += wz * w0.w * (a[3] * x[3]);
                acc[4] += wz * w1.x * (a[4] * x[4]); acc[5] += wz * w1.y * (a[5] * x[5]); acc[6] += wz * w1.z * (a[6] * x[6]); acc[7] += wz * w1.w * (a[7] * x[7]); }
            float b8[8], g8[8], y[8]; unpk8(bb[hh], b8); unpk8(bg[hh], g8);
#pragma unroll
            for (int i = 0; i < 8; ++i) y[i] = b8[i] * acc[i] * siluf_(g8[i]);
            v4u o; o.x = pg8::cvt_pk_bf16(y[0], y[1]); o.y = pg8::cvt_pk_bf16(y[2], y[3]); o.z = pg8::cvt_pk_bf16(y[4], y[5]); o.w = pg8::cvt_pk_bf16(y[6], y[7]);
            *(v4u*)(Y + (size_t)row * D_MODEL + 1024 + c0 + 8 * hh) = o;
            float qq[8], kk[8]; unpk8(qv[hh], qq); unpk8(kv[hh], kk);
#pragma unroll
            for (int i = 0; i < 8; ++i) { q2 += qq[i] * qq[i]; k2 += kk[i] * kk[i]; }
        }
        q2 += dpp_f<0xB1>(q2); k2 += dpp_f<0xB1>(k2); q2 += dpp_f<0x4E>(q2); k2 += dpp_f<0x4E>(k2); q2 += dpp_f<0x141>(q2); k2 += dpp_f<0x141>(k2);
        if (row < SEQ) { mq0 = fmaxf(mq0, q2); mk0 = fmaxf(mk0, k2); } else { mq1 = fmaxf(mq1, q2); mk1 = fmaxf(mk1, k2); }
    }
    if ((ln & 7) == 0) { unsigned* slot = (unsigned*)ap->ws + CW_FOXN + ((l * 2 + 0) * 8 + (ln >> 3)) * 2;
        atomicMax(slot, __float_as_uint(mq0)); atomicMax(slot + 1, __float_as_uint(mk0)); atomicMax(slot + 16, __float_as_uint(mq1)); atomicMax(slot + 17, __float_as_uint(mk1)); }
}
static __device__ __forceinline__ void dsa_score_unit(const bf16_t* U, const float* UM, const bf16_t* IKB, unsigned short* score, int b, int qblk, int tidv) {
    using att::bf16x8; using att::f32x16;
    const int wave = __builtin_amdgcn_readfirstlane(tidv >> 6), lane = tidv & 63, r = lane & 31, hi = lane >> 5;
    const size_t brow = (size_t)b * SEQ; const int t0 = qblk * 32 + wave * 4;
    const int qq = (r >> 2) & 1, head = (r & 3) + 4 * (r >> 3);
    bf16x8 A[2][4]; float w[2][16];
#pragma unroll
    for (int s = 0; s < 2; ++s) {
        const bf16_t* qp = U + (brow + t0 + 2 * s + qq) * LDU + C_AIQ + head * 64 + 8 * hi;
#pragma unroll
        for (int ks = 0; ks < 4; ++ks) A[s][ks] = *(const bf16x8*)(qp + ks * 16);
        const float* wp = UM + (brow + t0 + 2 * s + hi) * LDM + MC_IW;
#pragma unroll
        for (int g = 0; g < 4; ++g) { const float4 x = *(const float4*)(wp + 4 * g); w[s][4 * g] = x.x * (1.0f / 32.0f); w[s][4 * g + 1] = x.y * (1.0f / 32.0f); w[s][4 * g + 2] = x.z * (1.0f / 32.0f); w[s][4 * g + 3] = x.w * (1.0f / 32.0f); }
    }
    const int nblk = (qblk + 2) >> 1;
    const bf16_t* kp = IKB + (brow >> 5) * 2048 + (size_t)lane * 8;
    unsigned* sp0 = (unsigned*)(score + (brow + t0 + hi) * SCPH) + r; unsigned* sp1 = (unsigned*)(score + (brow + t0 + 2 + hi) * SCPH) + r;
    bf16x8 B[2][4], Bn[2][4];
#pragma unroll
    for (int g = 0; g < 2; ++g)
#pragma unroll
        for (int ks = 0; ks < 4; ++ks) B[g][ks] = *(const bf16x8*)(kp + (size_t)g * 2048 + ks * 512);
    for (int tb = 0; tb < nblk; ++tb) {
        const int tn = tb + 1 < nblk ? tb + 1 : tb;
#pragma unroll
        for (int g = 0; g < 2; ++g)
#pragma unroll
            for (int ks = 0; ks < 4; ++ks) Bn[g][ks] = *(const bf16x8*)(kp + (size_t)(2 * tn + g) * 2048 + ks * 512);
        f32x16 c[2][2] = {};
#pragma unroll
        for (int ks = 0; ks < 4; ++ks)
#pragma unroll
            for (int g = 0; g < 2; ++g) { c[g][0] = __builtin_amdgcn_mfma_f32_32x32x16_bf16(A[0][ks], B[g][ks], c[g][0], 0, 0, 0); c[g][1] = __builtin_amdgcn_mfma_f32_32x32x16_bf16(A[1][ks], B[g][ks], c[g][1], 0, 0, 0); }
        float sc[2][2];
#pragma unroll
        for (int g = 0; g < 2; ++g) {
            float s0a = 0.f, s0b = 0.f, s1a = 0.f, s1b = 0.f;
#pragma unroll
            for (int i = 0; i < 16; i += 2) {
                s0a += w[0][i] * __builtin_amdgcn_fmed3f(c[g][0][i], 0.f, 3.0e38f); s0b += w[0][i + 1] * __builtin_amdgcn_fmed3f(c[g][0][i + 1], 0.f, 3.0e38f);
                s1a += w[1][i] * __builtin_amdgcn_fmed3f(c[g][1][i], 0.f, 3.0e38f); s1b += w[1][i + 1] * __builtin_amdgcn_fmed3f(c[g][1][i + 1], 0.f, 3.0e38f); }
            sc[g][0] = s0a + s0b; sc[g][1] = s1a + s1b;
        }
        sp0[tb * 32] = __builtin_bit_cast(unsigned, __builtin_amdgcn_cvt_pkrtz(sc[0][0], sc[1][0]));
        sp1[tb * 32] = __builtin_bit_cast(unsigned, __builtin_amdgcn_cvt_pkrtz(sc[0][1], sc[1][1]));
#pragma unroll
        for (int g = 0; g < 2; ++g)
#pragma unroll
            for (int ks = 0; ks < 4; ++ks) B[g][ks] = Bn[g][ks];
    }
}
static __device__ __forceinline__ void dsa_score_phase(ArgsP ap, int tidv, int vcu) {
    const bf16_t* U = (const bf16_t*)(ap->ws + WS_U); const float* UM = (const float*)(ap->ws + WS_UM); const bf16_t* IKB = (const bf16_t*)(ap->ws + WS_IKB); unsigned short* score = (unsigned short*)(ap->ws + WS_SCORE);
    for (int pi = vcu; pi < BATCH * 128; pi += (int)gridDim.x) {
        const int b = pi >> 7, x = pi & 127;
        dsa_score_unit(U, UM, IKB, score, b, 255 - x, tidv);
        dsa_score_unit(U, UM, IKB, score, b, x, tidv);
    }
}
template <int NR> static __device__ __forceinline__ void dsa_topk_row_n(const float* sr, int* out, int n, int lane) {
    unsigned key[NR];
#pragma unroll
    for (int i = 0; i < NR; ++i) { const int s = i * 64 + lane;
        const unsigned bts = __float_as_uint(sr[s < n ? s : n - 1]); const unsigned k = bts ^ ((bts >> 31) ? 0xFFFFFFFFu : 0x80000000u);
        key[i] = s < n ? k : 0u; }
    unsigned T = 0u; int cT = n;
    for (int bit = 31; bit >= 0 && cT != 256; --bit) {
        const unsigned cand = T | (1u << bit); int c = 0;
#pragma unroll
        for (int i = 0; i < NR; ++i) c += (key[i] >= cand) ? 1 : 0;
        c = wave_sum_i(c);
        if (c >= 256) { T = cand; cT = c; }
    }
    int need = 0; unsigned Tg = (T ? T : 1u) - 1u;
    if (cT != 256) {
        int cgt = 0;
#pragma unroll
        for (int i = 0; i < NR; ++i) cgt += (key[i] > T) ? 1 : 0;
        cgt = wave_sum_i(cgt); need = 256 - cgt; Tg = T;
    }
    int base = 0;
    const unsigned long long lmask = (lane == 0) ? 0ull : (~0ull >> (64 - lane));
#pragma unroll
    for (int i = 0; i < NR; ++i) {
        const bool gt = key[i] > Tg, eq = (need > 0) && key[i] == T;
        const unsigned long long beq = __ballot(eq);
        const int eqrank = __popcll(beq & lmask);
        const bool sel = gt || (eq && eqrank < need);
        const unsigned long long bsel = __ballot(sel);
        if (sel) out[base + __popcll(bsel & lmask)] = i * 64 + lane;
        base += __popcll(bsel);
        const int neq = __popcll(beq); need -= neq < need ? neq : need;
    }
}
__device__ __forceinline__ unsigned wave_max_u(unsigned v) {
    v = max(v, (unsigned)dpp_i<0xB1>((int)v)); v = max(v, (unsigned)dpp_i<0x4E>((int)v)); v = max(v, (unsigned)dpp_i<0x141>((int)v)); v = max(v, (unsigned)dpp_i<0x140>((int)v));
    return max(max((unsigned)__builtin_amdgcn_readlane((int)v, 0), (unsigned)__builtin_amdgcn_readlane((int)v, 16)), max((unsigned)__builtin_amdgcn_readlane((int)v, 32), (unsigned)__builtin_amdgcn_readlane((int)v, 48)));
}
template <int NC> static __device__ __forceinline__ void topk_final(LAS const unsigned* cand, int c0, unsigned Tlo, int* out, int lane) {
    unsigned ck[NC], ci[NC];
#pragma unroll
    for (int j = 0; j < NC; ++j) { const int p = j * 64 + lane; ck[j] = p < c0 ? cand[p] : 0u; ci[j] = cand[1024 + p]; }
    unsigned mx = 0u;
#pragma unroll
    for (int j = 0; j < NC; ++j) mx = max(mx, ck[j]);
    mx = wave_max_u(mx);
    const unsigned diff = mx ^ Tlo; const int hb = diff ? 31 - __builtin_clz(diff) : -1;
    unsigned T = hb >= 0 ? (Tlo & ~((2u << hb) - 1u)) : Tlo; int cT = c0;
    for (int bit = hb; bit >= 16 && cT != 256; --bit) {
        const unsigned cnd = T | (1u << bit); int c = 0;
#pragma unroll
        for (int j = 0; j < NC; ++j) c += (ck[j] >= cnd) ? 1 : 0;
        c = wave_sum_i(c);
        if (c >= 256) { T = cnd; cT = c; }
    }
    int need = 0; unsigned Tg = (T ? T : 1u) - 1u;
    if (cT != 256) {
        int cgt = 0;
#pragma unroll
        for (int j = 0; j < NC; ++j) cgt += (ck[j] > T) ? 1 : 0;
        cgt = wave_sum_i(cgt); need = 256 - cgt; Tg = T;
    }
    int base = 0;
    const unsigned long long lmask = (lane == 0) ? 0ull : (~0ull >> (64 - lane));
#pragma unroll
    for (int j = 0; j < NC; ++j) {
        const bool gt = ck[j] > Tg, eq = (need > 0) && ck[j] == T;
        const unsigned long long beq = __ballot(eq);
        const int eqrank = __popcll(beq & lmask);
        const bool sel = gt || (eq && eqrank < need);
        const unsigned long long bsel = __ballot(sel);
        if (sel) out[base + __popcll(bsel & lmask)] = (int)ci[j];
        base += __popcll(bsel);
        const int neq = __popcll(beq); need -= neq < need ? neq : need;
    }
}
template <int NR> static __device__ __forceinline__ bool dsa_topk_row_fast(const unsigned short* sr, int* out, int n, int lane, LAS unsigned* cand) {
    constexpr int NG = NR / 8;
    unsigned key[NR];
    int lane8 = 8 * lane; asm volatile("" : "+v"(lane8));
#pragma unroll
    for (int j = 0; j < NG; ++j) { const v4u v = *(const v4u*)((const char*)sr + (size_t)j * 1024 + (unsigned)(lane8 * 2)); const int nj = n - 512 * j;
        const unsigned wv[4] = {v.x, v.y, v.z, v.w};
#pragma unroll
        for (int q = 0; q < 4; ++q) {
            typedef short s16x2_t __attribute__((ext_vector_type(2)));
            const unsigned sg = __builtin_bit_cast(unsigned, __builtin_bit_cast(s16x2_t, wv[q]) >> (s16x2_t){15, 15});
            const unsigned tq = wv[q] ^ (sg | 0x80008000u);
            key[8 * j + 2 * q] = tq << 16; key[8 * j + 2 * q + 1] = tq & 0xffff0000u; }
        if (nj < 512) {
#pragma unroll
            for (int c = 0; c < 8; ++c) key[8 * j + c] = lane8 < nj - c ? key[8 * j + c] : 0u; } }
    constexpr int SG = NG / 4 > 0 ? NG / 4 : 1;
    const unsigned sk[4] = {key[0], key[(8 * SG) % NR], key[(16 * SG) % NR], key[(24 * SG) % NR]};
    int ns = 0;
#pragma unroll
    for (int q = 0; q < 4; ++q) { const int v = (n - 512 * ((q * SG) % NG) + 7) >> 3; ns += v < 0 ? 0 : (v > 64 ? 64 : v); }
    const float ctf = 256.f + 2.f * sqrtf(256.f * (float)n / (float)ns);
    int m = (int)(ctf * (float)ns / (float)n) + 1; m = m > ns ? ns : m;
    unsigned T0 = 1u << 16; int c0 = n;
    for (int tries = 0; tries < 4; ++tries) {
        unsigned Ts = 0u; int cs = 256;
        for (int bit = 31; bit >= 18 && cs != m; --bit) {
            const unsigned cnd = Ts | (1u << bit);
            int c = ((sk[0] >= cnd) ? 1 : 0) + ((sk[1] >= cnd) ? 1 : 0) + ((sk[2] >= cnd) ? 1 : 0) + ((sk[3] >= cnd) ? 1 : 0);
            c = wave_sum_i(c);
            if (c >= m) { Ts = cnd; cs = c; }
        }
        if (Ts == 0u) Ts = 1u << 16;
        int c = 0;
#pragma unroll
        for (int i = 0; i < NR; ++i) c += (key[i] >= Ts) ? 1 : 0;
        c = wave_sum_i(c);
        if (c >= 256) { T0 = Ts; c0 = c; break; }
        if (m >= ns) break;
        m = 2 * m + 8; m = m > ns ? ns : m;
    }
    bool mass_ties = false; unsigned Tt = 0u; int cgt_t = 0;
    if (c0 > 1024) {
        unsigned T = 0u; int cT = n;
        for (int bit = 31; bit >= 16 && cT != 256; --bit) {
            const unsigned cnd = T | (1u << bit); int c = 0;
#pragma unroll
            for (int i = 0; i < NR; ++i) c += (key[i] >= cnd) ? 1 : 0;
            c = wave_sum_i(c);
            if (c >= 256) { T = cnd; cT = c; }
        }
        T0 = T; c0 = cT;
        if (cT > 1024) {
            int c = 0;
#pragma unroll
            for (int i = 0; i < NR; ++i) c += (key[i] > T) ? 1 : 0;
            mass_ties = true; Tt = T; cgt_t = wave_sum_i(c); }
    }
    if (mass_ties) {
        int base = 0, ebase = cgt_t;
#pragma unroll
        for (int j = 0; j < NG; ++j) {
            bool e[8]; unsigned long long qe[8]; int erank = 0;
#pragma unroll
            for (int c = 0; c < 8; ++c) { const unsigned k = key[8 * j + c]; const bool g = k > Tt; e[c] = k == Tt && k != 0u;
                const unsigned long long qg = __ballot(g); qe[c] = __ballot(e[c]);
                if (g) out[base + (int)__builtin_amdgcn_mbcnt_hi((unsigned)(qg >> 32), __builtin_amdgcn_mbcnt_lo((unsigned)qg, 0u))] = lane8 + (512 * j + c);
                base += __popcll(qg);
                erank += (int)__builtin_amdgcn_mbcnt_hi((unsigned)(qe[c] >> 32), __builtin_amdgcn_mbcnt_lo((unsigned)qe[c], 0u)); }
            int pe = ebase + erank;
#pragma unroll
            for (int c = 0; c < 8; ++c) { if (e[c] && pe < 256) out[pe] = lane8 + (512 * j + c); pe += e[c] ? 1 : 0; ebase += __popcll(qe[c]); }
        }
        return true;
    }
    int base = 0;
#pragma unroll
    for (int j = 0; j < NG; ++j) {
        bool p[8]; int cnt = 0;
#pragma unroll
        for (int c = 0; c < 8; ++c) { p[c] = key[8 * j + c] >= T0; cnt += p[c] ? 1 : 0; }
        int inc = cnt;
        inc += __builtin_amdgcn_update_dpp(0, inc, 0x111, 0xf, 0xf, true); inc += __builtin_amdgcn_update_dpp(0, inc, 0x112, 0xf, 0xf, true);
        inc += __builtin_amdgcn_update_dpp(0, inc, 0x114, 0xf, 0xf, true); inc += __builtin_amdgcn_update_dpp(0, inc, 0x118, 0xf, 0xf, true);
        inc += __builtin_amdgcn_update_dpp(0, inc, 0x142, 0xA, 0xf, false);
        inc += __builtin_amdgcn_update_dpp(0, inc, 0x143, 0xC, 0xf, false);
        int pos = base + inc - cnt; base += __builtin_amdgcn_readlane(inc, 63);
#pragma unroll
        for (int c = 0; c < 8; ++c) { if (p[c]) { cand[pos] = key[8 * j + c]; cand[1024 + pos] = (unsigned)(lane8 + (512 * j + c)); } pos += p[c] ? 1 : 0; }
    }
    asm volatile("s_waitcnt lgkmcnt(0)" ::: "memory");
    if (c0 <= 512) topk_final<8>(cand, c0, T0, out, lane); else topk_final<16>(cand, c0, T0, out, lane);
    return true;
}
static __device__ __forceinline__ void dsa_topk_row(const unsigned short* score, int* idx, int row, int lane, LAS unsigned* cand) {
    asm volatile("" : "+v"(lane));
    const int t = row % SEQ, n = t + 1;
    int* out = idx + (size_t)row * 256;
    if (n <= 256) {
#pragma unroll
        for (int j = 0; j < 4; ++j) { const int p = j * 64 + lane; out[p] = p < n ? p : -1; }
        return;
    }
    const unsigned short* sr = score + (size_t)row * SCPH;
    if (n <= 2048) (void)dsa_topk_row_fast<32>(sr, out, n, lane, cand);
    else if (n <= 3072) (void)dsa_topk_row_fast<48>(sr, out, n, lane, cand);
    else if (n <= 4096) (void)dsa_topk_row_fast<64>(sr, out, n, lane, cand);
    else if (n <= 5120) (void)dsa_topk_row_fast<80>(sr, out, n, lane, cand);
    else if (n <= 6144) (void)dsa_topk_row_fast<96>(sr, out, n, lane, cand);
    else if (n <= 7168) (void)dsa_topk_row_fast<112>(sr, out, n, lane, cand);
    else (void)dsa_topk_row_fast<128>(sr, out, n, lane, cand);
}
static __device__ __forceinline__ void dsa_topk_phase(ArgsP ap, LAS unsigned char* lds, int tidv, int vcu) {
    const unsigned short* score = (const unsigned short*)(ap->ws + WS_SCORE); int* idx = (int*)(ap->ws + WS_IDX);
    const int lane = tidv & 63, wave = __builtin_amdgcn_readfirstlane(tidv >> 6);
    LAS unsigned* cand = (LAS unsigned*)(lds + wave * 8192);
    const int g = vcu * NWAVES + wave, NGW = (int)gridDim.x * NWAVES;
    for (int k = 0; k * NGW < MTOK; ++k) { const int row = k * NGW + ((k & 1) ? NGW - 1 - g : g); if (row < MTOK) dsa_topk_row(score, idx, row, lane, cand); }
}
static __device__ __forceinline__ void dsa_attn_simple_phase(ArgsP ap, LAS unsigned char* lds, int tidv, int vcu) {
    const bf16_t* U = (const bf16_t*)(ap->ws + WS_U); const int* idx = (const int*)(ap->ws + WS_IDX); bf16_t* Y = (bf16_t*)(ap->ws + WS_Y);
    const int h = __builtin_amdgcn_readfirstlane(tidv >> 6), lane = tidv & 63;
    LAS int* sidx = (LAS int*)lds; LAS float* qs = (LAS float*)(lds + 1024) + h * 128; LAS float* ps = (LAS float*)(lds + 1024 + 4096) + h * 256;
    for (int row = vcu; row < MTOK; row += (int)gridDim.x) {
        const int b = row / SEQ;
        __syncthreads();
        if (tidv < 256) sidx[tidv] = idx[(size_t)row * 256 + tidv];
        const bf16_t* ur = U + (size_t)row * LDU;
        qs[lane] = bf2f(ur[C_AQ + h * 128 + lane]); qs[lane + 64] = bf2f(ur[C_AQ + h * 128 + lane + 64]);
        __syncthreads();
        float lg[4]; float mx = -1e30f;
#pragma unroll
        for (int c = 0; c < 4; ++c) { const int id = sidx[c * 64 + lane]; float d = -INFINITY;
            if (id >= 0) { const uint4* kr = (const uint4*)(U + ((size_t)b * SEQ + id) * LDU + C_AK); d = 0.f;
#pragma unroll
                for (int j = 0; j < 16; ++j) { const uint4 kk = kr[j]; const LAS float* q = qs + j * 8;
                    d += q[0] * __uint_as_float(kk.x << 16) + q[1] * __uint_as_float(kk.x & 0xffff0000u) + q[2] * __uint_as_float(kk.y << 16) + q[3] * __uint_as_float(kk.y & 0xffff0000u)
                       + q[4] * __uint_as_float(kk.z << 16) + q[5] * __uint_as_float(kk.z & 0xffff0000u) + q[6] * __uint_as_float(kk.w << 16) + q[7] * __uint_as_float(kk.w & 0xffff0000u); }
                d *= 0.08838834764831845f; }
            lg[c] = d; mx = fmaxf(mx, d); }
        mx = wave_max(mx);
        float sum = 0.f;
#pragma unroll
        for (int c = 0; c < 4; ++c) { lg[c] = __expf(lg[c] - mx); sum += lg[c]; }
        sum = wave_sum(sum); const float inv = 1.0f / sum;
#pragma unroll
        for (int c = 0; c < 4; ++c) ps[c * 64 + lane] = lg[c] * inv;
        LDS_WAIT();
        float o0 = 0.f, o1 = 0.f;
        for (int j = 0; j < 256; ++j) { const int id = sidx[j]; if (id < 0) continue; const float p = ps[j];
            const unsigned vv = *(const unsigned*)(U + ((size_t)b * SEQ + id) * LDU + C_AV + 2 * lane);
            o0 += p * __uint_as_float(vv << 16); o1 += p * __uint_as_float(vv & 0xffff0000u); }
        const unsigned gg = *(const unsigned*)(ur + C_AG + h * 128 + 2 * lane);
        o0 *= siluf_(__uint_as_float(gg << 16)); o1 *= siluf_(__uint_as_float(gg & 0xffff0000u));
        *(unsigned*)(Y + (size_t)row * D_MODEL + h * 128 + 2 * lane) = pk2(o0, o1);
    }
    __syncthreads();
}

constexpr int DSA_WAVE_LDS = 16384 + 1024 + 256;
static __device__ __forceinline__ void dsa_attn_row(const bf16_t* U, const int* idx, bf16_t* Y, int row, LAS char* wl, int lane) {
    using namespace att;
    const int r32 = lane & 31, hi = lane >> 5;
    const int b = row / SEQ, t = row % SEQ; const size_t brow = (size_t)b * SEQ;
    const int nvalid = (t + 1) < 256 ? (t + 1) : 256;
    LAS char* Kt = wl; LAS char* Vt = wl + 8192; LAS int* sidx = (LAS int*)(wl + 16384); LAS float* li_l = (LAS float*)(wl + 16384 + 1024); LAS float* al_l = li_l + 32;
    { const v4u v = *(const v4u*)(idx + (size_t)row * 256 + lane * 4); *(LAS v4u*)(sidx + lane * 4) = v; }
    bf16x8 qr[8];
    const bf16_t* qp = U + (size_t)row * LDU + C_AQ + (r32 & 7) * 128 + hi * 8;
#pragma unroll
    for (int d0 = 0; d0 < 8; ++d0) { bf16x8 q = *(const bf16x8*)(qp + d0 * 16); if (r32 >= 8) q = (bf16x8){0, 0, 0, 0, 0, 0, 0, 0}; qr[d0] = q; }
    asm volatile("s_waitcnt lgkmcnt(0)" ::: "memory");
    float m_reg = -1e30f, l_reg = 0; f32x16 o[4] = {};
    const int vbase = (int)(uintptr_t)Vt + v_rd_base(lane);
    const int gr = lane >> 4, gc = lane & 15;
    const bf16_t* Kg = U + brow * LDU + C_AK + gc * 8; const bf16_t* Vg = U + brow * LDU + C_AV + gc * 8;
    bf16x8 kv[8], vv[8];
#define DA_GATHER(tt_) do { _Pragma("unroll") for (int i = 0; i < 8; ++i) { int iv = sidx[(tt_) * 32 + i * 4 + gr]; iv = iv < 0 ? 0 : iv; \
            kv[i] = *(const bf16x8*)(Kg + (size_t)iv * LDU); vv[i] = *(const bf16x8*)(Vg + (size_t)iv * LDU); } } while (0)
    DA_GATHER(0);
    for (int tt = 0; tt < 8; ++tt) {
#pragma unroll
        for (int i = 0; i < 8; ++i) { const int kk = i * 4 + gr; *(LAS bf16x8*)(Kt + KSWZ(kk, gc * 16)) = kv[i]; *(LAS bf16x8*)(Vt + v_st(kk, gc * 8)) = vv[i]; }
        if (tt + 1 < 8) DA_GATHER(tt + 1);
        asm volatile("s_waitcnt lgkmcnt(0)" ::: "memory");
        f32x16 p = {};
        {   const LAS char* kb4[4];
#pragma unroll
            for (int dd = 0; dd < 4; ++dd) kb4[dd] = Kt + KSWZ(r32, (dd * 16 + hi * 8) * 2);
#pragma unroll
            for (int d0 = 0; d0 < 8; ++d0) { const bf16x8 kf = *reinterpret_cast<const LAS bf16x8*>(kb4[d0 & 3] + (d0 >> 2) * 128);
                p = __builtin_amdgcn_mfma_f32_32x32x16_bf16(kf, qr[d0], p, 0, 0, 0); } }
        if (tt * 32 + 32 > nvalid) {
            const float NEG = -__builtin_inff();
#pragma unroll
            for (int r = 0; r < 16; ++r) if (tt * 32 + crow(r, hi) >= nvalid) p[r] = NEG; }
        float pmax = p[0];
#pragma unroll
        for (int r = 1; r < 16; ++r) pmax = fmaxf(pmax, p[r]);
        { auto rr = __builtin_amdgcn_permlane32_swap(__float_as_uint(pmax), __float_as_uint(pmax), false, false); pmax = fmaxf(__uint_as_float(rr[0]), __uint_as_float(rr[1])); }
        constexpr float C2 = 1.4426950408889634f * SCALE;
        float mn, alpha;
        if (__builtin_expect(__all((pmax - m_reg) * SCALE <= THR), 1)) { mn = m_reg; alpha = 1.f; }
        else { mn = fmaxf(m_reg, pmax); alpha = __builtin_amdgcn_exp2f((m_reg - mn) * C2); m_reg = mn; }
        const float mnL = -mn * C2; float ps = 0.f;
#pragma unroll
        for (int r = 0; r < 16; ++r) { p[r] = __builtin_amdgcn_exp2f(fmaf(p[r], C2, mnL)); ps += p[r]; }
        { auto rr = __builtin_amdgcn_permlane32_swap(__float_as_uint(ps), __float_as_uint(ps), false, false); ps = __uint_as_float(rr[0]) + __uint_as_float(rr[1]); }
        l_reg = l_reg * alpha + ps;
        if (__any(alpha < 1.f)) { if (hi == 0) al_l[r32] = alpha; asm volatile("s_waitcnt lgkmcnt(0)" ::: "memory");
#pragma unroll
            for (int d_ = 0; d_ < 4; ++d_)
#pragma unroll
                for (int r = 0; r < 4; ++r) o[d_][r] *= al_l[crow(r, hi)]; }
        bf16x8 pa0, pa1;
#define DA_PK4(P, B_, OUT) do { unsigned a0 = cvtpk(P[B_+0], P[B_+1]), a1 = cvtpk(P[B_+2], P[B_+3]); unsigned b0 = cvtpk(P[B_+4], P[B_+5]), b1 = cvtpk(P[B_+6], P[B_+7]); \
        auto r0 = __builtin_amdgcn_permlane32_swap(a0, b0, false, false); auto r1 = __builtin_amdgcn_permlane32_swap(a1, b1, false, false); \
        u32x4 w = {r0[0], r1[0], r0[1], r1[1]}; OUT = *reinterpret_cast<bf16x8*>(&w); } while (0)
        DA_PK4(p, 0, pa0); DA_PK4(p, 8, pa1);
#undef DA_PK4
        SBAR();
#define DA_TRRD(dst, off) asm volatile("ds_read_b64_tr_b16 %0, %1 offset:%2" : "=&v"(dst) : "v"(vbase), "i"(off) : "memory")
#define DA_PV(d0) do { s16x4 l0, h0, l1, h1; DA_TRRD(l0, (d0) * 512); DA_TRRD(h0, (d0) * 512 + 2048); DA_TRRD(l1, (d0) * 512 + 4096); DA_TRRD(h1, (d0) * 512 + 6144); \
        asm volatile("s_waitcnt lgkmcnt(0)" ::: "memory"); SBAR(); \
        o[d0] = __builtin_amdgcn_mfma_f32_32x32x16_bf16(pa0, (bf16x8){l0[0], l0[1], l0[2], l0[3], h0[0], h0[1], h0[2], h0[3]}, o[d0], 0, 0, 0); \
        o[d0] = __builtin_amdgcn_mfma_f32_32x32x16_bf16(pa1, (bf16x8){l1[0], l1[1], l1[2], l1[3], h1[0], h1[1], h1[2], h1[3]}, o[d0], 0, 0, 0); } while (0)
        DA_PV(0); DA_PV(1); DA_PV(2); DA_PV(3);
#undef DA_PV
#undef DA_TRRD
    }
#undef DA_GATHER
    if (hi == 0) li_l[r32] = l_reg; asm volatile("s_waitcnt lgkmcnt(0)" ::: "memory");
    const bf16_t* gp = U + (size_t)row * LDU + C_AG; bf16_t* yp = Y + (size_t)row * D_MODEL;
    unsigned short gv[4][4];
#pragma unroll
    for (int r = 0; r < 4; ++r)
#pragma unroll
        for (int d0 = 0; d0 < 4; ++d0) gv[r][d0] = gp[(r + 4 * hi) * 128 + d0 * 32 + r32];
#pragma unroll
    for (int r = 0; r < 4; ++r) { const int head = r + 4 * hi; const float rl = __builtin_amdgcn_rcpf(li_l[head]);
#pragma unroll
        for (int d0 = 0; d0 < 4; ++d0) { const float y = o[d0][r] * rl * siluf_(bf2f(gv[r][d0])); const float yn = dpp_f<0xB1>(y);
            if ((r32 & 1) == 0) *(unsigned*)(yp + head * 128 + d0 * 32 + r32) = cvtpk(y, yn); } }
}
static __device__ __forceinline__ void dsa_attn_phase(ArgsP ap, LAS unsigned char* lds, int tidv, int vcu) {
    const bf16_t* U = (const bf16_t*)(ap->ws + WS_U); const int* idx = (const int*)(ap->ws + WS_IDX); bf16_t* Y = (bf16_t*)(ap->ws + WS_Y);
    const int lane = tidv & 63, wave = __builtin_amdgcn_readfirstlane(tidv >> 6);
    LAS char* wl = (LAS char*)lds + wave * DSA_WAVE_LDS;
    for (int row = vcu * NWAVES + wave; row < MTOK; row += (int)gridDim.x * NWAVES) dsa_attn_row(U, idx, Y, row, wl, lane);
}

static __device__ __forceinline__ void ph_inproj(ArgsP ap, int l, LAS unsigned char* lds, int tidv) {
    unsigned char* ws = ap->ws;
    pg8::Gemm g{}; g.A = (const bf16_t*)(ws + WS_XB); g.Bt = (const bf16_t*)(ws + WS_WIN) + (size_t)l * NU * D_MODEL; g.M = MTOK; g.N = NU; g.K = D_MODEL; g.lda = D_MODEL; g.ldb = D_MODEL;
    pg8::EpiInProj E{}; E.U = (bf16_t*)(ws + WS_U); E.UM = (float*)(ws + WS_UM); E.IKB = (bf16_t*)(ws + WS_IKB); E.T128 = (const float*)(ws + WS_ROPE128); E.T64 = (const float*)(ws + WS_ROPE64); E.RS = (const float*)(ws + WS_RS);
    pg8::SchedPlain S; S.init(MTOK / 256, NU / 256, (int)gridDim.x, (int)blockIdx.x);
    pg8::gemm_phase<pg8::EpiInProj, pg8::SchedPlain>(lds + RING_OFF, g, S, E, tidv);
}
static __device__ __forceinline__ void ph_gates(ArgsP ap, int l, LAS unsigned char* lds, int tidv) {
    unsigned char* ws = ap->ws;
    pg8::Gemm g{}; g.A = (const bf16_t*)(ws + WS_XB); g.Bt = (const bf16_t*)(ws + WS_WM) + (size_t)l * 4 * 16 * 65536; g.M = MTOK; g.N = 4 * D_MODEL; g.K = 256; g.lda = D_MODEL; g.ldb = 256;
    pg8::EpiGates E{}; E.G = (unsigned char*)(ws + WS_GATE); E.bias = ap->in[9] + (size_t)l * 4 * D_MODEL; E.RS = (const float*)(ws + WS_RS);
    pg8::SchedGates S; S.init(MTOK / 256, 64, (int)gridDim.x, (int)blockIdx.x);
    pg8::gemm_phase<pg8::EpiGates, pg8::SchedGates>(lds + RING_OFF, g, S, E, tidv);
}
static __device__ __forceinline__ void ph_branch(ArgsP ap, int l, LAS unsigned char* lds, int tidv) {
    unsigned char* ws = ap->ws;
    pg8::Gemm g{}; g.A = (const bf16_t*)(ws + WS_Y); g.Bt = (const bf16_t*)(ws + WS_WB) + (size_t)l * 4 * D_MODEL * 1024; g.M = MTOK; g.N = D_MODEL; g.K = 1024; g.lda = D_MODEL; g.ldb = 1024;
    pg8::EpiBranch E{}; E.G = (const unsigned char*)(ws + WS_GATE); E.merged = (bf16_t*)(ws + WS_MERGED);
    pg8::SchedBranch S; S.init(MTOK / 256, D_MODEL / 256, (int)gridDim.x, (int)blockIdx.x);
    pg8::gemm_phase<pg8::EpiBranch, pg8::SchedBranch>(lds + RING_OFF, g, S, E, tidv);
}
static __device__ __forceinline__ void ph_out(ArgsP ap, int l, LAS unsigned char* lds, int tidv) {
    unsigned char* ws = ap->ws;
    pg8::Gemm g{}; g.A = (const bf16_t*)(ws + WS_MERGED); g.Bt = (const bf16_t*)(ws + WS_WO) + (size_t)l * D_MODEL * D_MODEL; g.M = MTOK; g.N = D_MODEL; g.K = D_MODEL; g.lda = D_MODEL; g.ldb = D_MODEL;
    pg8::EpiOut E{}; E.x = (bf16_t*)(ws + WS_XB); E.ps = (float*)(ws + WS_HO);
    pg8::SchedPlain S; S.init(MTOK / 256, D_MODEL / 256, (int)gridDim.x, (int)blockIdx.x);
    pg8::gemm_phase<pg8::EpiOut, pg8::SchedPlain>(lds + RING_OFF, g, S, E, tidv);
}
__device__ __forceinline__ bool in_range(int lo, int hi, int k) { asm volatile("" : "+s"(k)); return lo <= k && k < hi; }
__device__ __forceinline__ float2 rope_cs(int pos, float frac) {
    const float inv = exp2f(-frac * 13.287712379549449f);
    const float ang = (float)pos * inv;
    double r = (double)ang * 0.15915494309189535; r -= floor(r);
    const float f = (float)r;
    return make_float2(__builtin_amdgcn_cosf(f), __builtin_amdgcn_sinf(f));
}
__global__ void __launch_bounds__(NWAVES * 64, 2) k_mega(Args args_unused) {
    extern __shared__ __attribute__((aligned(16))) unsigned char lds_raw[];
    ArgsP ap = (ArgsP)__builtin_amdgcn_kernarg_segment_ptr();
    int wave_s = __builtin_amdgcn_readfirstlane((int)threadIdx.x >> 6);
#define PHASE_BEGIN() do { asm volatile("" : "+s"(ap), "+s"(wave_s)); unsigned m_ = ~0u; asm volatile("" : "+s"(m_)); tidv = (wave_s << 6) | (int)__builtin_amdgcn_mbcnt_hi(m_, __builtin_amdgcn_mbcnt_lo(m_, 0u)); asm volatile("" : "+v"(tidv)); } while (0)
    int tidv;
    LAS unsigned char* const lds = (LAS unsigned char*)lds_raw;
    const int lo = ap->ph_lo, hi = ap->ph_hi;
    for (int u = threadIdx.x; u < (LDS_BYTES - LDSCTL_OFF) / 4; u += NWAVES * 64) ((LAS unsigned*)(lds + LDSCTL_OFF))[u] = 0u;
    __syncthreads();
    XcdBarrier bar; bar.bar = (unsigned*)ap->ws + CW_BAR + ap->li * XCD_BAR_WORDS; bar.x = 0; bar.st = nullptr;
    if (hi - lo > 1) bar = xcd_barrier_post((unsigned*)ap->ws + CW_BAR + ap->li * XCD_BAR_WORDS, (volatile LAS unsigned*)(lds + MISC_OFF) + 8);
#define IN(k) in_range(lo, hi, (k))
#define BOTH(k) in_range(lo, hi - 1, (k))
#define GRID_BAR() do { asm volatile("" : "+s"(bar.x), "+s"(ap)); bar.bar = (unsigned*)ap->ws + CW_BAR + ap->li * XCD_BAR_WORDS; xcd_barrier(bar); } while (0)
#define VCU() ((int)((gridDim.x % 8 == 0) ? (blockIdx.x % 8) * (gridDim.x / 8) + blockIdx.x / 8 : blockIdx.x))

    if (IN(PH_PRO)) {
        PHASE_BEGIN();
        unsigned char* ws = ap->ws;
        const float* norm_w = ap->in[1]; const float* w_in = ap->in[2]; const float* hgrn_gamma = ap->in[5]; const float* w_branch = ap->in[7]; const float* w_merge = ap->in[8]; const float* w_out = ap->in[10];
        bf16_t* WinT = (bf16_t*)(ws + WS_WIN); bf16_t* WbT = (bf16_t*)(ws + WS_WB); bf16_t* WmT = (bf16_t*)(ws + WS_WM); bf16_t* WoT = (bf16_t*)(ws + WS_WO);
        float2* R128 = (float2*)(ws + WS_ROPE128); float2* R64 = (float2*)(ws + WS_ROPE64); float* LB = (float*)(ws + WS_LB);
        const int lane = tidv & 63, wave = __builtin_amdgcn_readfirstlane(tidv >> 6);
        const int gw = VCU() * NWAVES + wave, NGW = gridDim.x * NWAVES, gt = VCU() * (NWAVES * 64) + tidv, NGT = gridDim.x * NWAVES * 64;
        LAS float* scr = (LAS float*)(lds + RING_OFF + wave * 16384);
        constexpr int I_IN = (D_MODEL / 64) * (NU / 32), I_BR = (1024 / 64) * (D_MODEL / 32), I_MG = (256 / 64) * (256 / 32), I_OUT = (D_MODEL / 64) * (D_MODEL / 32);
        constexpr int T_IN = DEPTH * I_IN, T_BR = DEPTH * 4 * I_BR, T_MG = DEPTH * 64 * I_MG, T_OUT = DEPTH * I_OUT;
#define P0_FAMILY(TOT, IPER, WSRC, SSTR, LDW, KK, NBLK, WDST, DSTR, MAPPED, KSC) \
        for (int it = gw; it < (TOT); it += 2 * NGW) { const int i2 = it + NGW < (TOT) ? it + NGW : it; float ta[32], tb[32]; \
            const float* wa = (WSRC) + (size_t)(it / (IPER)) * (SSTR); const float* wb = (WSRC) + (size_t)(i2 / (IPER)) * (SSTR); \
            p0_item_load(wa, (LDW), (NBLK), it % (IPER), lane, (MAPPED), ta); p0_item_load(wb, (LDW), (NBLK), i2 % (IPER), lane, (MAPPED), tb); \
            { const int mi_ = it / (IPER); p0_item_store((KK), (NBLK), (WDST) + (size_t)mi_ * (DSTR), scr, it % (IPER), lane, ta, KSC); } \
            if (i2 != it) { const int mi_ = i2 / (IPER); p0_item_store((KK), (NBLK), (WDST) + (size_t)mi_ * (DSTR), scr, i2 % (IPER), lane, tb, KSC); } }
        P0_FAMILY(T_IN, I_IN, w_in, (size_t)D_MODEL * IN_WIDTH, IN_WIDTH, D_MODEL, NU / 32, WinT, (size_t)NU * D_MODEL, true, norm_w + (size_t)mi_ * D_MODEL)
        P0_FAMILY(T_BR, I_BR, w_branch, (size_t)1024 * D_MODEL, D_MODEL, 1024, D_MODEL / 32, WbT, (size_t)D_MODEL * 1024, false, (const float*)nullptr)
        P0_FAMILY(T_MG, I_MG, w_merge, (size_t)65536, 256, 256, 256 / 32, WmT, (size_t)65536, false, norm_w + (size_t)(mi_ >> 6) * D_MODEL + (mi_ & 15) * 256)
        P0_FAMILY(T_OUT, I_OUT, w_out, (size_t)D_MODEL * D_MODEL, D_MODEL, D_MODEL, D_MODEL / 32, WoT, (size_t)D_MODEL * D_MODEL, false, (const float*)nullptr)
#undef P0_FAMILY
        for (int i = gt; i < SEQ * 64; i += NGT) { const int pos = i >> 6, j = i & 63; R128[i] = rope_cs(pos, (float)j * (1.0f / 64.0f)); }
        for (int i = gt; i < SEQ * 32; i += NGT) { const int pos = i >> 5, j = i & 31; R64[i] = rope_cs(pos, (float)j * (1.0f / 32.0f)); }
        for (int c = gt; c < 1024; c += NGT) {
            const float g0 = hgrn_gamma[c], g1 = hgrn_gamma[1024 + c], g2 = hgrn_gamma[2048 + c], g3 = hgrn_gamma[3072 + c];
            const float mx = fmaxf(fmaxf(g0, g1), fmaxf(g2, g3));
            const float e0 = expf(g0 - mx), e1 = expf(g1 - mx), e2 = expf(g2 - mx), e3 = expf(g3 - mx);
            const float is = 1.0f / (e0 + e1 + e2 + e3);
            LB[c] = 0.f; LB[1024 + c] = e1 * is; LB[2048 + c] = (e1 + e2) * is; LB[3072 + c] = (e1 + e2 + e3) * is;
        }
    }

    for (int l = 0; l < DEPTH; ++l) {
        const int pb = 1 + l * PH_PER_LAYER;
        if (IN(pb + PH_NORM)) {
            PHASE_BEGIN();
            float* RS = (float*)(ap->ws + WS_RS); bf16_t* XB = (bf16_t*)(ap->ws + WS_XB);
            const int lane = tidv & 63, wave = __builtin_amdgcn_readfirstlane(tidv >> 6);
            const int gw = VCU() * NWAVES + wave, NGW = gridDim.x * NWAVES;
            if (l == 0) { const float* x0 = ap->in[0]; for (int m = gw; m < MTOK; m += NGW) rstd_row_f(x0 + (size_t)m * D_MODEL, XB + (size_t)m * D_MODEL, RS + m, lane); }
            else {
                const float* PS = (const float*)(ap->ws + WS_HO);
                for (int m0 = gw; m0 < MTOK; m0 += 8 * NGW) { float v[8];
#pragma unroll
                    for (int k = 0; k < 8; ++k) { const int m = m0 + k * NGW; v[k] = PS[(size_t)(m < MTOK ? m : m0) * 64 + lane]; }
#pragma unroll
                    for (int k = 0; k < 8; ++k) { const int m = m0 + k * NGW; const float sm = wave_sum(v[k]); if (lane == 0 && m < MTOK) RS[m] = rsqrtf(sm * (1.0f / D_MODEL) + 1e-6f); } } }
            if (BOTH(pb + PH_NORM)) GRID_BAR();
        }
        if (IN(pb + PH_INPROJ)) {
            PHASE_BEGIN(); ph_inproj(ap, l, lds, tidv);
            PHASE_BEGIN(); ph_gates(ap, l, lds, tidv);
            if (BOTH(pb + PH_INPROJ)) GRID_BAR();
        }
        if (IN(pb + PH_M1)) {
            PHASE_BEGIN(); hgrn_h1_phase(ap, l, lds, tidv, VCU()); __syncthreads();
            PHASE_BEGIN(); fox_prep(ap, l, lds, tidv, VCU());
            PHASE_BEGIN(); conv_phase(ap, l, tidv, VCU());
            PHASE_BEGIN(); dsa_score_phase(ap, tidv, VCU());
            if (BOTH(pb + PH_M1)) GRID_BAR(); }
        if (IN(pb + PH_M2)) {
            PHASE_BEGIN(); fox_attn_phase(ap, l, lds, tidv, VCU());
            PHASE_BEGIN(); hgrn_h2_phase(ap, tidv, VCU());
            __syncthreads(); PHASE_BEGIN(); dsa_topk_phase(ap, lds, tidv, VCU());
            if (BOTH(pb + PH_M2)) GRID_BAR(); }
        if (IN(pb + PH_M3)) {
            PHASE_BEGIN(); hgrn_h3_phase(ap, l, lds, tidv, VCU());
            __syncthreads(); PHASE_BEGIN(); dsa_attn_phase(ap, lds, tidv, VCU());
            if (BOTH(pb + PH_M3)) GRID_BAR(); }
        if (IN(pb + PH_BRANCH)) { PHASE_BEGIN(); ph_branch(ap, l, lds, tidv); if (BOTH(pb + PH_BRANCH)) GRID_BAR(); }
        if (IN(pb + PH_OUT)) { PHASE_BEGIN(); ph_out(ap, l, lds, tidv); if (BOTH(pb + PH_OUT)) GRID_BAR(); }
    }
    if (IN(PH_FINAL)) {
        PHASE_BEGIN();
        const bf16_t* XB = (const bf16_t*)(ap->ws + WS_XB); float* xout = ap->out; const float* fw = ap->in[11];
        const int lane = tidv & 63, wave = __builtin_amdgcn_readfirstlane(tidv >> 6);
        const int gw = VCU() * NWAVES + wave, NGW = gridDim.x * NWAVES;
        for (int m = gw; m < MTOK; m += NGW) rms_row_b<true>(XB + (size_t)m * D_MODEL, fw, nullptr, xout + (size_t)m * D_MODEL, lane);
    }
#undef IN
#undef BOTH
#undef GRID_BAR
#undef PHASE_BEGIN
#undef VCU
}

extern "C" void kernel_launch(void* const* d_in, const int* in_sizes, int n_in, void* d_out, int out_size, void* d_ws, size_t ws_size, hipStream_t stream) {
    static int grid = 0;
    if (grid == 0) {
        if (ws_size < WS_END || n_in != 12) { fprintf(stderr, "kernel_launch: bad arguments (ws %zu < %zu or n_in %d)\n", ws_size, (size_t)WS_END, n_in); grid = -1; return; }
        int dev = 0, cus = 0, per_cu = 0;
        if (hipGetDevice(&dev) != hipSuccess || hipDeviceGetAttribute(&cus, hipDeviceAttributeMultiprocessorCount, dev) != hipSuccess) { grid = -1; return; }
        if (hipFuncSetAttribute((const void*)k_mega, hipFuncAttributeMaxDynamicSharedMemorySize, LDS_BYTES) != hipSuccess) { fprintf(stderr, "kernel_launch: hipFuncSetAttribute failed\n"); grid = -1; return; }
        if (hipOccupancyMaxActiveBlocksPerMultiprocessor(&per_cu, (const void*)k_mega, NWAVES * 64, LDS_BYTES) != hipSuccess || per_cu < 1) { fprintf(stderr, "kernel_launch: occupancy query says %d\n", per_cu); }
        (void)hipGetLastError();
        grid = cus;
    }
    if (grid < 0) return;
    (void)hipMemsetAsync((char*)d_ws + WS_CTL, 0, (size_t)(CW_BAR + XCD_BAR_WORDS) * 4, stream);
    Args a{};
    for (int i = 0; i < 12; ++i) a.in[i] = (const float*)d_in[i];
    a.out = (float*)d_out; a.ws = (unsigned char*)d_ws;
    const float* fox_f_bias = (const float*)d_in[3]; const float* conv_w = (const float*)d_in[4]; const float* hgrn_norm_w = (const float*)d_in[6];
    unsigned char* ws = (unsigned char*)d_ws;
    bf16_t* U = (bf16_t*)(ws + WS_U); float* UM = (float*)(ws + WS_UM); bf16_t* Y = (bf16_t*)(ws + WS_Y);
    float* SCORE = (float*)(ws + WS_SCORE); int* IDX = (int*)(ws + WS_IDX); float* CF = (float*)(ws + WS_CF); float* HO = (float*)(ws + WS_HO);
    float2* R128 = (float2*)(ws + WS_ROPE128); float2* R64 = (float2*)(ws + WS_ROPE64); float* LB = (float*)(ws + WS_LB);
    a.ph_lo = 0; a.ph_hi = PH_COUNT; a.li = 0;
    hipLaunchKernelGGL(k_mega, dim3(grid), dim3(NWAVES * 64), LDS_BYTES, stream, a);
}
```

```cpp
#include <hip/hip_runtime.h>
#include <stdint.h>
#include <stdio.h>

typedef unsigned short bf16_t;
#define LAS __attribute__((address_space(3)))

constexpr int D_MODEL = 4096, BATCH = 2, SEQ = 8192, DEPTH = 4, MTOK = BATCH * SEQ;
constexpr int IN_WIDTH = 15704;
constexpr int NU = 15872;
constexpr int LDU = 15616;
constexpr int LDM = 256;
constexpr int C_AQ = 0, C_AIQ = 1024, C_AG = 2048, C_BB = 3072, C_BC = 4096, C_BX = 5120, C_BG = 6144, C_CQ = 7168, C_CK = 8192, C_CV = 9216, C_CG = 10240,
              C_DQ = 11264, C_DF = 12288, C_DI = 13312, C_DG = 14336, C_AK = 15360, C_AV = 15488;
constexpr int MC_IK = 0, MC_IW = 64, MC_CF = 80;

__host__ __device__ __forceinline__ int inproj_src_col(int n) {
    if (n < 1024) { const int c = n & 127; return (n & ~127) + (c >> 1) + 64 * (c & 1); }
    if (n < 2048) { const int m = n - 1024, c = m & 63; return 1280 + (m & ~63) + (c >> 1) + 32 * (c & 1); }
    if (n < 3072) return 2384 + (n - 2048);
    if (n < 4096) return 3408 + (n - 3072);
    if (n < 5120) return 4432 + (n - 4096);
    if (n < 6144) return 5456 + (n - 5120);
    if (n < 7168) return 6480 + (n - 6144);
    if (n < 8192) return 7504 + (n - 7168);
    if (n < 9216) return 8528 + (n - 8192);
    if (n < 10240) return 9552 + (n - 9216);
    if (n < 11264) return 10584 + (n - 10240);
    if (n < 12288) return 11608 + (n - 11264);
    if (n < 13312) return 12632 + (n - 12288);
    if (n < 14336) return 13656 + (n - 13312);
    if (n < 15360) return 14680 + (n - 14336);
    if (n < 15488) { const int c = n - 15360; return 1024 + (c >> 1) + 64 * (c & 1); }
    if (n < 15616) return 1152 + (n - 15488);
    if (n < 15680) { const int c = n - 15616; return 2304 + (c >> 1) + 32 * (c & 1); }
    if (n < 15696) return 2368 + (n - 15680);
    if (n < 15704) return 10576 + (n - 15696);
    return -1;
}

constexpr size_t al256(size_t x) { return (x + 255) & ~(size_t)255; }
constexpr size_t WS_CTL = 0;
constexpr int CW_FOXN = 1024;
constexpr size_t WS_WIN = 1u << 20;
constexpr size_t WS_WB = WS_WIN + al256((size_t)DEPTH * NU * D_MODEL * 2);
constexpr size_t WS_WM = WS_WB + al256((size_t)DEPTH * 4 * D_MODEL * 1024 * 2);
constexpr size_t WS_WO = WS_WM + al256((size_t)DEPTH * 4 * 16 * 256 * 256 * 2);
constexpr size_t WS_H = WS_WO + al256((size_t)DEPTH * D_MODEL * D_MODEL * 2);
constexpr size_t WS_RS = WS_H;
constexpr size_t WS_U = WS_H + al256((size_t)MTOK * D_MODEL * 2);
constexpr size_t WS_UM = WS_U + al256((size_t)MTOK * LDU * 2);
constexpr size_t WS_GATE = WS_UM + al256((size_t)MTOK * LDM * 4);
constexpr size_t WS_Y = WS_GATE + al256((size_t)4 * MTOK * D_MODEL * 2);
constexpr size_t WS_MACC = WS_Y + al256((size_t)MTOK * D_MODEL * 2);
constexpr size_t WS_XB = WS_MACC;
constexpr size_t WS_MERGED = WS_MACC + al256((size_t)MTOK * D_MODEL * 4);
constexpr size_t WS_SCORE = WS_MERGED + al256((size_t)MTOK * D_MODEL * 2);
constexpr int SCP = SEQ + 832;
constexpr int SCPH = SEQ + 1664;
constexpr int SCP_UNUSED = SEQ + 832;
constexpr size_t WS_IDX = WS_SCORE + al256((size_t)MTOK * SCP * 4);
constexpr size_t WS_CF = WS_IDX + al256((size_t)MTOK * 256 * 4);
constexpr size_t WS_HO = WS_CF + al256((size_t)BATCH * 8 * SEQ * 4 * 2);
constexpr size_t WS_ROPE128 = WS_HO + al256((size_t)MTOK * 1024 * 4);
constexpr size_t WS_ROPE64 = WS_ROPE128 + al256((size_t)SEQ * 64 * 2 * 4);
constexpr size_t WS_LB = WS_ROPE64 + al256((size_t)SEQ * 32 * 2 * 4);
constexpr size_t WS_HUT = WS_LB + al256((size_t)DEPTH * 1024 * 4);
constexpr size_t WS_HD = WS_HUT + al256((size_t)BATCH * 8 * (SEQ / 32) * 16384 * 4);
constexpr size_t WS_HST = WS_HD + al256((size_t)BATCH * 8 * (SEQ / 32) * 128 * 4);
constexpr size_t WS_IKB = WS_HST + al256((size_t)BATCH * 8 * (SEQ / 32) * 16384 * 2);
constexpr size_t WS_END = WS_IKB + al256((size_t)MTOK * 64 * 2);

__device__ __forceinline__ float bf2f(bf16_t b) { return __uint_as_float(((unsigned)b) << 16); }
__device__ __forceinline__ bf16_t f2bf(float f) { unsigned u = __float_as_uint(f); u += 0x7fffu + ((u >> 16) & 1u); return (bf16_t)(u >> 16); }
__device__ __forceinline__ unsigned pk2(float lo, float hi) { return (unsigned)f2bf(lo) | ((unsigned)f2bf(hi) << 16); }
template <int CTRL> __device__ __forceinline__ float dpp_f(float v) { return __int_as_float(__builtin_amdgcn_update_dpp(0, __float_as_int(v), CTRL, 0xf, 0xf, true)); }
template <int CTRL> __device__ __forceinline__ int dpp_i(int v) { return __builtin_amdgcn_update_dpp(0, v, CTRL, 0xf, 0xf, true); }
__device__ __forceinline__ float wave_sum(float v) {
    v += dpp_f<0xB1>(v); v += dpp_f<0x4E>(v); v += dpp_f<0x141>(v); v += dpp_f<0x140>(v);
    const int i = __float_as_int(v);
    return (__int_as_float(__builtin_amdgcn_readlane(i, 0)) + __int_as_float(__builtin_amdgcn_readlane(i, 16))) + (__int_as_float(__builtin_amdgcn_readlane(i, 32)) + __int_as_float(__builtin_amdgcn_readlane(i, 48)));
}
__device__ __forceinline__ float wave_max(float v) {
    v = fmaxf(v, dpp_f<0xB1>(v)); v = fmaxf(v, dpp_f<0x4E>(v)); v = fmaxf(v, dpp_f<0x141>(v)); v = fmaxf(v, dpp_f<0x140>(v));
    const int i = __float_as_int(v);
    return fmaxf(fmaxf(__int_as_float(__builtin_amdgcn_readlane(i, 0)), __int_as_float(__builtin_amdgcn_readlane(i, 16))), fmaxf(__int_as_float(__builtin_amdgcn_readlane(i, 32)), __int_as_float(__builtin_amdgcn_readlane(i, 48))));
}
__device__ __forceinline__ int wave_sum_i(int v) {
    v += dpp_i<0xB1>(v); v += dpp_i<0x4E>(v); v += dpp_i<0x141>(v); v += dpp_i<0x140>(v);
    return (__builtin_amdgcn_readlane(v, 0) + __builtin_amdgcn_readlane(v, 16)) + (__builtin_amdgcn_readlane(v, 32) + __builtin_amdgcn_readlane(v, 48));
}
__device__ __forceinline__ float sigmoidf_(float x) { return __builtin_amdgcn_rcpf(1.0f + __expf(-x)); }
__device__ __forceinline__ float siluf_(float x) { return x * __builtin_amdgcn_rcpf(1.0f + __expf(-x)); }

namespace pg8 {
typedef short bf16x8 __attribute__((ext_vector_type(8)));
typedef float f32x4 __attribute__((ext_vector_type(4)));
typedef unsigned u32x4 __attribute__((ext_vector_type(4)));
constexpr int BM = 256, BK = 64, HALF = 128, HTB = HALF * BK * 2, STAGE_BYTES = 8 * HTB, NXCD = 8, WGM = 8;

__host__ __device__ __forceinline__ int lds_byte(int r, int c) { const int st = (r >> 4) * 2 + (c >> 5), rr = r & 15, cc = c & 31, ob = rr * 64 + cc * 2; return st * 1024 + (ob ^ (((ob >> 9) & 1) << 5)); }
__host__ __device__ __forceinline__ void stage_rc(int b, int& R, int& C) { const int st = b / 1024, sb = b % 1024, swz = sb ^ (((sb >> 9) & 1) << 5); R = (st >> 1) * 16 + swz / 64; C = (st & 1) * 32 + (swz % 64) / 2; }
__host__ __device__ __forceinline__ int perm32(int rho) { const int n = rho >> 4, i = rho & 15; return 8 * (i >> 2) + 4 * n + (i & 3); }

struct Unit { int pm, pn, z, pad; };
struct Gemm { const bf16_t* A; const bf16_t* Bt; int M, N, K, lda, ldb, pad; };

struct TileOrder {
    int nM, nN, nwg, G, c, pad;
    __host__ __device__ void init(int nM_, int nN_, int G_, int c_) { nM = nM_; nN = nN_; nwg = nM * nN; G = G_; c = c_; pad = 0; }
    __host__ __device__ bool tile(int i, int& pm, int& pn) const {
        const long L = (long)i * G + c; if (L >= nwg) return false;
        int wgid = (int)L; { const int q = nwg / NXCD, r = nwg % NXCD, xcd = wgid % NXCD, off = wgid / NXCD; wgid = (xcd < r ? xcd * (q + 1) : r * (q + 1) + (xcd - r) * q) + off; }
        const int nig = WGM * nN, gid = wgid / nig, fm = gid * WGM, gsz = (nM - fm) < WGM ? (nM - fm) : WGM;
        pm = fm + ((wgid % nig) % gsz); pn = (wgid % nig) / gsz; return true;
    }
};
struct SchedPlain : TileOrder {
    __device__ __forceinline__ bool next(int i, Unit& u) const { u.z = 0; u.pad = 0; return tile(i, u.pm, u.pn); }
    __device__ __forceinline__ size_t a_off(const Unit& u, const Gemm& g) const { return (size_t)u.pm * BM * g.lda * 2; }
    __device__ __forceinline__ size_t b_off(const Unit& u, const Gemm& g) const { return (size_t)u.pn * BM * g.ldb * 2; }
};
struct SchedGates : TileOrder {
    __device__ __forceinline__ bool next(int i, Unit& u) const { u.z = 0; u.pad = 0;
        if (G != 256 || nwg != 4096) return tile(i, u.pm, u.pn);
        const int cnt = c < 128 ? 12 : 20; if (i >= cnt) return false;
        const int id = (c < 128 ? c * 12 : 128 * 12 + (c - 128) * 20) + i;
        u.pm = id >> 6; u.pn = id & 63; return true; }
    __device__ __forceinline__ size_t a_off(const Unit& u, const Gemm& g) const { return (size_t)u.pm * BM * g.lda * 2 + (size_t)(u.pn & 15) * 512; }
    __device__ __forceinline__ size_t b_off(const Unit& u, const Gemm& g) const { return (size_t)u.pn * 256 * 256 * 2; }
};
struct SchedBranch : TileOrder {
    __device__ __forceinline__ bool next(int i, Unit& u) const { u.z = i & 3; u.pad = 0; return tile(i >> 2, u.pm, u.pn); }
    __device__ __forceinline__ size_t a_off(const Unit& u, const Gemm& g) const { return (size_t)u.pm * BM * g.lda * 2 + (size_t)u.z * 2048; }
    __device__ __forceinline__ size_t b_off(const Unit& u, const Gemm& g) const { return (size_t)u.z * ((size_t)4096 * 1024 * 2) + (size_t)u.pn * BM * g.ldb * 2; }
};

typedef __bf16 bf16x2_t __attribute__((ext_vector_type(2)));
typedef float f32x2_t __attribute__((ext_vector_type(2)));
__device__ __forceinline__ unsigned cvt_pk_bf16(float lo, float hi) { const f32x2_t v = {lo, hi}; return __builtin_bit_cast(unsigned, __builtin_convertvector(v, bf16x2_t)); }

struct NoPre {};
struct EpiInProj {
    static constexpr bool PERM = true;
    struct Pre { float rs2[2]; };
    __device__ __forceinline__ Pre pre(const Unit& u, int wr, int, int fr, int fq) const { Pre p; const float* rp = RS + u.pm * BM + wr * 64 + fq * 16 + fr;
        p.rs2[0] = rp[0]; p.rs2[1] = rp[HALF]; return p; }
    static __device__ __forceinline__ float rs_of(const Pre& pr, int ai, int m, int fr) { return __int_as_float(__builtin_amdgcn_ds_bpermute((m * 16 + fr) * 4, __float_as_int(pr.rs2[ai]))); }
    __device__ __forceinline__ bool keep(const Unit&) const { return false; }
    bf16_t* U; float* UM; bf16_t* IKB; const float* T128; const float* T64;
    const float* RS;
    static __device__ __forceinline__ void rot8(f32x4& v0, f32x4& v1, const float* tab) {
        const f32x4 c0 = *(const f32x4*)tab, c1 = *(const f32x4*)(tab + 4);
        const float a0 = v0[0] * c0[0] - v0[1] * c0[1], a1 = v0[0] * c0[1] + v0[1] * c0[0], a2 = v0[2] * c0[2] - v0[3] * c0[3], a3 = v0[2] * c0[3] + v0[3] * c0[2];
        const float b0 = v1[0] * c1[0] - v1[1] * c1[1], b1 = v1[0] * c1[1] + v1[1] * c1[0], b2 = v1[2] * c1[2] - v1[3] * c1[3], b3 = v1[2] * c1[3] + v1[3] * c1[2];
        v0 = (f32x4){a0, a1, a2, a3}; v1 = (f32x4){b0, b1, b2, b3};
    }
    template <int RK> __device__ __forceinline__ void tile_bf16(f32x4 (&acc)[2][2][4][2], const Unit& u, int wr, int wc, int fr, int fq, const Pre& pr) const {
        const int row0 = u.pm * BM + wr * 64 + fr, col0 = u.pn * BM + wc * 32 + 8 * fq;
#pragma unroll
        for (int ai = 0; ai < 2; ++ai) {
            f32x4 tb[4][2][2]; float rsv[4];
#pragma unroll
            for (int m = 0; m < 4; ++m) rsv[m] = rs_of(pr, ai, m, fr);
            if (RK != 0) {
#pragma unroll
                for (int m = 0; m < 4; ++m) { const int pos = (row0 + ai * HALF + m * 16) & (SEQ - 1);
#pragma unroll
                    for (int bj = 0; bj < 2; ++bj) { if (RK == 3 && bj == 1) continue; const int ct = bj * HALF + wc * 32 + 8 * fq;
                        const float* tp = (RK == 2) ? T64 + ((size_t)pos * 32 + ((ct & 63) >> 1)) * 2 : T128 + ((size_t)pos * 64 + ((ct & 127) >> 1)) * 2;
                        tb[m][bj][0] = *(const f32x4*)tp; tb[m][bj][1] = *(const f32x4*)(tp + 4); } }
            }
#pragma unroll
            for (int m = 0; m < 4; ++m) { bf16_t* rowp = U + (size_t)(row0 + ai * HALF + m * 16) * LDU + col0;
#pragma unroll
                for (int bj = 0; bj < 2; ++bj) { f32x4 v0 = acc[ai][bj][m][0] * rsv[m], v1 = acc[ai][bj][m][1] * rsv[m];
                    if (RK == 1 || RK == 2 || (RK == 3 && bj == 0)) { const f32x4 c0 = tb[m][bj][0], c1 = tb[m][bj][1];
                        const float a0 = v0[0] * c0[0] - v0[1] * c0[1], a1 = v0[0] * c0[1] + v0[1] * c0[0], a2 = v0[2] * c0[2] - v0[3] * c0[3], a3 = v0[2] * c0[3] + v0[3] * c0[2];
                        const float b0 = v1[0] * c1[0] - v1[1] * c1[1], b1 = v1[0] * c1[1] + v1[1] * c1[0], b2 = v1[2] * c1[2] - v1[3] * c1[3], b3 = v1[2] * c1[3] + v1[3] * c1[2];
                        v0 = (f32x4){a0, a1, a2, a3}; v1 = (f32x4){b0, b1, b2, b3}; }
                    u32x4 w; w.x = cvt_pk_bf16(v0[0], v0[1]); w.y = cvt_pk_bf16(v0[2], v0[3]); w.z = cvt_pk_bf16(v1[0], v1[1]); w.w = cvt_pk_bf16(v1[2], v1[3]);
                    *(u32x4*)(rowp + bj * HALF) = w; } }
        }
    }
    __device__ __forceinline__ void operator()(f32x4 (&acc)[2][2][4][2], const Unit& u, int wr, int wc, int fr, int fq, const Pre& pr) const {
        const int row0 = u.pm * BM + wr * 64 + fr;
        if (u.pn < 61) {
            if (u.pn < 4) tile_bf16<1>(acc, u, wr, wc, fr, fq, pr);
            else if (u.pn < 8) tile_bf16<2>(acc, u, wr, wc, fr, fq, pr);
            else if (u.pn == 60) tile_bf16<3>(acc, u, wr, wc, fr, fq, pr);
            else tile_bf16<0>(acc, u, wr, wc, fr, fq, pr);
        } else {
            const int col0 = wc * 32 + 8 * fq;
#pragma unroll
            for (int ai = 0; ai < 2; ++ai)
#pragma unroll
                for (int m = 0; m < 4; ++m) { const int row = row0 + ai * HALF + m * 16, pos = row & (SEQ - 1);
                    const float rsv = rs_of(pr, ai, m, fr); f32x4 v0 = acc[ai][0][m][0] * rsv, v1 = acc[ai][0][m][1] * rsv;
                    if (col0 < 64) { rot8(v0, v1, T64 + ((size_t)pos * 32 + (col0 >> 1)) * 2);
                        u32x4 w; w.x = cvt_pk_bf16(v0[0], v0[1]); w.y = cvt_pk_bf16(v0[2], v0[3]); w.z = cvt_pk_bf16(v1[0], v1[1]); w.w = cvt_pk_bf16(v1[2], v1[3]);
                        *(u32x4*)(IKB + (((((size_t)(row >> 6) * 2 + (row & 1)) * 4 + (col0 >> 4)) * 64 + ((row & 63) >> 1) + 32 * ((col0 >> 3) & 1)) << 3)) = w; }
                    else { float* rowp = UM + (size_t)row * LDM + col0; *(f32x4*)rowp = v0; *(f32x4*)(rowp + 4) = v1; } }
        }
    }
};
struct EpiGates {
    static constexpr bool PERM = true;
    struct Pre { unsigned bvp[2][2][2]; float rs2[2]; };
    __device__ __forceinline__ Pre pre(const Unit& u, int wr, int wc, int fr, int fq) const { const float* bb = bias + (u.pn >> 4) * D_MODEL + (u.pn & 15) * 256 + wc * 32 + 8 * fq; Pre p; const float* rp = RS + u.pm * BM + wr * 64 + fq * 16 + fr; p.rs2[0] = rp[0]; p.rs2[1] = rp[HALF];
#pragma unroll
        for (int bj = 0; bj < 2; ++bj)
#pragma unroll
            for (int n = 0; n < 2; ++n) { const f32x4 t = *(const f32x4*)(bb + bj * HALF + 4 * n); p.bvp[bj][n][0] = cvt_pk_bf16(t[0], t[1]); p.bvp[bj][n][1] = cvt_pk_bf16(t[2], t[3]); }
        return p; }
    __device__ __forceinline__ bool keep(const Unit&) const { return false; }
    unsigned char* G; const float* bias; const float* RS;
    static __device__ __forceinline__ unsigned q8(float x) { const float g = sigmoidf_(x); return (unsigned)fmaxf(__builtin_rintf(g * 255.0f), 1.0f); }
    __device__ __forceinline__ void operator()(f32x4 (&acc)[2][2][4][2], const Unit& u, int wr, int wc, int fr, int fq, const Pre& pr) const {
        const int row0 = u.pm * BM + wr * 64 + fr; const int br = u.pn >> 4, nb = u.pn & 15;
        const int col0 = nb * 256 + wc * 32 + 8 * fq;
        unsigned char* base = G + ((((size_t)br * (MTOK / BM) + u.pm) * 16 + nb) << 16) + (unsigned)(((wr * 4 + wc) * 64 + fq * 16 + fr) * 16); const float* bb = bias + br * D_MODEL + col0;
        f32x4 bv[2][2];
#pragma unroll
        for (int bj = 0; bj < 2; ++bj)
#pragma unroll
            for (int n = 0; n < 2; ++n) { const unsigned a = pr.bvp[bj][n][0], b = pr.bvp[bj][n][1]; bv[bj][n] = (f32x4){__uint_as_float(a << 16), __uint_as_float(a & 0xffff0000u), __uint_as_float(b << 16), __uint_as_float(b & 0xffff0000u)}; }
#pragma unroll
        for (int ai = 0; ai < 2; ++ai)
#pragma unroll
            for (int m = 0; m < 4; ++m) { u32x4 w;
#pragma unroll
                for (int bj = 0; bj < 2; ++bj) { const float rsv = __int_as_float(__builtin_amdgcn_ds_bpermute((m * 16 + fr) * 4, __float_as_int(pr.rs2[ai]))); const f32x4 v0 = acc[ai][bj][m][0] * rsv + bv[bj][0], v1 = acc[ai][bj][m][1] * rsv + bv[bj][1];
                    const unsigned lo = q8(v0[0]) | (q8(v0[1]) << 8) | (q8(v0[2]) << 16) | (q8(v0[3]) << 24), hi = q8(v1[0]) | (q8(v1[1]) << 8) | (q8(v1[2]) << 16) | (q8(v1[3]) << 24);
                    if (bj == 0) { w.x = lo; w.y = hi; } else { w.z = lo; w.w = hi; } }
                *(u32x4*)(base + (ai * 4 + m) * 8192) = w; }
    }
};
struct EpiBranch {
    static constexpr bool PERM = true;
    typedef NoPre Pre; __device__ __forceinline__ Pre pre(const Unit&, int, int, int, int) const { return Pre{}; }
    const unsigned char* G; bf16_t* merged;
    __device__ __forceinline__ bool keep(const Unit& u) const { return u.z < 3; }
    static __device__ __forceinline__ void gate8(const uint2 gw, float (&g)[8]) {
        g[0] = (float)(gw.x & 0xffu); g[1] = (float)((gw.x >> 8) & 0xffu); g[2] = (float)((gw.x >> 16) & 0xffu); g[3] = (float)(gw.x >> 24);
        g[4] = (float)(gw.y & 0xffu); g[5] = (float)((gw.y >> 8) & 0xffu); g[6] = (float)((gw.y >> 16) & 0xffu); g[7] = (float)(gw.y >> 24);
    }
    __device__ __forceinline__ void operator()(f32x4 (&acc)[2][2][4][2], const Unit& u, int wr, int wc, int fr, int fq, const Pre&) const {
        { unsigned m_ = ~0u; asm volatile("" : "+s"(m_)); const int ln_ = (int)__builtin_amdgcn_mbcnt_hi(m_, __builtin_amdgcn_mbcnt_lo(m_, 0u)); fr = ln_ & 15; fq = ln_ >> 4; }
        const int row0 = u.pm * BM + wr * 64 + fr; const int col0 = u.pn * BM + wc * 32 + 8 * fq; const int z = u.z;
        const unsigned toff = (unsigned)(((wr * 4 + wc) * 64 + fq * 16 + fr) * 16);
        const unsigned char* ga = G + ((((size_t)z * (MTOK / BM) + u.pm) * 16 + u.pn) << 16); const unsigned char* gb = G + ((((size_t)(z < 3 ? z + 1 : z) * (MTOK / BM) + u.pm) * 16 + u.pn) << 16);
        const bool last = z == 3;
        u32x4 ra[2][4], rb[2][4];
#pragma unroll
        for (int ai = 0; ai < 2; ++ai)
#pragma unroll
            for (int m = 0; m < 4; ++m) { const unsigned off = toff + (unsigned)((ai * 4 + m) * 8192);
                ra[ai][m] = *(const u32x4*)(ga + off); rb[ai][m] = *(const u32x4*)(gb + off); }
#pragma unroll
        for (int ai = 0; ai < 2; ++ai)
#pragma unroll
            for (int m = 0; m < 4; ++m)
#pragma unroll
                for (int bj = 0; bj < 2; ++bj) { float r[8], d[8]; gate8(bj ? make_uint2(ra[ai][m].z, ra[ai][m].w) : make_uint2(ra[ai][m].x, ra[ai][m].y), r); gate8(bj ? make_uint2(rb[ai][m].z, rb[ai][m].w) : make_uint2(rb[ai][m].x, rb[ai][m].y), d);
#pragma unroll
                    for (int j = 0; j < 8; ++j) r[j] = last ? r[j] * (1.0f / 255.0f) : r[j] * __builtin_amdgcn_rcpf(d[j]);
                    f32x4 v0 = acc[ai][bj][m][0], v1 = acc[ai][bj][m][1];
                    v0[0] *= r[0]; v0[1] *= r[1]; v0[2] *= r[2]; v0[3] *= r[3]; v1[0] *= r[4]; v1[1] *= r[5]; v1[2] *= r[6]; v1[3] *= r[7];
                    acc[ai][bj][m][0] = v0; acc[ai][bj][m][1] = v1; }
        if (last) {
#pragma unroll
            for (int ai = 0; ai < 2; ++ai)
#pragma unroll
                for (int m = 0; m < 4; ++m)
#pragma unroll
                    for (int bj = 0; bj < 2; ++bj) { const size_t off = (size_t)(row0 + ai * HALF + m * 16) * D_MODEL + col0 + bj * HALF;
                        const f32x4 v0 = acc[ai][bj][m][0], v1 = acc[ai][bj][m][1];
                        u32x4 w; w.x = cvt_pk_bf16(v0[0], v0[1]); w.y = cvt_pk_bf16(v0[2], v0[3]); w.z = cvt_pk_bf16(v1[0], v1[1]); w.w = cvt_pk_bf16(v1[2], v1[3]);
                        *(u32x4*)(merged + off) = w; }
        }
    }
};
struct EpiOut {
    static constexpr bool PERM = true;
    typedef NoPre Pre; __device__ __forceinline__ Pre pre(const Unit&, int, int, int, int) const { return Pre{}; }
    __device__ __forceinline__ bool keep(const Unit&) const { return false; }
    bf16_t* x; float* ps;
    __device__ __forceinline__ void operator()(f32x4 (&acc)[2][2][4][2], const Unit& u, int wr, int wc, int fr, int fq, const Pre&) const {
        const int row0 = u.pm * BM + wr * 64 + fr, col0 = u.pn * BM + wc * 32 + 8 * fq;
        const unsigned o0 = ((unsigned)row0 * (unsigned)D_MODEL + (unsigned)col0) * 2u;
        u32x4 b[2][4][2];
#pragma unroll
        for (int ai = 0; ai < 2; ++ai)
#pragma unroll
            for (int m = 0; m < 4; ++m)
#pragma unroll
                for (int bj = 0; bj < 2; ++bj) b[ai][m][bj] = *(const u32x4*)((const char*)x + (o0 + (unsigned)(((ai * HALF + m * 16) * D_MODEL + bj * HALF) * 2)));
        const int ln = fq * 16 + fr;
#pragma unroll
        for (int ai = 0; ai < 2; ++ai) {
#pragma unroll
            for (int m = 0; m < 4; ++m) { float ss = 0.f;
#pragma unroll
                for (int bj = 0; bj < 2; ++bj) { const u32x4 q = b[ai][m][bj]; const f32x4 v0 = acc[ai][bj][m][0], v1 = acc[ai][bj][m][1];
                    const float e0 = v0[0] + __uint_as_float(q.x << 16), e1 = v0[1] + __uint_as_float(q.x & 0xffff0000u), e2 = v0[2] + __uint_as_float(q.y << 16), e3 = v0[3] + __uint_as_float(q.y & 0xffff0000u);
                    const float e4 = v1[0] + __uint_as_float(q.z << 16), e5 = v1[1] + __uint_as_float(q.z & 0xffff0000u), e6 = v1[2] + __uint_as_float(q.w << 16), e7 = v1[3] + __uint_as_float(q.w & 0xffff0000u);
                    ss += (e0 * e0 + e1 * e1) + (e2 * e2 + e3 * e3) + (e4 * e4 + e5 * e5) + (e6 * e6 + e7 * e7);
                    u32x4 w; w.x = cvt_pk_bf16(e0, e1); w.y = cvt_pk_bf16(e2, e3); w.z = cvt_pk_bf16(e4, e5); w.w = cvt_pk_bf16(e6, e7);
                    *(u32x4*)((char*)x + (o0 + (unsigned)(((ai * HALF + m * 16) * D_MODEL + bj * HALF) * 2))) = w; }
                ss += __int_as_float(__builtin_amdgcn_ds_bpermute((ln ^ 16) * 4, __float_as_int(ss)));
                ss += __int_as_float(__builtin_amdgcn_ds_bpermute((ln ^ 32) * 4, __float_as_int(ss)));
                if (fq == 0) ps[(unsigned)(row0 + ai * HALF + m * 16) * 64u + (unsigned)(u.pn * 4 + wc)] = ss; }
        }
    }
};

template <class Epi, class Sched>
__device__ __forceinline__ void gemm_phase(LAS unsigned char* lds, const Gemm g, const Sched& S, const Epi& E, const int tid) {
    const int wid = __builtin_amdgcn_readfirstlane(tid >> 6), lane = tid & 63, wr = wid >> 2, wc = wid & 3, fr = lane & 15, fq = lane >> 4;
    int K = g.K; asm volatile("" : "+s"(K));
    const int nt = K / BK;
    unsigned voffA[2], voffB[2];
#pragma unroll
    for (int i = 0; i < 2; ++i) { int R, C; stage_rc(tid * 16 + i * 8192, R, C); const int Rb = Epi::PERM ? ((R & ~31) + perm32(R & 31)) : R;
        voffA[i] = (unsigned)(R * g.lda + C) * 2u; voffB[i] = (unsigned)(Rb * g.ldb + C) * 2u; }
    const size_t kstep = (size_t)(BK * 2);
    const size_t hstepA = (size_t)HALF * g.lda * 2, hstepB = (size_t)HALF * g.ldb * 2;
    const unsigned ldsw = (unsigned)wid * 1024u;
    const int aoff = lds_byte(wr * 64 + fr, fq * 8), boff = lds_byte(wc * 32 + fr, fq * 8);
#define PG8_SA(b, h) (((b) * 2 + (h)) * HTB)
#define PG8_SB(b, h) ((4 + (b) * 2 + (h)) * HTB)
#define PG8_STAGE(bufoff, gbase, voff) do { _Pragma("unroll") for (int _i = 0; _i < 2; ++_i) \
        __builtin_amdgcn_global_load_lds((const unsigned*)((const char*)(gbase) + (voff)[_i]), (LAS unsigned*)(lds + (bufoff) + ldsw + _i * 8192), 16, 0, 0); } while (0)
#define PG8_LDA(dst, b, h) do { _Pragma("unroll") for (int m = 0; m < 4; ++m) _Pragma("unroll") for (int k = 0; k < 2; ++k) dst[m][k] = *(const LAS bf16x8*)(lds + PG8_SA(b, h) + aoff + m * 2048 + k * 1024); } while (0)
#define PG8_LDB(dst, b, h) do { _Pragma("unroll") for (int n = 0; n < 2; ++n) _Pragma("unroll") for (int k = 0; k < 2; ++k) dst[n][k] = *(const LAS bf16x8*)(lds + PG8_SB(b, h) + boff + n * 2048 + k * 1024); } while (0)
#define PG8_MMA(ai, bj, At, Bt) do { __builtin_amdgcn_s_setprio(1); _Pragma("unroll") for (int m = 0; m < 4; ++m) _Pragma("unroll") for (int n = 0; n < 2; ++n) _Pragma("unroll") for (int k = 0; k < 2; ++k) \
        acc[ai][bj][m][n] = __builtin_amdgcn_mfma_f32_16x16x32_bf16(Bt[n][k], At[m][k], acc[ai][bj][m][n], 0, 0, 0); __builtin_amdgcn_s_setprio(0); } while (0)
#define PG8_WAIT_V(n) asm volatile("s_waitcnt vmcnt(" #n ")" ::: "memory")
#define PG8_WAIT_L(n) asm volatile("s_waitcnt lgkmcnt(" #n ")" ::: "memory")
#define PG8_BAR __builtin_amdgcn_s_barrier()
#define PG8_SCHED __builtin_amdgcn_sched_barrier(0)
    Unit cur, nxt; int ui = 0;
    if (!S.next(0, cur)) return;
    f32x4 acc[2][2][4][2];
#pragma unroll
    for (int a = 0; a < 2; ++a)
#pragma unroll
        for (int b = 0; b < 2; ++b)
#pragma unroll
            for (int m = 0; m < 4; ++m)
#pragma unroll
                for (int n = 0; n < 2; ++n) acc[a][b][m][n] = (f32x4){0.f, 0.f, 0.f, 0.f};
    bf16x8 At[4][2], B0[2][2], B1[2][2];
    typename Epi::Pre pre = E.pre(cur, wr, wc, fr, fq);
    const char* cA = (const char*)g.A + S.a_off(cur, g); const char* cB = (const char*)g.Bt + S.b_off(cur, g);
    PG8_STAGE(PG8_SB(0, 0), cB, voffB); PG8_STAGE(PG8_SA(0, 0), cA, voffA); PG8_STAGE(PG8_SB(0, 1), cB + hstepB, voffB); PG8_STAGE(PG8_SA(0, 1), cA + hstepA, voffA);
    if (wr == 1) PG8_BAR;
    PG8_WAIT_V(4); PG8_BAR;
    PG8_STAGE(PG8_SB(1, 0), cB + kstep, voffB); PG8_STAGE(PG8_SA(1, 0), cA + kstep, voffA); PG8_STAGE(PG8_SB(1, 1), cB + hstepB + kstep, voffB);
    PG8_WAIT_V(6); PG8_BAR;
    for (;;) {
        const bool has_next = S.next(ui + 1, nxt);
        const char* nA = has_next ? (const char*)g.A + S.a_off(nxt, g) : cA; const char* nB = has_next ? (const char*)g.Bt + S.b_off(nxt, g) : cB;
        for (int t = 0; t < nt; t += 2) {
            const bool last = (t == nt - 2);
            const char* a1 = cA + (size_t)(t + 1) * kstep;
            const char* a2 = last ? nA : cA + (size_t)(t + 2) * kstep; const char* b2 = last ? nB : cB + (size_t)(t + 2) * kstep;
            const char* a3 = a2 + kstep; const char* b3 = b2 + kstep;
            PG8_LDB(B0, 0, 0); PG8_SCHED; PG8_LDA(At, 0, 0); PG8_STAGE(PG8_SA(1, 1), a1 + hstepA, voffA);
            PG8_WAIT_L(8); PG8_BAR; PG8_WAIT_L(0); PG8_MMA(0, 0, At, B0); PG8_BAR; PG8_SCHED;
            PG8_LDB(B1, 0, 1); PG8_STAGE(PG8_SB(0, 0), b2, voffB);
            PG8_BAR; PG8_WAIT_L(0); PG8_MMA(0, 1, At, B1); PG8_BAR;
            PG8_LDA(At, 0, 1); PG8_STAGE(PG8_SA(0, 0), a2, voffA);
            PG8_BAR; PG8_WAIT_L(0); PG8_MMA(1, 0, At, B0); PG8_BAR; PG8_SCHED;
            PG8_STAGE(PG8_SB(0, 1), b2 + hstepB, voffB);
            PG8_WAIT_V(6); PG8_BAR; PG8_MMA(1, 1, At, B1); PG8_BAR;
            PG8_LDB(B0, 1, 0); PG8_SCHED; PG8_LDA(At, 1, 0); PG8_STAGE(PG8_SA(0, 1), a2 + hstepA, voffA);
            PG8_WAIT_L(8); PG8_BAR; PG8_WAIT_L(0); PG8_MMA(0, 0, At, B0); PG8_BAR; PG8_SCHED;
            PG8_LDB(B1, 1, 1); PG8_STAGE(PG8_SB(1, 0), b3, voffB);
            PG8_BAR; PG8_WAIT_L(0); PG8_MMA(0, 1, At, B1); PG8_BAR;
            PG8_LDA(At, 1, 1); PG8_STAGE(PG8_SA(1, 0), a3, voffA);
            PG8_BAR; PG8_WAIT_L(0); PG8_MMA(1, 0, At, B0); PG8_BAR; PG8_SCHED;
            PG8_STAGE(PG8_SB(1, 1), b3 + hstepB, voffB);
            PG8_WAIT_V(6); PG8_BAR; PG8_MMA(1, 1, At, B1); PG8_BAR;
        }
        E(acc, cur, wr, wc, fr, fq, pre);
        if (!has_next) break;
        if (!E.keep(cur))
#pragma unroll
        for (int a = 0; a < 2; ++a)
#pragma unroll
            for (int b = 0; b < 2; ++b)
#pragma unroll
                for (int m = 0; m < 4; ++m)
#pragma unroll
                    for (int n = 0; n < 2; ++n) acc[a][b][m][n] = (f32x4){0.f, 0.f, 0.f, 0.f};
        cur = nxt; cA = nA; cB = nB; ++ui; pre = E.pre(cur, wr, wc, fr, fq);
    }
    PG8_WAIT_V(0);
    if (wr == 0) PG8_BAR;
    PG8_BAR;
#undef PG8_SA
#undef PG8_SB
#undef PG8_STAGE
#undef PG8_LDA
#undef PG8_LDB
#undef PG8_MMA
#undef PG8_WAIT_V
#undef PG8_WAIT_L
#undef PG8_BAR
#undef PG8_SCHED
}
}

namespace att {
typedef short bf16x8 __attribute__((ext_vector_type(8)));
typedef short s16x4 __attribute__((ext_vector_type(4)));
typedef float f32x16 __attribute__((ext_vector_type(16)));
typedef float f32x4 __attribute__((ext_vector_type(4)));
typedef unsigned u32x4 __attribute__((ext_vector_type(4)));
constexpr int D = 128, KVBLK = 64, QBLK = 32, SHM_V = KVBLK * D * 2, SHM_K = KVBLK * D * 2;
constexpr float SCALE = 0.08838834764831845f, THR = 8.f;
#define KSWZ(row, colB) ((row) * 256 + ((colB) ^ (((row) & 7) << 4)))
#define SBAR() __builtin_amdgcn_sched_barrier(0)
__device__ __forceinline__ int v_st(int k, int c) { const int kk = (k & ~0xC) | ((k & 4) << 1) | ((k & 8) >> 1); return ((kk >> 3) * 4 + (c >> 5)) * 512 + ((kk & 7) * 32 + (c & 31)) * 2; }
__device__ __forceinline__ int v_rd_base(int lane) { return ((lane & 3) << 3) | (((lane >> 2) & 3) << 6) | (((lane >> 4) & 1) << 5) | (((lane >> 5) & 1) << 8); }
constexpr int v_rd_off(int d0, int ks, int half) { return d0 * 512 + ks * 4096 + half * 2048; }
__device__ __forceinline__ int crow(int r, int hi) { return (r & 3) + 8 * (r >> 2) + 4 * hi; }
__device__ __forceinline__ unsigned cvtpk(float lo, float hi) { return pg8::cvt_pk_bf16(lo, hi); }
__device__ __forceinline__ void mask_tile(f32x16& p0, f32x16& p1, int dq) {
    const float NEG = -__builtin_inff();
#pragma unroll
    for (int r = 0; r < 16; ++r) {
        const int c = (r & 3) + 8 * (r >> 2);
        if (dq - c < 0) p0[r] = NEG;
        if (dq - c - 32 < 0) p1[r] = NEG;
    }
}
__device__ __forceinline__ void partialSM(f32x16& p0, f32x16& p1, float& m_reg, float& mn, float& alpha) {
    float pmax = p0[0];
#pragma unroll
    for (int r = 1; r < 16; ++r) pmax = fmaxf(pmax, p0[r]);
#pragma unroll
    for (int r = 0; r < 16; ++r) pmax = fmaxf(pmax, p1[r]);
    { auto rr = __builtin_amdgcn_permlane32_swap(__float_as_uint(pmax), __float_as_uint(pmax), false, false);
      pmax = fmaxf(__uint_as_float(rr[0]), __uint_as_float(rr[1])); }
    constexpr float C2 = 1.4426950408889634f * SCALE;
    if (__builtin_expect(__all((pmax - m_reg) * SCALE <= THR), 1)) { mn = m_reg; alpha = 1.f; }
    else { mn = fmaxf(m_reg, pmax); alpha = __builtin_amdgcn_exp2f((m_reg - mn) * C2); m_reg = mn; }
    const float mnL = -mn * C2;
#pragma unroll
    for (int r = 0; r < 16; ++r) p0[r] = fmaf(p0[r], C2, mnL);
#pragma unroll
    for (int r = 0; r < 16; ++r) p1[r] = fmaf(p1[r], C2, mnL);
#pragma unroll
    for (int r = 0; r < 16; ++r) p0[r] = __builtin_amdgcn_exp2f(p0[r]);
}
__device__ __forceinline__ void finishSM(f32x16& p0, f32x16& p1, float alpha, float& l_reg, bf16x8& pa0, bf16x8& pa1, bf16x8& pa2, bf16x8& pa3) {
#pragma unroll
    for (int r = 0; r < 16; ++r) p1[r] = __builtin_amdgcn_exp2f(p1[r]);
    float ps = 0;
#pragma unroll
    for (int r = 0; r < 16; ++r) ps += p0[r];
#pragma unroll
    for (int r = 0; r < 16; ++r) ps += p1[r];
    { auto rr = __builtin_amdgcn_permlane32_swap(__float_as_uint(ps), __float_as_uint(ps), false, false);
      ps = __uint_as_float(rr[0]) + __uint_as_float(rr[1]); }
    l_reg = l_reg * alpha + ps;
#define PK4(P, B_, OUT) do { unsigned a0 = cvtpk(P[B_+0], P[B_+1]), a1 = cvtpk(P[B_+2], P[B_+3]);                          \
        unsigned b0 = cvtpk(P[B_+4], P[B_+5]), b1 = cvtpk(P[B_+6], P[B_+7]);                                             \
        auto r0 = __builtin_amdgcn_permlane32_swap(a0, b0, false, false); auto r1 = __builtin_amdgcn_permlane32_swap(a1, b1, false, false); \
        u32x4 w = {r0[0], r1[0], r0[1], r1[1]}; OUT = *reinterpret_cast<bf16x8*>(&w); } while (0)
    PK4(p0, 0, pa0); PK4(p0, 8, pa1); PK4(p1, 0, pa2); PK4(p1, 8, pa3);
#undef PK4
}
__device__ __forceinline__ void qkt(f32x16& p0, f32x16& p1, const LAS char* Kt, int r32, int hi, const bf16x8* qr) {
    p0 = f32x16{}; p1 = f32x16{};
    const LAS char* kb[4];
#pragma unroll
    for (int dd = 0; dd < 4; ++dd) kb[dd] = Kt + KSWZ(r32, (dd * 16 + hi * 8) * 2);
#pragma unroll
    for (int d0 = 0; d0 < 8; ++d0) { const LAS char* a = kb[d0 & 3] + (d0 >> 2) * 128;
        bf16x8 b0 = *reinterpret_cast<const LAS bf16x8*>(a);
        bf16x8 b1 = *reinterpret_cast<const LAS bf16x8*>(a + 32 * 256);
        p0 = __builtin_amdgcn_mfma_f32_32x32x16_bf16(b0, qr[d0], p0, 0, 0, 0);
        p1 = __builtin_amdgcn_mfma_f32_32x32x16_bf16(b1, qr[d0], p1, 0, 0, 0); }
}
__device__ __forceinline__ void pv_tile(f32x16* o, int vb0, bf16x8 pa0, bf16x8 pa1, bf16x8 pa2, bf16x8 pa3) {
#define TRRD(dst, off) asm volatile("ds_read_b64_tr_b16 %0, %1 offset:%2" : "=&v"(dst) : "v"(vb0), "i"(off) : "memory")
#define PV_D0(d0) do { s16x4 l0, l1, l2, l3, h0, h1, h2, h3; constexpr int b_ = v_rd_off(d0, 0, 0); \
        TRRD(l0, b_); TRRD(h0, b_ + 2048); TRRD(l1, b_ + 4096); TRRD(h1, b_ + 6144); TRRD(l2, b_ + 8192); TRRD(h2, b_ + 10240); TRRD(l3, b_ + 12288); TRRD(h3, b_ + 14336); \
        asm volatile("s_waitcnt lgkmcnt(0)" ::: "memory"); SBAR();   \
        o[d0] = __builtin_amdgcn_mfma_f32_32x32x16_bf16(pa0, (bf16x8){l0[0], l0[1], l0[2], l0[3], h0[0], h0[1], h0[2], h0[3]}, o[d0], 0, 0, 0);   \
        o[d0] = __builtin_amdgcn_mfma_f32_32x32x16_bf16(pa1, (bf16x8){l1[0], l1[1], l1[2], l1[3], h1[0], h1[1], h1[2], h1[3]}, o[d0], 0, 0, 0);   \
        o[d0] = __builtin_amdgcn_mfma_f32_32x32x16_bf16(pa2, (bf16x8){l2[0], l2[1], l2[2], l2[3], h2[0], h2[1], h2[2], h2[3]}, o[d0], 0, 0, 0);   \
        o[d0] = __builtin_amdgcn_mfma_f32_32x32x16_bf16(pa3, (bf16x8){l3[0], l3[1], l3[2], l3[3], h3[0], h3[1], h3[2], h3[3]}, o[d0], 0, 0, 0); } while (0)
    PV_D0(0); PV_D0(1); PV_D0(2); PV_D0(3);
#undef PV_D0
#undef TRRD
}
}


#define GAS __attribute__((address_space(1)))
typedef GAS unsigned gu32;
#define RLX_AGENT __ATOMIC_RELAXED, __HIP_MEMORY_SCOPE_AGENT
#define LDS_WAIT() asm volatile("s_waitcnt lgkmcnt(0)" ::: "memory")
#define VM_WAIT() asm volatile("s_waitcnt vmcnt(0)" ::: "memory")
typedef unsigned v4u __attribute__((ext_vector_type(4)));

#define XB_TMO      128
#define XB_XCNT(j)  (256  + 64 * (j))
#define XB_XSUB(j)  (1280 + 64 * (j))
#define XB_XGEN(j)  (2304 + 64 * (j))
#define XB_TOP      3328
#define XB_TOPGEN   3392
#define XCD_BAR_WORDS 3456
#define XB_SPIN_CAP (1u << 18)
__device__ __forceinline__ unsigned xb_ld(unsigned* p)              { return __hip_atomic_load(p, __ATOMIC_RELAXED, __HIP_MEMORY_SCOPE_AGENT); }
__device__ __forceinline__ unsigned xb_add(unsigned* p, unsigned v) { return __hip_atomic_fetch_add(p, v, __ATOMIC_RELAXED, __HIP_MEMORY_SCOPE_AGENT); }
__device__ __forceinline__ unsigned xb_xcc_id() { return (unsigned)__builtin_amdgcn_s_getreg((3 << 11) | 20) & 0xFu; }
#define XB_SPIN(cond, bar) do { unsigned _sp = 0; while (cond) { __builtin_amdgcn_s_sleep(1); \
    if ((++_sp & 255u) == 0u) { if (xb_ld(&(bar)[XB_TMO])) break; if (_sp > XB_SPIN_CAP) { atomicAdd(&(bar)[XB_TMO], 1u); break; } } } } while (0)
struct XcdBarrier { unsigned* bar; unsigned x; volatile LAS unsigned* st; };
__device__ __forceinline__ XcdBarrier xcd_barrier_post(unsigned* bar, volatile LAS unsigned* st) {
    XcdBarrier b; b.bar = bar; b.x = xb_xcc_id(); b.st = st;
    if (threadIdx.x == 0) (void)xb_add(&bar[XB_XCNT(b.x)], 1u);
    return b;
}
__device__ __forceinline__ void xcd_barrier_complete(unsigned* bar, unsigned x, unsigned& nloc, unsigned& nx) {
    const unsigned G = gridDim.x * gridDim.y * gridDim.z;
    unsigned sum, cnt, mine, sp = 0u;
    for (;;) {
        sum = 0u; cnt = 0u; mine = 0u;
#pragma unroll
        for (unsigned j = 0; j < 16; ++j) { const unsigned c = xb_ld(&bar[XB_XCNT(j)]); sum += c; cnt += (c > 0u) ? 1u : 0u; mine = (j == x) ? c : mine; }
        if (sum == G) break;
        __builtin_amdgcn_s_sleep(1);
        if ((++sp & 255u) == 0u) { if (xb_ld(&bar[XB_TMO])) break; if (sp > XB_SPIN_CAP) { atomicAdd(&bar[XB_TMO], 1u); break; } }
    }
    nloc = mine > 0u ? mine : 1u; nx = cnt > 0u ? cnt : 1u;
}
__device__ __forceinline__ void xcd_barrier(const XcdBarrier& b) {
    asm volatile("s_waitcnt vmcnt(0)" ::: "memory");
    __syncthreads();
    if (threadIdx.x == 0) {
        unsigned* bar = b.bar;
        __builtin_amdgcn_s_waitcnt(0);
        unsigned nloc = b.st[0], nx = b.st[1];
        if (nloc == 0u) { xcd_barrier_complete(bar, b.x, nloc, nx); b.st[0] = nloc; b.st[1] = nx; }
        const unsigned old = xb_add(&bar[XB_XSUB(b.x)], 1u);
        const unsigned gen = old / nloc;
        if (old + 1u == (gen + 1u) * nloc) {
            __builtin_amdgcn_fence(__ATOMIC_RELEASE, "agent");
            asm volatile("s_waitcnt vmcnt(0)" ::: "memory");
            const unsigned og = xb_add(&bar[XB_TOP], 1u);
            const unsigned tg = og / nx;
            if (og + 1u == (tg + 1u) * nx) xb_add(&bar[XB_TOPGEN], 1u);
            else XB_SPIN(xb_ld(&bar[XB_TOPGEN]) == tg, bar);
            __builtin_amdgcn_fence(__ATOMIC_ACQUIRE, "agent");
            xb_add(&bar[XB_XGEN(b.x)], 1u);
            asm volatile("s_waitcnt vmcnt(0)" ::: "memory");
        } else {
            XB_SPIN(xb_ld(&bar[XB_XGEN(b.x)]) == gen, bar);
            __builtin_amdgcn_fence(__ATOMIC_ACQUIRE, "agent");
            asm volatile("s_waitcnt vmcnt(0)" ::: "memory");
        }
    }
    __syncthreads();
}

constexpr int PH_PRO = 0, PH_PER_LAYER = 8, PH_NORM = 0, PH_INPROJ = 1, PH_M1 = 2, PH_M2 = 3, PH_M3 = 4, PH_M4 = 5, PH_BRANCH = 6, PH_OUT = 7;
constexpr int PH_FINAL = 1 + DEPTH * PH_PER_LAYER, PH_COUNT = PH_FINAL + 1;
constexpr int RING_OFF = 0, RING_BYTES = 131072, LDSCTL_OFF = 147456, MISC_OFF = LDSCTL_OFF + 320, LDS_BYTES = 151552;
constexpr int NWAVES = 8;
constexpr int CW_BAR = 4096;
constexpr int MAX_BAR_REGIONS = 64;
static_assert((CW_BAR + MAX_BAR_REGIONS * XCD_BAR_WORDS) * 4 <= (1 << 20), "CTL region");
static_assert(MISC_OFF + 128 <= LDS_BYTES, "LDS map");

struct Args { const float* in[12]; float* out; unsigned char* ws; int ph_lo, ph_hi, li, pad; };
typedef const __attribute__((address_space(4))) Args* ArgsP;


__device__ __forceinline__ void p0_item_load(const float* W, int ldw, int nblk, int item, int lane, bool mapped, float (&tv)[32]) {
    const int kb = item / nblk, nb = item % nblk, k0 = 64 * kb, n0 = 32 * nb;
    const int nn = n0 + (lane & 31); const int sc = mapped ? inproj_src_col(nn) : nn; const int scc = sc >= 0 ? sc : 0;
#pragma unroll
    for (int i = 0; i < 32; ++i) { const int kk = 2 * i + (lane >> 5); const float v = W[(size_t)(k0 + kk) * ldw + scc]; tv[i] = sc >= 0 ? v : 0.f; }
}
__device__ __forceinline__ void p0_item_store(int K, int nblk, bf16_t* WT, LAS float* scr, int item, int lane, const float (&tv)[32], const float* kscale) {
    const int kb = item / nblk, nb = item % nblk, k0 = 64 * kb, n0 = 32 * nb;
    float4 ks0 = make_float4(1.f, 1.f, 1.f, 1.f), ks1 = ks0;
    if (kscale) { ks0 = *(const float4*)(kscale + k0 + 8 * (lane & 7)); ks1 = *(const float4*)(kscale + k0 + 8 * (lane & 7) + 4); }
#pragma unroll
    for (int i = 0; i < 32; ++i) { const int kk = 2 * i + (lane >> 5); scr[kk * 33 + (lane & 31)] = tv[i]; }
    LDS_WAIT(); asm volatile("" ::: "memory");
    const int c = lane & 7;
#pragma unroll
    for (int j = 0; j < 4; ++j) { const int n = (lane >> 3) + 8 * j; const LAS float* s = scr + (8 * c) * 33 + n;
        v4u o; o.x = pk2(s[0 * 33] * ks0.x, s[1 * 33] * ks0.y); o.y = pk2(s[2 * 33] * ks0.z, s[3 * 33] * ks0.w); o.z = pk2(s[4 * 33] * ks1.x, s[5 * 33] * ks1.y); o.w = pk2(s[6 * 33] * ks1.z, s[7 * 33] * ks1.w);
        *(v4u*)(WT + (size_t)(n0 + n) * K + k0 + 8 * c) = o; }
    LDS_WAIT(); asm volatile("" ::: "memory");
}
template <bool OUT_F32> __device__ __forceinline__ void rms_row(const float* xrow, const float* w, bf16_t* ob, float* of, bf16_t* xcopy, int lane) {
    const float4* xr = (const float4*)xrow;
    float4 v[16]; float s = 0.f;
#pragma unroll
    for (int j = 0; j < 16; ++j) { v[j] = xr[j * 64 + lane]; s += v[j].x * v[j].x + v[j].y * v[j].y + v[j].z * v[j].z + v[j].w * v[j].w; }
    if (xcopy) {
#pragma unroll
        for (int j = 0; j < 16; ++j) ((uint2*)xcopy)[j * 64 + lane] = make_uint2(pk2(v[j].x, v[j].y), pk2(v[j].z, v[j].w)); }
    s = wave_sum(s);
    const float r = rsqrtf(s * (1.0f / D_MODEL) + 1e-6f);
#pragma unroll
    for (int j = 0; j < 16; ++j) { const float4 ww = ((const float4*)w)[j * 64 + lane];
        const float a = v[j].x * r * ww.x, b = v[j].y * r * ww.y, c = v[j].z * r * ww.z, d = v[j].w * r * ww.w;
        if (OUT_F32) ((float4*)of)[j * 64 + lane] = make_float4(a, b, c, d);
        else ((uint2*)ob)[j * 64 + lane] = make_uint2(pk2(a, b), pk2(c, d)); }
}
__device__ __forceinline__ void rstd_row_f(const float* xrow, bf16_t* xcopy, float* rs, int lane) {
    const float4* xr = (const float4*)xrow;
    float4 v[16]; float s = 0.f;
#pragma unroll
    for (int j = 0; j < 16; ++j) { v[j] = xr[j * 64 + lane]; s += v[j].x * v[j].x + v[j].y * v[j].y + v[j].z * v[j].z + v[j].w * v[j].w; }
#pragma unroll
    for (int j = 0; j < 16; ++j) ((uint2*)xcopy)[j * 64 + lane] = make_uint2(pk2(v[j].x, v[j].y), pk2(v[j].z, v[j].w));
    s = wave_sum(s);
    if (lane == 0) *rs = rsqrtf(s * (1.0f / D_MODEL) + 1e-6f);
}
__device__ __forceinline__ void rstd_row_b(const bf16_t* xrow, float* rs, int lane) {
    v4u q[8]; float s = 0.f;
#pragma unroll
    for (int j = 0; j < 8; ++j) q[j] = ((const v4u*)xrow)[j * 64 + lane];
#pragma unroll
    for (int j = 0; j < 8; ++j) { const float a0 = __uint_as_float(q[j].x << 16), a1 = __uint_as_float(q[j].x & 0xffff0000u), a2 = __uint_as_float(q[j].y << 16), a3 = __uint_as_float(q[j].y & 0xffff0000u);
        const float a4 = __uint_as_float(q[j].z << 16), a5 = __uint_as_float(q[j].z & 0xffff0000u), a6 = __uint_as_float(q[j].w << 16), a7 = __uint_as_float(q[j].w & 0xffff0000u);
        s += (a0 * a0 + a1 * a1) + (a2 * a2 + a3 * a3) + (a4 * a4 + a5 * a5) + (a6 * a6 + a7 * a7); }
    s = wave_sum(s);
    if (lane == 0) *rs = rsqrtf(s * (1.0f / D_MODEL) + 1e-6f);
}
__device__ __forceinline__ void rstd_row_b2(const bf16_t* xa, const bf16_t* xb, float* rsa, float* rsb, int lane) {
    v4u qa[8], qb[8]; float sa = 0.f, sb = 0.f;
#pragma unroll
    for (int j = 0; j < 8; ++j) { qa[j] = ((const v4u*)xa)[j * 64 + lane]; qb[j] = ((const v4u*)xb)[j * 64 + lane]; }
#pragma unroll
    for (int j = 0; j < 8; ++j) {
        { const float a0 = __uint_as_float(qa[j].x << 16), a1 = __uint_as_float(qa[j].x & 0xffff0000u), a2 = __uint_as_float(qa[j].y << 16), a3 = __uint_as_float(qa[j].y & 0xffff0000u);
          const float a4 = __uint_as_float(qa[j].z << 16), a5 = __uint_as_float(qa[j].z & 0xffff0000u), a6 = __uint_as_float(qa[j].w << 16), a7 = __uint_as_float(qa[j].w & 0xffff0000u);
          sa += (a0 * a0 + a1 * a1) + (a2 * a2 + a3 * a3) + (a4 * a4 + a5 * a5) + (a6 * a6 + a7 * a7); }
        { const float a0 = __uint_as_float(qb[j].x << 16), a1 = __uint_as_float(qb[j].x & 0xffff0000u), a2 = __uint_as_float(qb[j].y << 16), a3 = __uint_as_float(qb[j].y & 0xffff0000u);
          const float a4 = __uint_as_float(qb[j].z << 16), a5 = __uint_as_float(qb[j].z & 0xffff0000u), a6 = __uint_as_float(qb[j].w << 16), a7 = __uint_as_float(qb[j].w & 0xffff0000u);
          sb += (a0 * a0 + a1 * a1) + (a2 * a2 + a3 * a3) + (a4 * a4 + a5 * a5) + (a6 * a6 + a7 * a7); } }
    sa = wave_sum(sa); sb = wave_sum(sb);
    if (lane == 0) { *rsa = rsqrtf(sa * (1.0f / D_MODEL) + 1e-6f); *rsb = rsqrtf(sb * (1.0f / D_MODEL) + 1e-6f); }
}
template <bool OUT_F32> __device__ __forceinline__ void rms_row_b(const bf16_t* xrow, const float* w, bf16_t* ob, float* of, int lane) {
    v4u q[8]; float s = 0.f;
#pragma unroll
    for (int j = 0; j < 8; ++j) q[j] = ((const v4u*)xrow)[j * 64 + lane];
#pragma unroll
    for (int j = 0; j < 8; ++j) { const float a0 = __uint_as_float(q[j].x << 16), a1 = __uint_as_float(q[j].x & 0xffff0000u), a2 = __uint_as_float(q[j].y << 16), a3 = __uint_as_float(q[j].y & 0xffff0000u);
        const float a4 = __uint_as_float(q[j].z << 16), a5 = __uint_as_float(q[j].z & 0xffff0000u), a6 = __uint_as_float(q[j].w << 16), a7 = __uint_as_float(q[j].w & 0xffff0000u);
        s += (a0 * a0 + a1 * a1) + (a2 * a2 + a3 * a3) + (a4 * a4 + a5 * a5) + (a6 * a6 + a7 * a7); }
    s = wave_sum(s);
    const float r = rsqrtf(s * (1.0f / D_MODEL) + 1e-6f);
#pragma unroll
    for (int j = 0; j < 8; ++j) { const float4 w0 = ((const float4*)w)[(j * 64 + lane) * 2], w1 = ((const float4*)w)[(j * 64 + lane) * 2 + 1];
        const float a0 = __uint_as_float(q[j].x << 16) * r * w0.x, a1 = __uint_as_float(q[j].x & 0xffff0000u) * r * w0.y, a2 = __uint_as_float(q[j].y << 16) * r * w0.z, a3 = __uint_as_float(q[j].y & 0xffff0000u) * r * w0.w;
        const float a4 = __uint_as_float(q[j].z << 16) * r * w1.x, a5 = __uint_as_float(q[j].z & 0xffff0000u) * r * w1.y, a6 = __uint_as_float(q[j].w << 16) * r * w1.z, a7 = __uint_as_float(q[j].w & 0xffff0000u) * r * w1.w;
        if (OUT_F32) { ((float4*)of)[(j * 64 + lane) * 2] = make_float4(a0, a1, a2, a3); ((float4*)of)[(j * 64 + lane) * 2 + 1] = make_float4(a4, a5, a6, a7); }
        else { v4u o; o.x = pk2(a0, a1); o.y = pk2(a2, a3); o.z = pk2(a4, a5); o.w = pk2(a6, a7); ((v4u*)ob)[j * 64 + lane] = o; } }
}


constexpr size_t WS_BSC = WS_CF + (size_t)BATCH * 8 * SEQ * 4;
static __device__ __forceinline__ void fox_prep(ArgsP ap, int l, LAS unsigned char* lds, int tidv, int vcu) {
    if (vcu >= BATCH * 8) return;
    const int bh = vcu, b = bh >> 3, h = bh & 7;
    const float* UM = (const float*)(ap->ws + WS_UM); float* CF = (float*)(ap->ws + WS_CF); float* BSC = (float*)(ap->ws + WS_BSC);
    const float bias = ap->in[3][l * 8 + h];
    LAS double* part = (LAS double*)lds;
    double loc[16]; double s = 0.0;
#pragma unroll
    for (int j = 0; j < 16; ++j) { const int t = tidv * 16 + j; const float x = UM[((size_t)b * SEQ + t) * LDM + MC_CF + h] + bias;
        const float ls = fminf(x, 0.f) - log1pf(expf(-fabsf(x))); s += (double)ls; loc[j] = s; }
    part[tidv] = s; __syncthreads();
    double off = 0.0; for (int i = 0; i < tidv; ++i) off += part[i];
#pragma unroll
    for (int j = 0; j < 16; ++j) { const double c = off + loc[j]; CF[(size_t)bh * SEQ + tidv * 16 + j] = (float)c; BSC[(size_t)bh * SEQ + tidv * 16 + j] = (float)(-c * 11.313708498984761); }
    __syncthreads();
}
static __device__ __forceinline__ void fox_attn_unit(const bf16_t* U, const float* bsc  , const float* cf  , float thr, bf16_t* Y, int b, int h, int qb, LAS unsigned char* ldsb, int tidv) {
    using namespace att;
    const int wid = __builtin_amdgcn_readfirstlane(tidv >> 6), lane = tidv & 63, r32 = lane & 31, hi = lane >> 5;
    const int P0 = qb * 256; const size_t brow = (size_t)b * SEQ;
    int j_lo;
    {   const float cp0 = cf[P0]; const int jd = P0 / KVBLK;
        const bool k0 = (lane <= jd) && (cp0 - cf[lane * KVBLK + KVBLK - 1] > -thr), k1 = (lane + 64 <= jd) && (cp0 - cf[(lane + 64) * KVBLK + KVBLK - 1] > -thr);
        const unsigned long long b0 = __ballot(k0), b1 = __ballot(k1);
        j_lo = b0 ? (int)__builtin_ctzll(b0) : (b1 ? 64 + (int)__builtin_ctzll(b1) : jd);
        j_lo = __builtin_amdgcn_readfirstlane(j_lo < jd ? j_lo : jd); }
    const int j_hi = (P0 + 255) / KVBLK + 1, NT = j_hi - j_lo;
    const int qlo = P0 + wid * QBLK, qm = qlo + r32 - 4 * hi;
    LAS char* V_lds = (LAS char*)ldsb; LAS char* K_lds = (LAS char*)ldsb + 2 * SHM_V;
    LAS float* wsl = (LAS float*)(ldsb + 2 * SHM_V + 2 * SHM_K) + wid * 64; LAS float* li_l = wsl; LAS float* al_l = wsl + 32;
    float m_reg = -1e30f, l_reg = 0; f32x16 o[4] = {};
    const int sr = tidv >> 4, sc = (tidv & 15) * 8, vst0 = v_st(sr, sc), vst1 = v_st(32 + sr, sc), kws = KSWZ(sr, sc * 2);
    const int vbase = (int)(uintptr_t)V_lds + v_rd_base(lane);
    const bf16_t* Kg = U + brow * LDU + C_CK + h * 128 + sc; const bf16_t* Vg = U + brow * LDU + C_CV + h * 128 + sc;
    bf16x8 qr[8];
#pragma unroll
    for (int d0 = 0; d0 < 8; ++d0) qr[d0] = *(const bf16x8*)(U + (brow + qlo + r32) * LDU + C_CQ + h * 128 + d0 * 16 + hi * 8);
    bf16x8 st_k0, st_k1, st_v0, st_v1;
#define FX_SLOAD(kb) do { st_k0 = *(const bf16x8*)(Kg + (size_t)((kb) + sr) * LDU); st_k1 = *(const bf16x8*)(Kg + (size_t)((kb) + 32 + sr) * LDU); \
                          st_v0 = *(const bf16x8*)(Vg + (size_t)((kb) + sr) * LDU); st_v1 = *(const bf16x8*)(Vg + (size_t)((kb) + 32 + sr) * LDU); } while (0)
#define FX_SWRITE(bf) do { *(LAS bf16x8*)(K_lds + (bf) * SHM_K + kws) = st_k0; *(LAS bf16x8*)(K_lds + (bf) * SHM_K + kws + 32 * 256) = st_k1; \
                           *(LAS bf16x8*)(V_lds + (bf) * SHM_V + vst0) = st_v0; *(LAS bf16x8*)(V_lds + (bf) * SHM_V + vst1) = st_v1; } while (0)
    FX_SLOAD(j_lo * KVBLK); VM_WAIT(); FX_SWRITE(0);
    __syncthreads();
    for (int t = 0; t < NT; ++t) {
        const int buf = t & 1, kb = (j_lo + t) * KVBLK;
        if (t + 1 < NT) FX_SLOAD(kb + KVBLK);
        f32x16 p0, p1;
        qkt(p0, p1, K_lds + buf * SHM_K, r32, hi, qr);
        {   const float4* bp = (const float4*)(bsc + kb);
#pragma unroll
            for (int g = 0; g < 4; ++g) { const float4 b0 = bp[2 * g + hi], b1 = bp[8 + 2 * g + hi];
                p0[4 * g + 0] += b0.x; p0[4 * g + 1] += b0.y; p0[4 * g + 2] += b0.z; p0[4 * g + 3] += b0.w;
                p1[4 * g + 0] += b1.x; p1[4 * g + 1] += b1.y; p1[4 * g + 2] += b1.z; p1[4 * g + 3] += b1.w; } }
        if (kb + KVBLK - 1 > qlo) mask_tile(p0, p1, qm - kb);
        float mn, alpha; bf16x8 pa0, pa1, pa2, pa3;
        partialSM(p0, p1, m_reg, mn, alpha);
        if (__any(alpha < 1.f)) { if (hi == 0) al_l[r32] = alpha; asm volatile("s_waitcnt lgkmcnt(0)" ::: "memory");
#pragma unroll
            for (int d_ = 0; d_ < 4; ++d_)
#pragma unroll
                for (int r = 0; r < 16; ++r) o[d_][r] *= al_l[crow(r, hi)]; }
        finishSM(p0, p1, alpha, l_reg, pa0, pa1, pa2, pa3); SBAR();
        pv_tile(o, vbase + buf * SHM_V, pa0, pa1, pa2, pa3);
        if (t + 1 < NT) { VM_WAIT(); FX_SWRITE(buf ^ 1); }
        __syncthreads();
    }
#undef FX_SLOAD
#undef FX_SWRITE
    if (hi == 0) li_l[r32] = l_reg; asm volatile("s_waitcnt lgkmcnt(0)" ::: "memory");
#pragma unroll
    for (int rh = 0; rh < 2; ++rh) {
        unsigned short gv[8][4];
#pragma unroll
        for (int r8 = 0; r8 < 8; ++r8)
#pragma unroll
            for (int d0 = 0; d0 < 4; ++d0) gv[r8][d0] = U[(brow + qlo + crow(rh * 8 + r8, hi)) * LDU + C_CG + h * 128 + d0 * 32 + r32];
#pragma unroll
        for (int r8 = 0; r8 < 8; ++r8) { const int r = rh * 8 + r8, orow = crow(r, hi); const float rl = __builtin_amdgcn_rcpf(li_l[orow]);
            const size_t grow = brow + qlo + orow;
#pragma unroll
            for (int d0 = 0; d0 < 4; ++d0) { const float y = o[d0][r] * rl * siluf_(bf2f(gv[r8][d0])); const float yn = dpp_f<0xB1>(y);
                if ((r32 & 1) == 0) *(unsigned*)(Y + grow * D_MODEL + 2 * 1024 + h * 128 + d0 * 32 + r32) = cvtpk(y, yn); } }
    }
    __syncthreads();
}
static __device__ __forceinline__ void fox_attn_phase(ArgsP ap, int l, LAS unsigned char* lds, int tidv, int vcu) {
    const bf16_t* U = (const bf16_t*)(ap->ws + WS_U); const float* BSC = (const float*)(ap->ws + WS_BSC); bf16_t* Y = (bf16_t*)(ap->ws + WS_Y);
    const float* CF = (const float*)(ap->ws + WS_CF); const float* nslot = (const float*)((const unsigned*)ap->ws + CW_FOXN) + l * 32;
    for (int pi = vcu; pi < BATCH * 8 * 16; pi += (int)gridDim.x) {
        const int bh = pi >> 4, x = pi & 15;
        const float bound = att::SCALE * sqrtf(nslot[bh * 2] * nslot[bh * 2 + 1]) * 1.001f;
        const float thr = 2.f * bound + 105.f;
        fox_attn_unit(U, BSC + (size_t)bh * SEQ, CF + (size_t)bh * SEQ, thr, Y, bh >> 3, bh & 7, 31 - x, lds, tidv);
        fox_attn_unit(U, BSC + (size_t)bh * SEQ, CF + (size_t)bh * SEQ, thr, Y, bh >> 3, bh & 7, x, lds, tidv);
    }
}

constexpr int HG_NCH = SEQ / 32;
namespace hg {
using att::bf16x8; using att::f32x16; using att::s16x4; using att::u32x4;
template <int CTRL, int ROWMASK> __device__ __forceinline__ float dppz(float v) { return __int_as_float(__builtin_amdgcn_update_dpp(0, __float_as_int(v), CTRL, ROWMASK, 0xf, true)); }
__device__ __forceinline__ float scan32(float v) {
    v += dppz<0x111, 0xf>(v); v += dppz<0x112, 0xf>(v); v += dppz<0x114, 0xf>(v); v += dppz<0x118, 0xf>(v);
    v += __int_as_float(__builtin_amdgcn_update_dpp(0, __float_as_int(v), 0x142, 0xA, 0xf, false));
    return v;
}
__device__ __forceinline__ float pick_lane(float v, int lane_lo, int hi) {
    const float a = __int_as_float(__builtin_amdgcn_readlane(__float_as_int(v), lane_lo)), b = __int_as_float(__builtin_amdgcn_readlane(__float_as_int(v), lane_lo + 32));
    return hi ? b : a;
}
__device__ __forceinline__ float cl80(float x) { return fminf(fmaxf(x, -115.4156f), 115.4156f); }
__device__ __forceinline__ bf16x8 pack8f(const float (&v)[8]) { u32x4 w = {att::cvtpk(v[0], v[1]), att::cvtpk(v[2], v[3]), att::cvtpk(v[4], v[5]), att::cvtpk(v[6], v[7])}; return *reinterpret_cast<bf16x8*>(&w); }
__device__ __forceinline__ void unpack8(const bf16x8 x, float (&v)[8]) { const u32x4 w = *reinterpret_cast<const u32x4*>(&x);
    v[0] = __uint_as_float(w.x << 16); v[1] = __uint_as_float(w.x & 0xffff0000u); v[2] = __uint_as_float(w.y << 16); v[3] = __uint_as_float(w.y & 0xffff0000u);
    v[4] = __uint_as_float(w.z << 16); v[5] = __uint_as_float(w.z & 0xffff0000u); v[6] = __uint_as_float(w.w << 16); v[7] = __uint_as_float(w.w & 0xffff0000u); }
__device__ __forceinline__ void stage_vtile(const bf16_t* g, size_t ld, LAS char* tile, int lane) {
    bf16x8 t[8];
#pragma unroll
    for (int i = 0; i < 8; ++i) t[i] = *(const bf16x8*)(g + (size_t)(i * 4 + (lane >> 4)) * ld + (lane & 15) * 8);
#pragma unroll
    for (int i = 0; i < 8; ++i) *(LAS bf16x8*)(tile + att::v_st(i * 4 + (lane >> 4), (lane & 15) * 8)) = t[i];
}
#define HG_TRRD(dst, base, off) asm volatile("ds_read_b64_tr_b16 %0, %1 offset:%2" : "=&v"(dst) : "v"(base), "i"(off) : "memory")
#define HG_FRAG2(f0, f1, base, cb) do { s16x4 l0_, h0_, l1_, h1_; HG_TRRD(l0_, base, (cb) * 512); HG_TRRD(h0_, base, (cb) * 512 + 2048); HG_TRRD(l1_, base, (cb) * 512 + 4096); HG_TRRD(h1_, base, (cb) * 512 + 6144); \
        asm volatile("s_waitcnt lgkmcnt(0)" ::: "memory"); __builtin_amdgcn_sched_barrier(0); \
        f0 = (bf16x8){l0_[0], l0_[1], l0_[2], l0_[3], h0_[0], h0_[1], h0_[2], h0_[3]}; f1 = (bf16x8){l1_[0], l1_[1], l1_[2], l1_[3], h1_[0], h1_[1], h1_[2], h1_[3]}; } while (0)

static __device__ __forceinline__ void h1_chunk(const bf16_t* U, const float* lb, bf16_t* UT, float* Dc, int cu, LAS char* wl, int lane) {
    const int r32 = lane & 31, hi = lane >> 5;
    const int bh = cu / HG_NCH, c = cu % HG_NCH, b = bh >> 3, h = bh & 7;
    const size_t row0 = (size_t)b * SEQ + c * 32;
    LAS char* Vt = wl; LAS char* Kt = wl + 8192;
    stage_vtile(U + row0 * LDU + C_DI + h * 128, LDU, Vt, lane);
    const bf16_t* fr = U + (row0 + r32) * LDU + C_DF + h * 128 + hi * 8;
#pragma unroll
    for (int d0 = 0; d0 < 8; ++d0) {
        float x[8], lbv[8], kk[8], bc[8], kt[8];
        unpack8(*(const bf16x8*)(fr + d0 * 16), x);
        { const float4 a = *(const float4*)(lb + h * 128 + d0 * 16 + hi * 8), bq = *(const float4*)(lb + h * 128 + d0 * 16 + hi * 8 + 4);
          lbv[0] = a.x; lbv[1] = a.y; lbv[2] = a.z; lbv[3] = a.w; lbv[4] = bq.x; lbv[5] = bq.y; lbv[6] = bq.z; lbv[7] = bq.w; }
#pragma unroll
        for (int j = 0; j < 8; ++j) { const float f = lbv[j] + (1.0f - lbv[j]) * sigmoidf_(x[j]); kk[j] = 1.0f - f; bc[j] = scan32(__builtin_amdgcn_logf(f)); }
        float dl[8];
#pragma unroll
        for (int j = 0; j < 8; ++j) { const float last = pick_lane(bc[j], 31, hi); kt[j] = kk[j] * __builtin_amdgcn_exp2f(last - bc[j]); dl[j] = __builtin_amdgcn_exp2f(last); }
        *(LAS bf16x8*)(Kt + att::v_st(r32, d0 * 16 + hi * 8)) = pack8f(kt);
        if (r32 == 0) { float* dp = Dc + (size_t)cu * 128 + d0 * 16 + hi * 8; *(float4*)dp = make_float4(dl[0], dl[1], dl[2], dl[3]); *(float4*)(dp + 4) = make_float4(dl[4], dl[5], dl[6], dl[7]); }
    }
    asm volatile("s_waitcnt lgkmcnt(0)" ::: "memory");
    const int vb = (int)(uintptr_t)Vt + att::v_rd_base(lane), kb = (int)(uintptr_t)Kt + att::v_rd_base(lane);
    bf16x8 kf[4][2];
#pragma unroll
    for (int dblk = 0; dblk < 4; ++dblk) HG_FRAG2(kf[dblk][0], kf[dblk][1], kb, dblk);
    bf16_t* out = UT + (size_t)cu * 16384;
#pragma unroll
    for (int e0 = 0; e0 < 4; ++e0) {
        bf16x8 v0, v1; HG_FRAG2(v0, v1, vb, e0);
#pragma unroll
        for (int dblk = 0; dblk < 4; ++dblk) {
            f32x16 acc = {};
            acc = __builtin_amdgcn_mfma_f32_32x32x16_bf16(v0, kf[dblk][0], acc, 0, 0, 0);
            acc = __builtin_amdgcn_mfma_f32_32x32x16_bf16(v1, kf[dblk][1], acc, 0, 0, 0);
#pragma unroll
            for (int r = 0; r < 16; ++r) { const float v = acc[r], vn = dpp_f<0xB1>(v);
                if ((r32 & 1) == 0) *(unsigned*)(out + (size_t)(e0 * 32 + att::crow(r, hi)) * 128 + dblk * 32 + r32) = att::cvtpk(v, vn); }
        }
    }
}
static __device__ __forceinline__ void h3_chunk(const bf16_t* U, const float* lb, const bf16_t* ST, const float* nw, bf16_t* Y, int cu, LAS char* wl, int lane) {
    const int r32 = lane & 31, hi = lane >> 5;
    const int bh = cu / HG_NCH, c = cu % HG_NCH, b = bh >> 3, h = bh & 7;
    const size_t row0 = (size_t)b * SEQ + c * 32;
    LAS char* Vt = wl;
    stage_vtile(U + row0 * LDU + C_DI + h * 128, LDU, Vt, lane);
    const bf16_t* fr = U + (row0 + r32) * LDU + C_DF + h * 128 + hi * 8; const bf16_t* qrp = U + (row0 + r32) * LDU + C_DQ + h * 128 + hi * 8;
    bf16x8 qi[8], qd[8], kd[8];
#pragma unroll
    for (int d0 = 0; d0 < 8; ++d0) {
        float x[8], q[8], lbv[8], a[8], bq_[8], cc[8];
        unpack8(*(const bf16x8*)(fr + d0 * 16), x); unpack8(*(const bf16x8*)(qrp + d0 * 16), q);
        { const float4 a4 = *(const float4*)(lb + h * 128 + d0 * 16 + hi * 8), b4 = *(const float4*)(lb + h * 128 + d0 * 16 + hi * 8 + 4);
          lbv[0] = a4.x; lbv[1] = a4.y; lbv[2] = a4.z; lbv[3] = a4.w; lbv[4] = b4.x; lbv[5] = b4.y; lbv[6] = b4.z; lbv[7] = b4.w; }
#pragma unroll
        for (int j = 0; j < 8; ++j) { const float f = lbv[j] + (1.0f - lbv[j]) * sigmoidf_(x[j]); const float bc = scan32(__builtin_amdgcn_logf(f)); const float mid = pick_lane(bc, 15, hi);
            a[j] = q[j] * __builtin_amdgcn_exp2f(bc); bq_[j] = q[j] * __builtin_amdgcn_exp2f(cl80(bc - mid)); cc[j] = (1.0f - f) * __builtin_amdgcn_exp2f(cl80(mid - bc)); }
        qi[d0] = pack8f(a); qd[d0] = pack8f(bq_); kd[d0] = pack8f(cc);
    }
    f32x16 p = {};
#pragma unroll
    for (int d0 = 0; d0 < 8; ++d0) p = __builtin_amdgcn_mfma_f32_32x32x16_bf16(kd[d0], qd[d0], p, 0, 0, 0);
#pragma unroll
    for (int r = 0; r < 16; ++r) if (att::crow(r, hi) > r32) p[r] = 0.f;
    bf16x8 pa0, pa1;
#define HG_PK4(P, B_, OUT) do { unsigned a0 = att::cvtpk(P[B_+0], P[B_+1]), a1 = att::cvtpk(P[B_+2], P[B_+3]); unsigned b0 = att::cvtpk(P[B_+4], P[B_+5]), b1 = att::cvtpk(P[B_+6], P[B_+7]); \
        auto r0 = __builtin_amdgcn_permlane32_swap(a0, b0, false, false); auto r1 = __builtin_amdgcn_permlane32_swap(a1, b1, false, false); \
        u32x4 w = {r0[0], r1[0], r0[1], r1[1]}; OUT = *reinterpret_cast<bf16x8*>(&w); } while (0)
    HG_PK4(p, 0, pa0); HG_PK4(p, 8, pa1);
#undef HG_PK4
    asm volatile("s_waitcnt lgkmcnt(0)" ::: "memory");
    const int vb = (int)(uintptr_t)Vt + att::v_rd_base(lane);
    const bf16_t* st = ST + (size_t)cu * 16384;
    f32x16 o[4];
#pragma unroll
    for (int e0 = 0; e0 < 4; ++e0) {
        bf16x8 v0, v1; HG_FRAG2(v0, v1, vb, e0);
        f32x16 acc = {};
        acc = __builtin_amdgcn_mfma_f32_32x32x16_bf16(v0, pa0, acc, 0, 0, 0);
        acc = __builtin_amdgcn_mfma_f32_32x32x16_bf16(v1, pa1, acc, 0, 0, 0);
#pragma unroll
        for (int d0 = 0; d0 < 8; ++d0) { const bf16x8 sf = *(const bf16x8*)(st + (size_t)(e0 * 32 + r32) * 128 + d0 * 16 + hi * 8);
            acc = __builtin_amdgcn_mfma_f32_32x32x16_bf16(sf, qi[d0], acc, 0, 0, 0); }
        o[e0] = acc;
    }
    float ss = 0.f;
#pragma unroll
    for (int e0 = 0; e0 < 4; ++e0)
#pragma unroll
        for (int r = 0; r < 16; ++r) ss += o[e0][r] * o[e0][r];
    { auto rr = __builtin_amdgcn_permlane32_swap(__float_as_uint(ss), __float_as_uint(ss), false, false); ss = __uint_as_float(rr[0]) + __uint_as_float(rr[1]); }
    const float rinv = rsqrtf(ss * (1.0f / 128.0f) + 1e-6f);
    const bf16_t* gp = U + (row0 + r32) * LDU + C_DG + h * 128; bf16_t* yp = Y + (row0 + r32) * D_MODEL + 3 * 1024 + h * 128;
#pragma unroll
    for (int e0 = 0; e0 < 4; ++e0)
#pragma unroll
        for (int g4 = 0; g4 < 4; ++g4) { const int e = e0 * 32 + 8 * g4 + 4 * hi;
            const uint2 gg = *(const uint2*)(gp + e); const float4 ww = *(const float4*)(nw + h * 128 + e);
            const float y0 = o[e0][4 * g4 + 0] * rinv * ww.x * siluf_(__uint_as_float(gg.x << 16)), y1 = o[e0][4 * g4 + 1] * rinv * ww.y * siluf_(__uint_as_float(gg.x & 0xffff0000u));
            const float y2 = o[e0][4 * g4 + 2] * rinv * ww.z * siluf_(__uint_as_float(gg.y << 16)), y3 = o[e0][4 * g4 + 3] * rinv * ww.w * siluf_(__uint_as_float(gg.y & 0xffff0000u));
            *(uint2*)(yp + e) = make_uint2(att::cvtpk(y0, y1), att::cvtpk(y2, y3)); }
}
#undef HG_FRAG2
#undef HG_TRRD
}

static __device__ __forceinline__ void hgrn_h1_phase(ArgsP ap, int l, LAS unsigned char* lds, int tidv, int vcu) {
    const bf16_t* U = (const bf16_t*)(ap->ws + WS_U); const float* lb = (const float*)(ap->ws + WS_LB) + l * 1024; bf16_t* UT = (bf16_t*)(ap->ws + WS_HUT); float* Dc = (float*)(ap->ws + WS_HD);
    const int lane = tidv & 63, wave = __builtin_amdgcn_readfirstlane(tidv >> 6);
    LAS char* wl = (LAS char*)lds + wave * 16384;
    for (int cu = vcu * NWAVES + wave; cu < BATCH * 8 * HG_NCH; cu += (int)gridDim.x * NWAVES) hg::h1_chunk(U, lb, UT, Dc, cu, wl, lane);
}
static __device__ __forceinline__ void hgrn_h2_phase(ArgsP ap, int tidv, int vcu) {
    const bf16_t* UT = (const bf16_t*)(ap->ws + WS_HUT); const float* Dc = (const float*)(ap->ws + WS_HD); bf16_t* ST = (bf16_t*)(ap->ws + WS_HST);
    for (int gt = vcu * (NWAVES * 64) + tidv; gt < BATCH * 8 * 128 * 64; gt += (int)gridDim.x * NWAVES * 64) {
        const int bh = gt >> 13, e = (gt >> 6) & 127, d2 = (gt & 63) * 2;
        const size_t base = (size_t)bh * HG_NCH * 16384 + (size_t)e * 128 + d2; const float* dp = Dc + (size_t)bh * HG_NCH * 128 + d2;
        float s0 = 0.f, s1 = 0.f;
        for (int c0 = 0; c0 < HG_NCH; c0 += 16) {
            unsigned uu[16]; float2 dd[16];
#pragma unroll
            for (int j = 0; j < 16; ++j) { uu[j] = *(const unsigned*)(UT + base + (size_t)(c0 + j) * 16384); dd[j] = *(const float2*)(dp + (size_t)(c0 + j) * 128); }
            unsigned so[16];
#pragma unroll
            for (int j = 0; j < 16; ++j) { so[j] = att::cvtpk(s0, s1); s0 = dd[j].x * s0 + __uint_as_float(uu[j] << 16); s1 = dd[j].y * s1 + __uint_as_float(uu[j] & 0xffff0000u); }
#pragma unroll
            for (int j = 0; j < 16; ++j) *(unsigned*)(ST + base + (size_t)(c0 + j) * 16384) = so[j];
        }
    }
}
static __device__ __forceinline__ void hgrn_h3_phase(ArgsP ap, int l, LAS unsigned char* lds, int tidv, int vcu) {
    const bf16_t* U = (const bf16_t*)(ap->ws + WS_U); const float* lb = (const float*)(ap->ws + WS_LB) + l * 1024; const bf16_t* ST = (const bf16_t*)(ap->ws + WS_HST);
    const float* nw = ap->in[6] + (size_t)l * 1024; bf16_t* Y = (bf16_t*)(ap->ws + WS_Y);
    const int lane = tidv & 63, wave = __builtin_amdgcn_readfirstlane(tidv >> 6);
    LAS char* wl = (LAS char*)lds + wave * 16384;
    for (int cu = vcu * NWAVES + wave; cu < BATCH * 8 * HG_NCH; cu += (int)gridDim.x * NWAVES) hg::h3_chunk(U, lb, ST, nw, Y, cu, wl, lane);
}

__device__ __forceinline__ void unpk8(const v4u w, float (&v)[8]) {
    v[0] = __uint_as_float(w.x << 16); v[1] = __uint_as_float(w.x & 0xffff0000u); v[2] = __uint_as_float(w.y << 16); v[3] = __uint_as_float(w.y & 0xffff0000u);
    v[4] = __uint_as_float(w.z << 16); v[5] = __uint_as_float(w.z & 0xffff0000u); v[6] = __uint_as_float(w.w << 16); v[7] = __uint_as_float(w.w & 0xffff0000u); }
static __device__ __forceinline__ void conv_phase(ArgsP ap, int l, int tidv, int vcu) {
    const bf16_t* U = (const bf16_t*)(ap->ws + WS_U); const float* cw = ap->in[4] + (size_t)l * 3 * 1024; bf16_t* Y = (bf16_t*)(ap->ws + WS_Y);
    const int wv = __builtin_amdgcn_readfirstlane(tidv >> 6), ln = tidv & 63, c0 = ln * 16;
    float mq0 = 0.f, mk0 = 0.f, mq1 = 0.f, mk1 = 0.f;
    for (int row = vcu * NWAVES + wv; row < MTOK; row += (int)gridDim.x * NWAVES) {
        const int t = row % SEQ; const bf16_t* u0 = U + (size_t)row * LDU;
        v4u bc[3][2], bx[3][2];
#pragma unroll
        for (int j = 0; j < 3; ++j) { const int back = (t - 2 + j >= 0) ? 2 - j : 0; const bf16_t* ur = u0 - (size_t)back * LDU;
#pragma unroll
            for (int hh = 0; hh < 2; ++hh) { bc[j][hh] = *(const v4u*)(ur + C_BC + c0 + 8 * hh); bx[j][hh] = *(const v4u*)(ur + C_BX + c0 + 8 * hh); } }
        v4u bb[2], bg[2], qv[2], kv[2];
#pragma unroll
        for (int hh = 0; hh < 2; ++hh) { bb[hh] = *(const v4u*)(u0 + C_BB + c0 + 8 * hh); bg[hh] = *(const v4u*)(u0 + C_BG + c0 + 8 * hh);
            qv[hh] = *(const v4u*)(u0 + C_CQ + c0 + 8 * hh); kv[hh] = *(const v4u*)(u0 + C_CK + c0 + 8 * hh); }
        float q2 = 0.f, k2 = 0.f;
#pragma unroll
        for (int hh = 0; hh < 2; ++hh) {
            float acc[8] = {0.f, 0.f, 0.f, 0.f, 0.f, 0.f, 0.f, 0.f};
#pragma unroll
            for (int j = 0; j < 3; ++j) { float a[8], x[8]; unpk8(bc[j][hh], a); unpk8(bx[j][hh], x);
                const float4 w0 = *(const float4*)(cw + j * 1024 + c0 + 8 * hh), w1 = *(const float4*)(cw + j * 1024 + c0 + 8 * hh + 4);
                const float wz = (t - 2 + j >= 0) ? 1.f : 0.f;
                acc[0] += wz * w0.x * (a[0] * x[0]); acc[1] += wz * w0.y * (a[1] * x[1]); acc[2] += wz * w0.z * (a[2] * x[2]); acc[3] += wz * w0.w * (a[3] * x[3]);
                acc[4] += wz * w1.x * (a[4] * x[4]); acc[5] += wz * w1.y * (a[5] * x[5]); acc[6] += wz * w1.z * (a[6] * x[6]); acc[7] += wz * w1.w * (a[7] * x[7]); }
            float b8[8], g8[8], y[8]; unpk8(bb[hh], b8); unpk8(bg[hh], g8);
#pragma unroll
            for (int i = 0; i < 8; ++i) y[i] = b8[i] * acc[i] * siluf_(g8[i]);
            v4u o; o.x = pg8::cvt_pk_bf16(y[0], y[1]); o.y = pg8::cvt_pk_bf16(y[2], y[3]); o.z = pg8::cvt_pk_bf16(y[4], y[5]); o.w = pg8::cvt_pk_bf16(y[6], y[7]);
            *(v4u*)(Y + (size_t)row * D_MODEL + 1024 + c0 + 8 * hh) = o;
            float qq[8], kk[8]; unpk8(qv[hh], qq); unpk8(kv[hh], kk);
#pragma unroll
            for (int i = 0; i < 8; ++i) { q2 += qq[i] * qq[i]; k2 += kk[i] * kk[i]; }
        }
        q2 += dpp_f<0xB1>(q2); k2 += dpp_f<0xB1>(k2); q2 += dpp_f<0x4E>(q2); k2 += dpp_f<0x4E>(k2); q2 += dpp_f<0x141>(q2); k2 += dpp_f<0x141>(k2);
        if (row < SEQ) { mq0 = fmaxf(mq0, q2); mk0 = fmaxf(mk0, k2); } else { mq1 = fmaxf(mq1, q2); mk1 = fmaxf(mk1, k2); }
    }
    if ((ln & 7) == 0) { unsigned* slot = (unsigned*)ap->ws + CW_FOXN + ((l * 2 + 0) * 8 + (ln >> 3)) * 2;
        atomicMax(slot, __float_as_uint(mq0)); atomicMax(slot + 1, __float_as_uint(mk0)); atomicMax(slot + 16, __float_as_uint(mq1)); atomicMax(slot + 17, __float_as_uint(mk1)); }
}
static __device__ __forceinline__ void dsa_score_unit(const bf16_t* U, const float* UM, const bf16_t* IKB, unsigned short* score, int b, int qblk, int tidv) {
    using att::bf16x8; using att::f32x16;
    const int wave = __builtin_amdgcn_readfirstlane(tidv >> 6), lane = tidv & 63, r = lane & 31, hi = lane >> 5;
    const size_t brow = (size_t)b * SEQ; const int t0 = qblk * 32 + wave * 4;
    const int qq = (r >> 2) & 1, head = (r & 3) + 4 * (r >> 3);
    bf16x8 A[2][4]; float w[2][16];
#pragma unroll
    for (int s = 0; s < 2; ++s) {
        const bf16_t* qp = U + (brow + t0 + 2 * s + qq) * LDU + C_AIQ + head * 64 + 8 * hi;
#pragma unroll
        for (int ks = 0; ks < 4; ++ks) A[s][ks] = *(const bf16x8*)(qp + ks * 16);
        const float* wp = UM + (brow + t0 + 2 * s + hi) * LDM + MC_IW;
#pragma unroll
        for (int g = 0; g < 4; ++g) { const float4 x = *(const float4*)(wp + 4 * g); w[s][4 * g] = x.x * (1.0f / 32.0f); w[s][4 * g + 1] = x.y * (1.0f / 32.0f); w[s][4 * g + 2] = x.z * (1.0f / 32.0f); w[s][4 * g + 3] = x.w * (1.0f / 32.0f); }
    }
    const int nblk = (qblk + 2) >> 1;
    const bf16_t* kp = IKB + (brow >> 5) * 2048 + (size_t)lane * 8;
    unsigned* sp0 = (unsigned*)(score + (brow + t0 + hi) * SCPH) + r; unsigned* sp1 = (unsigned*)(score + (brow + t0 + 2 + hi) * SCPH) + r;
    bf16x8 B[2][4], Bn[2][4];
#pragma unroll
    for (int g = 0; g < 2; ++g)
#pragma unroll
        for (int ks = 0; ks < 4; ++ks) B[g][ks] = *(const bf16x8*)(kp + (size_t)g * 2048 + ks * 512);
    for (int tb = 0; tb < nblk; ++tb) {
        const int tn = tb + 1 < nblk ? tb + 1 : tb;
#pragma unroll
        for (int g = 0; g < 2; ++g)
#pragma unroll
            for (int ks = 0; ks < 4; ++ks) Bn[g][ks] = *(const bf16x8*)(kp + (size_t)(2 * tn + g) * 2048 + ks * 512);
        f32x16 c[2][2] = {};
#pragma unroll
        for (int ks = 0; ks < 4; ++ks)
#pragma unroll
            for (int g = 0; g < 2; ++g) { c[g][0] = __builtin_amdgcn_mfma_f32_32x32x16_bf16(A[0][ks], B[g][ks], c[g][0], 0, 0, 0); c[g][1] = __builtin_amdgcn_mfma_f32_32x32x16_bf16(A[1][ks], B[g][ks], c[g][1], 0, 0, 0); }
        float sc[2][2];
#pragma unroll
        for (int g = 0; g < 2; ++g) {
            float s0a = 0.f, s0b = 0.f, s1a = 0.f, s1b = 0.f;
#pragma unroll
            for (int i = 0; i < 16; i += 2) {
                s0a += w[0][i] * __builtin_amdgcn_fmed3f(c[g][0][i], 0.f, 3.0e38f); s0b += w[0][i + 1] * __builtin_amdgcn_fmed3f(c[g][0][i + 1], 0.f, 3.0e38f);
                s1a += w[1][i] * __builtin_amdgcn_fmed3f(c[g][1][i], 0.f, 3.0e38f); s1b += w[1][i + 1] * __builtin_amdgcn_fmed3f(c[g][1][i + 1], 0.f, 3.0e38f); }
            sc[g][0] = s0a + s0b; sc[g][1] = s1a + s1b;
        }
        sp0[tb * 32] = __builtin_bit_cast(unsigned, __builtin_amdgcn_cvt_pkrtz(sc[0][0], sc[1][0]));
        sp1[tb * 32] = __builtin_bit_cast(unsigned, __builtin_amdgcn_cvt_pkrtz(sc[0][1], sc[1][1]));
#pragma unroll
        for (int g = 0; g < 2; ++g)
#pragma unroll
            for (int ks = 0; ks < 4; ++ks) B[g][ks] = Bn[g][ks];
    }
}
static __device__ __forceinline__ void dsa_score_phase(ArgsP ap, int tidv, int vcu) {
    const bf16_t* U = (const bf16_t*)(ap->ws + WS_U); const float* UM = (const float*)(ap->ws + WS_UM); const bf16_t* IKB = (const bf16_t*)(ap->ws + WS_IKB); unsigned short* score = (unsigned short*)(ap->ws + WS_SCORE);
    for (int pi = vcu; pi < BATCH * 128; pi += (int)gridDim.x) {
        const int b = pi >> 7, x = pi & 127;
        dsa_score_unit(U, UM, IKB, score, b, 255 - x, tidv);
        dsa_score_unit(U, UM, IKB, score, b, x, tidv);
    }
}
template <int NR> static __device__ __forceinline__ void dsa_topk_row_n(const float* sr, int* out, int n, int lane) {
    unsigned key[NR];
#pragma unroll
    for (int i = 0; i < NR; ++i) { const int s = i * 64 + lane;
        const unsigned bts = __float_as_uint(sr[s < n ? s : n - 1]); const unsigned k = bts ^ ((bts >> 31) ? 0xFFFFFFFFu : 0x80000000u);
        key[i] = s < n ? k : 0u; }
    unsigned T = 0u; int cT = n;
    for (int bit = 31; bit >= 0 && cT != 256; --bit) {
        const unsigned cand = T | (1u << bit); int c = 0;
#pragma unroll
        for (int i = 0; i < NR; ++i) c += (key[i] >= cand) ? 1 : 0;
        c = wave_sum_i(c);
        if (c >= 256) { T = cand; cT = c; }
    }
    int need = 0; unsigned Tg = (T ? T : 1u) - 1u;
    if (cT != 256) {
        int cgt = 0;
#pragma unroll
        for (int i = 0; i < NR; ++i) cgt += (key[i] > T) ? 1 : 0;
        cgt = wave_sum_i(cgt); need = 256 - cgt; Tg = T;
    }
    int base = 0;
    const unsigned long long lmask = (lane == 0) ? 0ull : (~0ull >> (64 - lane));
#pragma unroll
    for (int i = 0; i < NR; ++i) {
        const bool gt = key[i] > Tg, eq = (need > 0) && key[i] == T;
        const unsigned long long beq = __ballot(eq);
        const int eqrank = __popcll(beq & lmask);
        const bool sel = gt || (eq && eqrank < need);
        const unsigned long long bsel = __ballot(sel);
        if (sel) out[base + __popcll(bsel & lmask)] = i * 64 + lane;
        base += __popcll(bsel);
        const int neq = __popcll(beq); need -= neq < need ? neq : need;
    }
}
__device__ __forceinline__ unsigned wave_max_u(unsigned v) {
    v = max(v, (unsigned)dpp_i<0xB1>((int)v)); v = max(v, (unsigned)dpp_i<0x4E>((int)v)); v = max(v, (unsigned)dpp_i<0x141>((int)v)); v = max(v, (unsigned)dpp_i<0x140>((int)v));
    return max(max((unsigned)__builtin_amdgcn_readlane((int)v, 0), (unsigned)__builtin_amdgcn_readlane((int)v, 16)), max((unsigned)__builtin_amdgcn_readlane((int)v, 32), (unsigned)__builtin_amdgcn_readlane((int)v, 48)));
}
template <int NC> static __device__ __forceinline__ void topk_final(LAS const unsigned* cand, int c0, unsigned Tlo, int* out, int lane) {
    unsigned ck[NC], ci[NC];
#pragma unroll
    for (int j = 0; j < NC; ++j) { const int p = j * 64 + lane; ck[j] = p < c0 ? cand[p] : 0u; ci[j] = cand[1024 + p]; }
    unsigned mx = 0u;
#pragma unroll
    for (int j = 0; j < NC; ++j) mx = max(mx, ck[j]);
    mx = wave_max_u(mx);
    const unsigned diff = mx ^ Tlo; const int hb = diff ? 31 - __builtin_clz(diff) : -1;
    unsigned T = hb >= 0 ? (Tlo & ~((2u << hb) - 1u)) : Tlo; int cT = c0;
    for (int bit = hb; bit >= 16 && cT != 256; --bit) {
        const unsigned cnd = T | (1u << bit); int c = 0;
#pragma unroll
        for (int j = 0; j < NC; ++j) c += (ck[j] >= cnd) ? 1 : 0;
        c = wave_sum_i(c);
        if (c >= 256) { T = cnd; cT = c; }
    }
    int need = 0; unsigned Tg = (T ? T : 1u) - 1u;
    if (cT != 256) {
        int cgt = 0;
#pragma unroll
        for (int j = 0; j < NC; ++j) cgt += (ck[j] > T) ? 1 : 0;
        cgt = wave_sum_i(cgt); need = 256 - cgt; Tg = T;
    }
    int base = 0;
    const unsigned long long lmask = (lane == 0) ? 0ull : (~0ull >> (64 - lane));
#pragma unroll
    for (int j = 0; j < NC; ++j) {
        const bool gt = ck[j] > Tg, eq = (need > 0) && ck[j] == T;
        const unsigned long long beq = __ballot(eq);
        const int eqrank = __popcll(beq & lmask);
        const bool sel = gt || (eq && eqrank < need);
        const unsigned long long bsel = __ballot(sel);
        if (sel) out[base + __popcll(bsel & lmask)] = (int)ci[j];
        base += __popcll(bsel);
        const int neq = __popcll(beq); need -= neq < need ? neq : need;
    }
}
template <int NR> static __device__ __forceinline__ bool dsa_topk_row_fast(const unsigned short* sr, int* out, int n, int lane, LAS unsigned* cand) {
    constexpr int NG = NR / 8;
    unsigned key[NR];
    int lane8 = 8 * lane; asm volatile("" : "+v"(lane8));
#pragma unroll
    for (int j = 0; j < NG; ++j) { const v4u v = *(const v4u*)((const char*)sr + (size_t)j * 1024 + (unsigned)(lane8 * 2)); const int nj = n - 512 * j;
        const unsigned wv[4] = {v.x, v.y, v.z, v.w};
#pragma unroll
        for (int q = 0; q < 4; ++q) {
            typedef short s16x2_t __attribute__((ext_vector_type(2)));
            const unsigned sg = __builtin_bit_cast(unsigned, __builtin_bit_cast(s16x2_t, wv[q]) >> (s16x2_t){15, 15});
            const unsigned tq = wv[q] ^ (sg | 0x80008000u);
            key[8 * j + 2 * q] = tq << 16; key[8 * j + 2 * q + 1] = tq & 0xffff0000u; }
        if (nj < 512) {
#pragma unroll
            for (int c = 0; c < 8; ++c) key[8 * j + c] = lane8 < nj - c ? key[8 * j + c] : 0u; } }
    constexpr int SG = NG / 4 > 0 ? NG / 4 : 1;
    const unsigned sk[4] = {key[0], key[(8 * SG) % NR], key[(16 * SG) % NR], key[(24 * SG) % NR]};
    int ns = 0;
#pragma unroll
    for (int q = 0; q < 4; ++q) { const int v = (n - 512 * ((q * SG) % NG) + 7) >> 3; ns += v < 0 ? 0 : (v > 64 ? 64 : v); }
    const float ctf = 256.f + 2.f * sqrtf(256.f * (float)n / (float)ns);
    int m = (int)(ctf * (float)ns / (float)n) + 1; m = m > ns ? ns : m;
    unsigned T0 = 1u << 16; int c0 = n;
    for (int tries = 0; tries < 4; ++tries) {
        unsigned Ts = 0u; int cs = 256;
        for (int bit = 31; bit >= 18 && cs != m; --bit) {
            const unsigned cnd = Ts | (1u << bit);
            int c = ((sk[0] >= cnd) ? 1 : 0) + ((sk[1] >= cnd) ? 1 : 0) + ((sk[2] >= cnd) ? 1 : 0) + ((sk[3] >= cnd) ? 1 : 0);
            c = wave_sum_i(c);
            if (c >= m) { Ts = cnd; cs = c; }
        }
        if (Ts == 0u) Ts = 1u << 16;
        int c = 0;
#pragma unroll
        for (int i = 0; i < NR; ++i) c += (key[i] >= Ts) ? 1 : 0;
        c = wave_sum_i(c);
        if (c >= 256) { T0 = Ts; c0 = c; break; }
        if (m >= ns) break;
        m = 2 * m + 8; m = m > ns ? ns : m;
    }
    bool mass_ties = false; unsigned Tt = 0u; int cgt_t = 0;
    if (c0 > 1024) {
        unsigned T = 0u; int cT = n;
        for (int bit = 31; bit >= 16 && cT != 256; --bit) {
            const unsigned cnd = T | (1u << bit); int c = 0;
#pragma unroll
            for (int i = 0; i < NR; ++i) c += (key[i] >= cnd) ? 1 : 0;
            c = wave_sum_i(c);
            if (c >= 256) { T = cnd; cT = c; }
        }
        T0 = T; c0 = cT;
        if (cT > 1024) {
            int c = 0;
#pragma unroll
            for (int i = 0; i < NR; ++i) c += (key[i] > T) ? 1 : 0;
            mass_ties = true; Tt = T; cgt_t = wave_sum_i(c); }
    }
    if (mass_ties) {
        int base = 0, ebase = cgt_t;
#pragma unroll
        for (int j = 0; j < NG; ++j) {
            bool e[8]; unsigned long long qe[8]; int erank = 0;
#pragma unroll
            for (int c = 0; c < 8; ++c) { const unsigned k = key[8 * j + c]; const bool g = k > Tt; e[c] = k == Tt && k != 0u;
                const unsigned long long qg = __ballot(g); qe[c] = __ballot(e[c]);
                if (g) out[base + (int)__builtin_amdgcn_mbcnt_hi((unsigned)(qg >> 32), __builtin_amdgcn_mbcnt_lo((unsigned)qg, 0u))] = lane8 + (512 * j + c);
                base += __popcll(qg);
                erank += (int)__builtin_amdgcn_mbcnt_hi((unsigned)(qe[c] >> 32), __builtin_amdgcn_mbcnt_lo((unsigned)qe[c], 0u)); }
            int pe = ebase + erank;
#pragma unroll
            for (int c = 0; c < 8; ++c) { if (e[c] && pe < 256) out[pe] = lane8 + (512 * j + c); pe += e[c] ? 1 : 0; ebase += __popcll(qe[c]); }
        }
        return true;
    }
    int base = 0;
#pragma unroll
    for (int j = 0; j < NG; ++j) {
        bool p[8]; int cnt = 0;
#pragma unroll
        for (int c = 0; c < 8; ++c) { p[c] = key[8 * j + c] >= T0; cnt += p[c] ? 1 : 0; }
        int inc = cnt;
        inc += __builtin_amdgcn_update_dpp(0, inc, 0x111, 0xf, 0xf, true); inc += __builtin_amdgcn_update_dpp(0, inc, 0x112, 0xf, 0xf, true);
        inc += __builtin_amdgcn_update_dpp(0, inc, 0x114, 0xf, 0xf, true); inc += __builtin_amdgcn_update_dpp(0, inc, 0x118, 0xf, 0xf, true);
        inc += __builtin_amdgcn_update_dpp(0, inc, 0x142, 0xA, 0xf, false);
        inc += __builtin_amdgcn_update_dpp(0, inc, 0x143, 0xC, 0xf, false);
        int pos = base + inc - cnt; base += __builtin_amdgcn_readlane(inc, 63);
#pragma unroll
        for (int c = 0; c < 8; ++c) { if (p[c]) { cand[pos] = key[8 * j + c]; cand[1024 + pos] = (unsigned)(lane8 + (512 * j + c)); } pos += p[c] ? 1 : 0; }
    }
    asm volatile("s_waitcnt lgkmcnt(0)" ::: "memory");
    if (c0 <= 512) topk_final<8>(cand, c0, T0, out, lane); else topk_final<16>(cand, c0, T0, out, lane);
    return true;
}
static __device__ __forceinline__ void dsa_topk_row(const unsigned short* score, int* idx, int row, int lane, LAS unsigned* cand) {
    asm volatile("" : "+v"(lane));
    const int t = row % SEQ, n = t + 1;
    int* out = idx + (size_t)row * 256;
    if (n <= 256) {
#pragma unroll
        for (int j = 0; j < 4; ++j) { const int p = j * 64 + lane; out[p] = p < n ? p : -1; }
        return;
    }
    const unsigned short* sr = score + (size_t)row * SCPH;
    if (n <= 1024) (void)dsa_topk_row_fast<16>(sr, out, n, lane, cand);
    else if (n <= 1536) (void)dsa_topk_row_fast<24>(sr, out, n, lane, cand);
    else if (n <= 2048) (void)dsa_topk_row_fast<32>(sr, out, n, lane, cand);
    else if (n <= 3072) (void)dsa_topk_row_fast<48>(sr, out, n, lane, cand);
    else if (n <= 4096) (void)dsa_topk_row_fast<64>(sr, out, n, lane, cand);
    else if (n <= 5120) (void)dsa_topk_row_fast<80>(sr, out, n, lane, cand);
    else if (n <= 6144) (void)dsa_topk_row_fast<96>(sr, out, n, lane, cand);
    else if (n <= 7168) (void)dsa_topk_row_fast<112>(sr, out, n, lane, cand);
    else (void)dsa_topk_row_fast<128>(sr, out, n, lane, cand);
}
static __device__ __forceinline__ void dsa_topk_phase(ArgsP ap, LAS unsigned char* lds, int tidv, int vcu) {
    const unsigned short* score = (const unsigned short*)(ap->ws + WS_SCORE); int* idx = (int*)(ap->ws + WS_IDX);
    const int lane = tidv & 63, wave = __builtin_amdgcn_readfirstlane(tidv >> 6);
    LAS unsigned* cand = (LAS unsigned*)(lds + wave * 8192);
    const int g = vcu * NWAVES + wave, NGW = (int)gridDim.x * NWAVES;
    for (int k = 0; k * NGW < MTOK; ++k) { const int row = k * NGW + ((k & 1) ? NGW - 1 - g : g); if (row < MTOK) dsa_topk_row(score, idx, row, lane, cand); }
}
static __device__ __forceinline__ void dsa_attn_simple_phase(ArgsP ap, LAS unsigned char* lds, int tidv, int vcu) {
    const bf16_t* U = (const bf16_t*)(ap->ws + WS_U); const int* idx = (const int*)(ap->ws + WS_IDX); bf16_t* Y = (bf16_t*)(ap->ws + WS_Y);
    const int h = __builtin_amdgcn_readfirstlane(tidv >> 6), lane = tidv & 63;
    LAS int* sidx = (LAS int*)lds; LAS float* qs = (LAS float*)(lds + 1024) + h * 128; LAS float* ps = (LAS float*)(lds + 1024 + 4096) + h * 256;
    for (int row = vcu; row < MTOK; row += (int)gridDim.x) {
        const int b = row / SEQ;
        __syncthreads();
        if (tidv < 256) sidx[tidv] = idx[(size_t)row * 256 + tidv];
        const bf16_t* ur = U + (size_t)row * LDU;
        qs[lane] = bf2f(ur[C_AQ + h * 128 + lane]); qs[lane + 64] = bf2f(ur[C_AQ + h * 128 + lane + 64]);
        __syncthreads();
        float lg[4]; float mx = -1e30f;
#pragma unroll
        for (int c = 0; c < 4; ++c) { const int id = sidx[c * 64 + lane]; float d = -INFINITY;
            if (id >= 0) { const uint4* kr = (const uint4*)(U + ((size_t)b * SEQ + id) * LDU + C_AK); d = 0.f;
#pragma unroll
                for (int j = 0; j < 16; ++j) { const uint4 kk = kr[j]; const LAS float* q = qs + j * 8;
                    d += q[0] * __uint_as_float(kk.x << 16) + q[1] * __uint_as_float(kk.x & 0xffff0000u) + q[2] * __uint_as_float(kk.y << 16) + q[3] * __uint_as_float(kk.y & 0xffff0000u)
                       + q[4] * __uint_as_float(kk.z << 16) + q[5] * __uint_as_float(kk.z & 0xffff0000u) + q[6] * __uint_as_float(kk.w << 16) + q[7] * __uint_as_float(kk.w & 0xffff0000u); }
                d *= 0.08838834764831845f; }
            lg[c] = d; mx = fmaxf(mx, d); }
        mx = wave_max(mx);
        float sum = 0.f;
#pragma unroll
        for (int c = 0; c < 4; ++c) { lg[c] = __expf(lg[c] - mx); sum += lg[c]; }
        sum = wave_sum(sum); const float inv = 1.0f / sum;
#pragma unroll
        for (int c = 0; c < 4; ++c) ps[c * 64 + lane] = lg[c] * inv;
        LDS_WAIT();
        float o0 = 0.f, o1 = 0.f;
        for (int j = 0; j < 256; ++j) { const int id = sidx[j]; if (id < 0) continue; const float p = ps[j];
            const unsigned vv = *(const unsigned*)(U + ((size_t)b * SEQ + id) * LDU + C_AV + 2 * lane);
            o0 += p * __uint_as_float(vv << 16); o1 += p * __uint_as_float(vv & 0xffff0000u); }
        const unsigned gg = *(const unsigned*)(ur + C_AG + h * 128 + 2 * lane);
        o0 *= siluf_(__uint_as_float(gg << 16)); o1 *= siluf_(__uint_as_float(gg & 0xffff0000u));
        *(unsigned*)(Y + (size_t)row * D_MODEL + h * 128 + 2 * lane) = pk2(o0, o1);
    }
    __syncthreads();
}

constexpr int DSA_WAVE_LDS = 16384 + 1024 + 256;
static __device__ __forceinline__ void dsa_attn_row(const bf16_t* U, const int* idx, bf16_t* Y, int row, LAS char* wl, int lane) {
    using namespace att;
    const int r32 = lane & 31, hi = lane >> 5;
    const int b = row / SEQ, t = row % SEQ; const size_t brow = (size_t)b * SEQ;
    const int nvalid = (t + 1) < 256 ? (t + 1) : 256;
    LAS char* Kt = wl; LAS char* Vt = wl + 8192; LAS int* sidx = (LAS int*)(wl + 16384); LAS float* li_l = (LAS float*)(wl + 16384 + 1024); LAS float* al_l = li_l + 32;
    { const v4u v = *(const v4u*)(idx + (size_t)row * 256 + lane * 4); *(LAS v4u*)(sidx + lane * 4) = v; }
    bf16x8 qr[8];
    const bf16_t* qp = U + (size_t)row * LDU + C_AQ + (r32 & 7) * 128 + hi * 8;
#pragma unroll
    for (int d0 = 0; d0 < 8; ++d0) { bf16x8 q = *(const bf16x8*)(qp + d0 * 16); if (r32 >= 8) q = (bf16x8){0, 0, 0, 0, 0, 0, 0, 0}; qr[d0] = q; }
    asm volatile("s_waitcnt lgkmcnt(0)" ::: "memory");
    float m_reg = -1e30f, l_reg = 0; f32x16 o[4] = {};
    const int vbase = (int)(uintptr_t)Vt + v_rd_base(lane);
    const int gr = lane >> 4, gc = lane & 15;
    const bf16_t* Kg = U + brow * LDU + C_AK + gc * 8; const bf16_t* Vg = U + brow * LDU + C_AV + gc * 8;
    bf16x8 kv[8], vv[8];
#define DA_GATHER(tt_) do { _Pragma("unroll") for (int i = 0; i < 8; ++i) { int iv = sidx[(tt_) * 32 + i * 4 + gr]; iv = iv < 0 ? 0 : iv; \
            kv[i] = *(const bf16x8*)(Kg + (size_t)iv * LDU); vv[i] = *(const bf16x8*)(Vg + (size_t)iv * LDU); } } while (0)
    DA_GATHER(0);
    for (int tt = 0; tt < 8; ++tt) {
#pragma unroll
        for (int i = 0; i < 8; ++i) { const int kk = i * 4 + gr; *(LAS bf16x8*)(Kt + KSWZ(kk, gc * 16)) = kv[i]; *(LAS bf16x8*)(Vt + v_st(kk, gc * 8)) = vv[i]; }
        if (tt + 1 < 8) DA_GATHER(tt + 1);
        asm volatile("s_waitcnt lgkmcnt(0)" ::: "memory");
        f32x16 p = {};
        {   const LAS char* kb4[4];
#pragma unroll
            for (int dd = 0; dd < 4; ++dd) kb4[dd] = Kt + KSWZ(r32, (dd * 16 + hi * 8) * 2);
#pragma unroll
            for (int d0 = 0; d0 < 8; ++d0) { const bf16x8 kf = *reinterpret_cast<const LAS bf16x8*>(kb4[d0 & 3] + (d0 >> 2) * 128);
                p = __builtin_amdgcn_mfma_f32_32x32x16_bf16(kf, qr[d0], p, 0, 0, 0); } }
        if (tt * 32 + 32 > nvalid) {
            const float NEG = -__builtin_inff();
#pragma unroll
            for (int r = 0; r < 16; ++r) if (tt * 32 + crow(r, hi) >= nvalid) p[r] = NEG; }
        float pmax = p[0];
#pragma unroll
        for (int r = 1; r < 16; ++r) pmax = fmaxf(pmax, p[r]);
        { auto rr = __builtin_amdgcn_permlane32_swap(__float_as_uint(pmax), __float_as_uint(pmax), false, false); pmax = fmaxf(__uint_as_float(rr[0]), __uint_as_float(rr[1])); }
        constexpr float C2 = 1.4426950408889634f * SCALE;
        float mn, alpha;
        if (__builtin_expect(__all((pmax - m_reg) * SCALE <= THR), 1)) { mn = m_reg; alpha = 1.f; }
        else { mn = fmaxf(m_reg, pmax); alpha = __builtin_amdgcn_exp2f((m_reg - mn) * C2); m_reg = mn; }
        const float mnL = -mn * C2; float ps = 0.f;
#pragma unroll
        for (int r = 0; r < 16; ++r) { p[r] = __builtin_amdgcn_exp2f(fmaf(p[r], C2, mnL)); ps += p[r]; }
        { auto rr = __builtin_amdgcn_permlane32_swap(__float_as_uint(ps), __float_as_uint(ps), false, false); ps = __uint_as_float(rr[0]) + __uint_as_float(rr[1]); }
        l_reg = l_reg * alpha + ps;
        if (__any(alpha < 1.f)) { if (hi == 0) al_l[r32] = alpha; asm volatile("s_waitcnt lgkmcnt(0)" ::: "memory");
#pragma unroll
            for (int d_ = 0; d_ < 4; ++d_)
#pragma unroll
                for (int r = 0; r < 4; ++r) o[d_][r] *= al_l[crow(r, hi)]; }
        bf16x8 pa0, pa1;
#define DA_PK4(P, B_, OUT) do { unsigned a0 = cvtpk(P[B_+0], P[B_+1]), a1 = cvtpk(P[B_+2], P[B_+3]); unsigned b0 = cvtpk(P[B_+4], P[B_+5]), b1 = cvtpk(P[B_+6], P[B_+7]); \
        auto r0 = __builtin_amdgcn_permlane32_swap(a0, b0, false, false); auto r1 = __builtin_amdgcn_permlane32_swap(a1, b1, false, false); \
        u32x4 w = {r0[0], r1[0], r0[1], r1[1]}; OUT = *reinterpret_cast<bf16x8*>(&w); } while (0)
        DA_PK4(p, 0, pa0); DA_PK4(p, 8, pa1);
#undef DA_PK4
        SBAR();
#define DA_TRRD(dst, off) asm volatile("ds_read_b64_tr_b16 %0, %1 offset:%2" : "=&v"(dst) : "v"(vbase), "i"(off) : "memory")
#define DA_PV(d0) do { s16x4 l0, h0, l1, h1; DA_TRRD(l0, (d0) * 512); DA_TRRD(h0, (d0) * 512 + 2048); DA_TRRD(l1, (d0) * 512 + 4096); DA_TRRD(h1, (d0) * 512 + 6144); \
        asm volatile("s_waitcnt lgkmcnt(0)" ::: "memory"); SBAR(); \
        o[d0] = __builtin_amdgcn_mfma_f32_32x32x16_bf16(pa0, (bf16x8){l0[0], l0[1], l0[2], l0[3], h0[0], h0[1], h0[2], h0[3]}, o[d0], 0, 0, 0); \
        o[d0] = __builtin_amdgcn_mfma_f32_32x32x16_bf16(pa1, (bf16x8){l1[0], l1[1], l1[2], l1[3], h1[0], h1[1], h1[2], h1[3]}, o[d0], 0, 0, 0); } while (0)
        DA_PV(0); DA_PV(1); DA_PV(2); DA_PV(3);
#undef DA_PV
#undef DA_TRRD
    }
#undef DA_GATHER
    if (hi == 0) li_l[r32] = l_reg; asm volatile("s_waitcnt lgkmcnt(0)" ::: "memory");
    const bf16_t* gp = U + (size_t)row * LDU + C_AG; bf16_t* yp = Y + (size_t)row * D_MODEL;
    unsigned short gv[4][4];
#pragma unroll
    for (int r = 0; r < 4; ++r)
#pragma unroll
        for (int d0 = 0; d0 < 4; ++d0) gv[r][d0] = gp[(r + 4 * hi) * 128 + d0 * 32 + r32];
#pragma unroll
    for (int r = 0; r < 4; ++r) { const int head = r + 4 * hi; const float rl = __builtin_amdgcn_rcpf(li_l[head]);
#pragma unroll
        for (int d0 = 0; d0 < 4; ++d0) { const float y = o[d0][r] * rl * siluf_(bf2f(gv[r][d0])); const float yn = dpp_f<0xB1>(y);
            if ((r32 & 1) == 0) *(unsigned*)(yp + head * 128 + d0 * 32 + r32) = cvtpk(y, yn); } }
}
static __device__ __forceinline__ void dsa_attn_phase(ArgsP ap, LAS unsigned char* lds, int tidv, int vcu) {
    const bf16_t* U = (const bf16_t*)(ap->ws + WS_U); const int* idx = (const int*)(ap->ws + WS_IDX); bf16_t* Y = (bf16_t*)(ap->ws + WS_Y);
    const int lane = tidv & 63, wave = __builtin_amdgcn_readfirstlane(tidv >> 6);
    LAS char* wl = (LAS char*)lds + wave * DSA_WAVE_LDS;
    for (int row = vcu * NWAVES + wave; row < MTOK; row += (int)gridDim.x * NWAVES) dsa_attn_row(U, idx, Y, row, wl, lane);
}

static __device__ __forceinline__ void ph_inproj(ArgsP ap, int l, LAS unsigned char* lds, int tidv) {
    unsigned char* ws = ap->ws;
    pg8::Gemm g{}; g.A = (const bf16_t*)(ws + WS_XB); g.Bt = (const bf16_t*)(ws + WS_WIN) + (size_t)l * NU * D_MODEL; g.M = MTOK; g.N = NU; g.K = D_MODEL; g.lda = D_MODEL; g.ldb = D_MODEL;
    pg8::EpiInProj E{}; E.U = (bf16_t*)(ws + WS_U); E.UM = (float*)(ws + WS_UM); E.IKB = (bf16_t*)(ws + WS_IKB); E.T128 = (const float*)(ws + WS_ROPE128); E.T64 = (const float*)(ws + WS_ROPE64); E.RS = (const float*)(ws + WS_RS);
    pg8::SchedPlain S; S.init(MTOK / 256, NU / 256, (int)gridDim.x, (int)blockIdx.x);
    pg8::gemm_phase<pg8::EpiInProj, pg8::SchedPlain>(lds + RING_OFF, g, S, E, tidv);
}
static __device__ __forceinline__ void ph_gates(ArgsP ap, int l, LAS unsigned char* lds, int tidv) {
    unsigned char* ws = ap->ws;
    pg8::Gemm g{}; g.A = (const bf16_t*)(ws + WS_XB); g.Bt = (const bf16_t*)(ws + WS_WM) + (size_t)l * 4 * 16 * 65536; g.M = MTOK; g.N = 4 * D_MODEL; g.K = 256; g.lda = D_MODEL; g.ldb = 256;
    pg8::EpiGates E{}; E.G = (unsigned char*)(ws + WS_GATE); E.bias = ap->in[9] + (size_t)l * 4 * D_MODEL; E.RS = (const float*)(ws + WS_RS);
    pg8::SchedGates S; S.init(MTOK / 256, 64, (int)gridDim.x, (int)blockIdx.x);
    pg8::gemm_phase<pg8::EpiGates, pg8::SchedGates>(lds + RING_OFF, g, S, E, tidv);
}
static __device__ __forceinline__ void ph_branch(ArgsP ap, int l, LAS unsigned char* lds, int tidv) {
    unsigned char* ws = ap->ws;
    pg8::Gemm g{}; g.A = (const bf16_t*)(ws + WS_Y); g.Bt = (const bf16_t*)(ws + WS_WB) + (size_t)l * 4 * D_MODEL * 1024; g.M = MTOK; g.N = D_MODEL; g.K = 1024; g.lda = D_MODEL; g.ldb = 1024;
    pg8::EpiBranch E{}; E.G = (const unsigned char*)(ws + WS_GATE); E.merged = (bf16_t*)(ws + WS_MERGED);
    pg8::SchedBranch S; S.init(MTOK / 256, D_MODEL / 256, (int)gridDim.x, (int)blockIdx.x);
    pg8::gemm_phase<pg8::EpiBranch, pg8::SchedBranch>(lds + RING_OFF, g, S, E, tidv);
}
static __device__ __forceinline__ void ph_out(ArgsP ap, int l, LAS unsigned char* lds, int tidv) {
    unsigned char* ws = ap->ws;
    pg8::Gemm g{}; g.A = (const bf16_t*)(ws + WS_MERGED); g.Bt = (const bf16_t*)(ws + WS_WO) + (size_t)l * D_MODEL * D_MODEL; g.M = MTOK; g.N = D_MODEL; g.K = D_MODEL; g.lda = D_MODEL; g.ldb = D_MODEL;
    pg8::EpiOut E{}; E.x = (bf16_t*)(ws + WS_XB); E.ps = (float*)(ws + WS_HO);
    pg8::SchedPlain S; S.init(MTOK / 256, D_MODEL / 256, (int)gridDim.x, (int)blockIdx.x);
    pg8::gemm_phase<pg8::EpiOut, pg8::SchedPlain>(lds + RING_OFF, g, S, E, tidv);
}
__device__ __forceinline__ bool in_range(int lo, int hi, int k) { asm volatile("" : "+s"(k)); return lo <= k && k < hi; }
__device__ __forceinline__ float2 rope_cs(int pos, float frac) {
    const float inv = exp2f(-frac * 13.287712379549449f);
    const float ang = (float)pos * inv;
    double r = (double)ang * 0.15915494309189535; r -= floor(r);
    const float f = (float)r;
    return make_float2(__builtin_amdgcn_cosf(f), __builtin_amdgcn_sinf(f));
}
__global__ void __launch_bounds__(NWAVES * 64, 2) k_mega(Args args_unused) {
    extern __shared__ __attribute__((aligned(16))) unsigned char lds_raw[];
    ArgsP ap = (ArgsP)__builtin_amdgcn_kernarg_segment_ptr();
    int wave_s = __builtin_amdgcn_readfirstlane((int)threadIdx.x >> 6);
#define PHASE_BEGIN() do { asm volatile("" : "+s"(ap), "+s"(wave_s)); unsigned m_ = ~0u; asm volatile("" : "+s"(m_)); tidv = (wave_s << 6) | (int)__builtin_amdgcn_mbcnt_hi(m_, __builtin_amdgcn_mbcnt_lo(m_, 0u)); asm volatile("" : "+v"(tidv)); } while (0)
    int tidv;
    LAS unsigned char* const lds = (LAS unsigned char*)lds_raw;
    const int lo = ap->ph_lo, hi = ap->ph_hi;
    for (int u = threadIdx.x; u < (LDS_BYTES - LDSCTL_OFF) / 4; u += NWAVES * 64) ((LAS unsigned*)(lds + LDSCTL_OFF))[u] = 0u;
    __syncthreads();
    XcdBarrier bar; bar.bar = (unsigned*)ap->ws + CW_BAR + ap->li * XCD_BAR_WORDS; bar.x = 0; bar.st = nullptr;
    if (hi - lo > 1) bar = xcd_barrier_post((unsigned*)ap->ws + CW_BAR + ap->li * XCD_BAR_WORDS, (volatile LAS unsigned*)(lds + MISC_OFF) + 8);
#define IN(k) in_range(lo, hi, (k))
#define BOTH(k) in_range(lo, hi - 1, (k))
#define GRID_BAR() do { asm volatile("" : "+s"(bar.x), "+s"(ap)); bar.bar = (unsigned*)ap->ws + CW_BAR + ap->li * XCD_BAR_WORDS; xcd_barrier(bar); } while (0)
#define VCU() ((int)((gridDim.x % 8 == 0) ? (blockIdx.x % 8) * (gridDim.x / 8) + blockIdx.x / 8 : blockIdx.x))

    if (IN(PH_PRO)) {
        PHASE_BEGIN();
        unsigned char* ws = ap->ws;
        const float* norm_w = ap->in[1]; const float* w_in = ap->in[2]; const float* hgrn_gamma = ap->in[5]; const float* w_branch = ap->in[7]; const float* w_merge = ap->in[8]; const float* w_out = ap->in[10];
        bf16_t* WinT = (bf16_t*)(ws + WS_WIN); bf16_t* WbT = (bf16_t*)(ws + WS_WB); bf16_t* WmT = (bf16_t*)(ws + WS_WM); bf16_t* WoT = (bf16_t*)(ws + WS_WO);
        float2* R128 = (float2*)(ws + WS_ROPE128); float2* R64 = (float2*)(ws + WS_ROPE64); float* LB = (float*)(ws + WS_LB);
        const int lane = tidv & 63, wave = __builtin_amdgcn_readfirstlane(tidv >> 6);
        const int gw = VCU() * NWAVES + wave, NGW = gridDim.x * NWAVES, gt = VCU() * (NWAVES * 64) + tidv, NGT = gridDim.x * NWAVES * 64;
        LAS float* scr = (LAS float*)(lds + RING_OFF + wave * 16384);
        constexpr int I_IN = (D_MODEL / 64) * (NU / 32), I_BR = (1024 / 64) * (D_MODEL / 32), I_MG = (256 / 64) * (256 / 32), I_OUT = (D_MODEL / 64) * (D_MODEL / 32);
        constexpr int T_IN = DEPTH * I_IN, T_BR = DEPTH * 4 * I_BR, T_MG = DEPTH * 64 * I_MG, T_OUT = DEPTH * I_OUT;
#define P0_FAMILY(TOT, IPER, WSRC, SSTR, LDW, KK, NBLK, WDST, DSTR, MAPPED, KSC) \
        for (int it = gw; it < (TOT); it += 2 * NGW) { const int i2 = it + NGW < (TOT) ? it + NGW : it; float ta[32], tb[32]; \
            const float* wa = (WSRC) + (size_t)(it / (IPER)) * (SSTR); const float* wb = (WSRC) + (size_t)(i2 / (IPER)) * (SSTR); \
            p0_item_load(wa, (LDW), (NBLK), it % (IPER), lane, (MAPPED), ta); p0_item_load(wb, (LDW), (NBLK), i2 % (IPER), lane, (MAPPED), tb); \
            { const int mi_ = it / (IPER); p0_item_store((KK), (NBLK), (WDST) + (size_t)mi_ * (DSTR), scr, it % (IPER), lane, ta, KSC); } \
            if (i2 != it) { const int mi_ = i2 / (IPER); p0_item_store((KK), (NBLK), (WDST) + (size_t)mi_ * (DSTR), scr, i2 % (IPER), lane, tb, KSC); } }
        P0_FAMILY(T_IN, I_IN, w_in, (size_t)D_MODEL * IN_WIDTH, IN_WIDTH, D_MODEL, NU / 32, WinT, (size_t)NU * D_MODEL, true, norm_w + (size_t)mi_ * D_MODEL)
        P0_FAMILY(T_BR, I_BR, w_branch, (size_t)1024 * D_MODEL, D_MODEL, 1024, D_MODEL / 32, WbT, (size_t)D_MODEL * 1024, false, (const float*)nullptr)
        P0_FAMILY(T_MG, I_MG, w_merge, (size_t)65536, 256, 256, 256 / 32, WmT, (size_t)65536, false, norm_w + (size_t)(mi_ >> 6) * D_MODEL + (mi_ & 15) * 256)
        P0_FAMILY(T_OUT, I_OUT, w_out, (size_t)D_MODEL * D_MODEL, D_MODEL, D_MODEL, D_MODEL / 32, WoT, (size_t)D_MODEL * D_MODEL, false, (const float*)nullptr)
#undef P0_FAMILY
        for (int i = gt; i < SEQ * 64; i += NGT) { const int pos = i >> 6, j = i & 63; R128[i] = rope_cs(pos, (float)j * (1.0f / 64.0f)); }
        for (int i = gt; i < SEQ * 32; i += NGT) { const int pos = i >> 5, j = i & 31; R64[i] = rope_cs(pos, (float)j * (1.0f / 32.0f)); }
        for (int c = gt; c < 1024; c += NGT) {
            const float g0 = hgrn_gamma[c], g1 = hgrn_gamma[1024 + c], g2 = hgrn_gamma[2048 + c], g3 = hgrn_gamma[3072 + c];
            const float mx = fmaxf(fmaxf(g0, g1), fmaxf(g2, g3));
            const float e0 = expf(g0 - mx), e1 = expf(g1 - mx), e2 = expf(g2 - mx), e3 = expf(g3 - mx);
            const float is = 1.0f / (e0 + e1 + e2 + e3);
            LB[c] = 0.f; LB[1024 + c] = e1 * is; LB[2048 + c] = (e1 + e2) * is; LB[3072 + c] = (e1 + e2 + e3) * is;
        }
    }

    for (int l = 0; l < DEPTH; ++l) {
        const int pb = 1 + l * PH_PER_LAYER;
        if (IN(pb + PH_NORM)) {
            PHASE_BEGIN();
            float* RS = (float*)(ap->ws + WS_RS); bf16_t* XB = (bf16_t*)(ap->ws + WS_XB);
            const int lane = tidv & 63, wave = __builtin_amdgcn_readfirstlane(tidv >> 6);
            const int gw = VCU() * NWAVES + wave, NGW = gridDim.x * NWAVES;
            if (l == 0) { const float* x0 = ap->in[0]; for (int m = gw; m < MTOK; m += NGW) rstd_row_f(x0 + (size_t)m * D_MODEL, XB + (size_t)m * D_MODEL, RS + m, lane); }
            else {
                const float* PS = (const float*)(ap->ws + WS_HO);
                for (int m0 = gw; m0 < MTOK; m0 += 8 * NGW) { float v[8];
#pragma unroll
                    for (int k = 0; k < 8; ++k) { const int m = m0 + k * NGW; v[k] = PS[(size_t)(m < MTOK ? m : m0) * 64 + lane]; }
#pragma unroll
                    for (int k = 0; k < 8; ++k) { const int m = m0 + k * NGW; const float sm = wave_sum(v[k]); if (lane == 0 && m < MTOK) RS[m] = rsqrtf(sm * (1.0f / D_MODEL) + 1e-6f); } } }
            if (BOTH(pb + PH_NORM)) GRID_BAR();
        }
        if (IN(pb + PH_INPROJ)) {
            PHASE_BEGIN(); ph_inproj(ap, l, lds, tidv);
            PHASE_BEGIN(); ph_gates(ap, l, lds, tidv);
            if (BOTH(pb + PH_INPROJ)) GRID_BAR();
        }
        if (IN(pb + PH_M1)) {
            PHASE_BEGIN(); hgrn_h1_phase(ap, l, lds, tidv, VCU()); __syncthreads();
            PHASE_BEGIN(); fox_prep(ap, l, lds, tidv, VCU());
            PHASE_BEGIN(); conv_phase(ap, l, tidv, VCU());
            PHASE_BEGIN(); dsa_score_phase(ap, tidv, VCU());
            if (BOTH(pb + PH_M1)) GRID_BAR(); }
        if (IN(pb + PH_M2)) {
            PHASE_BEGIN(); fox_attn_phase(ap, l, lds, tidv, VCU());
            PHASE_BEGIN(); hgrn_h2_phase(ap, tidv, VCU());
            __syncthreads(); PHASE_BEGIN(); dsa_topk_phase(ap, lds, tidv, VCU());
            if (BOTH(pb + PH_M2)) GRID_BAR(); }
        if (IN(pb + PH_M3)) {
            PHASE_BEGIN(); hgrn_h3_phase(ap, l, lds, tidv, VCU());
            __syncthreads(); PHASE_BEGIN(); dsa_attn_phase(ap, lds, tidv, VCU());
            if (BOTH(pb + PH_M3)) GRID_BAR(); }
        if (IN(pb + PH_BRANCH)) { PHASE_BEGIN(); ph_branch(ap, l, lds, tidv); if (BOTH(pb + PH_BRANCH)) GRID_BAR(); }
        if (IN(pb + PH_OUT)) { PHASE_BEGIN(); ph_out(ap, l, lds, tidv); if (BOTH(pb + PH_OUT)) GRID_BAR(); }
    }
    if (IN(PH_FINAL)) {
        PHASE_BEGIN();
        const bf16_t* XB = (const bf16_t*)(ap->ws + WS_XB); float* xout = ap->out; const float* fw = ap->in[11];
        const int lane = tidv & 63, wave = __builtin_amdgcn_readfirstlane(tidv >> 6);
        const int gw = VCU() * NWAVES + wave, NGW = gridDim.x * NWAVES;
        for (int m = gw; m < MTOK; m += NGW) rms_row_b<true>(XB + (size_t)m * D_MODEL, fw, nullptr, xout + (size_t)m * D_MODEL, lane);
    }
#undef IN
#undef BOTH
#undef GRID_BAR
#undef PHASE_BEGIN
#undef VCU
}

extern "C" void kernel_launch(void* const* d_in, const int* in_sizes, int n_in, void* d_out, int out_size, void* d_ws, size_t ws_size, hipStream_t stream) {
    static int grid = 0;
    if (grid == 0) {
        if (ws_size < WS_END || n_in != 12) { fprintf(stderr, "kernel_launch: bad arguments (ws %zu < %zu or n_in %d)\n", ws_size, (size_t)WS_END, n_in); grid = -1; return; }
        int dev = 0, cus = 0, per_cu = 0;
        if (hipGetDevice(&dev) != hipSuccess || hipDeviceGetAttribute(&cus, hipDeviceAttributeMultiprocessorCount, dev) != hipSuccess) { grid = -1; return; }
        if (hipFuncSetAttribute((const void*)k_mega, hipFuncAttributeMaxDynamicSharedMemorySize, LDS_BYTES) != hipSuccess) { fprintf(stderr, "kernel_launch: hipFuncSetAttribute failed\n"); grid = -1; return; }
        if (hipOccupancyMaxActiveBlocksPerMultiprocessor(&per_cu, (const void*)k_mega, NWAVES * 64, LDS_BYTES) != hipSuccess || per_cu < 1) { fprintf(stderr, "kernel_launch: occupancy query says %d\n", per_cu); }
        (void)hipGetLastError();
        grid = cus;
    }
    if (grid < 0) return;
    (void)hipMemsetAsync((char*)d_ws + WS_CTL, 0, (size_t)(CW_BAR + XCD_BAR_WORDS) * 4, stream);
    Args a{};
    for (int i = 0; i < 12; ++i) a.in[i] = (const float*)d_in[i];
    a.out = (float*)d_out; a.ws = (unsigned char*)d_ws;
    const float* fox_f_bias = (const float*)d_in[3]; const float* conv_w = (const float*)d_in[4]; const float* hgrn_norm_w = (const float*)d_in[6];
    unsigned char* ws = (unsigned char*)d_ws;
    bf16_t* U = (bf16_t*)(ws + WS_U); float* UM = (float*)(ws + WS_UM); bf16_t* Y = (bf16_t*)(ws + WS_Y);
    float* SCORE = (float*)(ws + WS_SCORE); int* IDX = (int*)(ws + WS_IDX); float* CF = (float*)(ws + WS_CF); float* HO = (float*)(ws + WS_HO);
    float2* R128 = (float2*)(ws + WS_ROPE128); float2* R64 = (float2*)(ws + WS_ROPE64); float* LB = (float*)(ws + WS_LB);
    a.ph_lo = 0; a.ph_hi = PH_COUNT; a.li = 0;
    hipLaunchKernelGGL(k_mega, dim3(grid), dim3(NWAVES * 64), LDS_BYTES, stream, a);
}
```
